# Optimizing an MI355X kernel written in HIP

```python
import jax, jax.numpy as jnp
from jax import lax
import numpy as np

D_MODEL = 1024
BATCH = 2
SEQ = 8192
DEPTH = 2

HEAD_DIM = 128
HEADS_PER_GROUP = 4
ATT_PATTERNS = ((128, 1), (512, 4), (2048, 16))
N_GROUPS = 3
N_ATT_HEADS = N_GROUPS * HEADS_PER_GROUP
ATT_QKV_WIDTH = N_ATT_HEADS * HEAD_DIM
ATT_OUT_WIDTH = HEADS_PER_GROUP * HEAD_DIM
ATT_BLOCK = 64
NEG_INF = -1e30
LRU_WIDTH = D_MODEL
LRU_BLOCKS = 4
LRU_BLOCK_WIDTH = LRU_WIDTH // LRU_BLOCKS
CONV_WIDTH = 4
CONV_LEFT = 2
RG_C = 8.0
NORM_EPS = 1e-6
IN_WIDTH = 3 * ATT_QKV_WIDTH + ATT_OUT_WIDTH + 2 * LRU_WIDTH + 2 * D_MODEL

kernel_name = "hybrid_dilated_attn_rglru_encoder"


def rms_norm(x, g):
    x32 = x.astype(jnp.float32)
    y = x32 * lax.rsqrt(jnp.mean(x32 * x32, axis=-1, keepdims=True) + NORM_EPS)
    return (y * g.astype(jnp.float32)).astype(x.dtype)


def alibi_slopes():
    return 2.0 ** (-8.0 * jnp.arange(1, N_ATT_HEADS + 1, dtype=jnp.float32) / N_ATT_HEADS)


def dilated_window_attention(q, k, v, window, dilation, slopes):
    b, s, h, dh = q.shape
    half = window // (2 * dilation)
    c = ATT_BLOCK
    n = s // dilation
    nblk = -(-n // c)
    pad = nblk * c - n

    def strided(t):
        return t.reshape(b, n, dilation, h, dh).transpose(0, 2, 1, 3, 4)

    qs = jnp.pad(strided(q), ((0, 0), (0, 0), (0, pad), (0, 0), (0, 0))).reshape(b, dilation, nblk, c, h, dh)

    def band(t):
        tp = jnp.pad(strided(t), ((0, 0), (0, 0), (c, pad + c), (0, 0), (0, 0))).reshape(b, dilation, nblk + 2, c, h, dh)
        return jnp.concatenate([tp[:, :, :-2], tp[:, :, 1:-1], tp[:, :, 2:]], axis=3)

    kw, vw = band(k), band(v)
    scores = jnp.einsum('brnqhd,brnkhd->brnhqk', qs, kw, preferred_element_type=jnp.float32) * (dh ** -0.5)
    qi = jnp.arange(c)
    kj = jnp.arange(3 * c) - c
    delta = kj[None, :] - qi[:, None]
    key_idx = jnp.arange(nblk)[:, None] * c + kj[None, :]
    valid = (jnp.abs(delta) <= half)[None] & ((key_idx >= 0) & (key_idx < n))[:, None, :]
    dist = (jnp.abs(delta) * dilation).astype(jnp.float32)
    bias = -slopes.astype(jnp.float32)[:, None, None] * dist[None]
    scores = jnp.where(valid[:, None], scores + bias, NEG_INF)
    m = jnp.max(scores, axis=-1, keepdims=True)
    p = jnp.exp(scores - m)
    den = jnp.sum(p, axis=-1, keepdims=True)
    out = jnp.einsum('brnhqk,brnkhd->brnqhd', p / den, vw.astype(jnp.float32))
    lse = (m + jnp.log(den))[..., 0].transpose(0, 1, 2, 4, 3)

    def unstride(t):
        t = t.reshape((b, dilation, nblk * c) + t.shape[4:])[:, :, :n]
        t = jnp.moveaxis(t, 1, 2)
        return t.reshape((b, s) + t.shape[3:])

    return unstride(out), unstride(lse)


def dilated_attention_mixer(q, k, v):
    b, s, _ = q.shape
    shp = (b, s, N_GROUPS, HEADS_PER_GROUP, HEAD_DIM)
    q, k, v = q.reshape(shp), k.reshape(shp), v.reshape(shp)
    slopes = alibi_slopes().reshape(N_GROUPS, HEADS_PER_GROUP)
    outs, lses = [], []
    for g, (window, dilation) in enumerate(ATT_PATTERNS):
        o, l = dilated_window_attention(q[:, :, g], k[:, :, g], v[:, :, g], window, dilation, slopes[g])
        outs.append(o)
        lses.append(l)
    outs = jnp.stack(outs, axis=0)
    alpha = jax.nn.softmax(jnp.stack(lses, axis=0), axis=0)
    mixed = jnp.sum(alpha[..., None] * outs, axis=0)
    return mixed.reshape(b, s, ATT_OUT_WIDTH).astype(q.dtype)


def centred_depthwise_conv(x, w, bias):
    s = x.shape[1]
    xp = jnp.pad(x, ((0, 0), (CONV_LEFT, CONV_WIDTH - 1 - CONV_LEFT), (0, 0)))
    y = bias + xp[:, 0:s] * w[0]
    for j in range(1, CONV_WIDTH):
        y = y + xp[:, j:j + s] * w[j]
    return y


def block_diag_linear(x, w, b):
    xr = x.reshape(x.shape[:-1] + (LRU_BLOCKS, LRU_BLOCK_WIDTH))
    return jnp.einsum('bsni,nij->bsnj', xr, w).reshape(x.shape) + b


def _linear_combine(left, right):
    a1, b1 = left
    a2, b2 = right
    return a1 * a2, a2 * b1 + b2


def rg_lru(x, w_a, b_a, w_x, b_x, lam, reverse):
    s = x.shape[1]
    r = jax.nn.sigmoid(block_diag_linear(x, w_a, b_a)).astype(jnp.float32)
    i = jax.nn.sigmoid(block_diag_linear(x, w_x, b_x))
    log_a = -RG_C * r * jax.nn.softplus(-lam.astype(jnp.float32))
    a = jnp.exp(log_a)
    mult = jnp.sqrt(-jnp.expm1(2.0 * log_a))
    first = (jnp.arange(s) == (s - 1 if reverse else 0))[None, :, None]
    mult = jnp.where(first, 1.0, mult)
    bterm = mult * (i * x).astype(jnp.float32)
    _, h = lax.associative_scan(_linear_combine, (a, bterm), axis=1, reverse=reverse)
    return h


def recurrent_mixer(x, conv_w, conv_b, w_a, b_a, w_x, b_x, lam):
    xc = centred_depthwise_conv(x, conv_w, conv_b)
    h = rg_lru(xc, w_a[0], b_a[0], w_x[0], b_x[0], lam[0], False) + \
        rg_lru(xc, w_a[1], b_a[1], w_x[1], b_x[1], lam[1], True)
    return h.astype(x.dtype)


def hybrid_layer(x, norm_g, w_in, b_gate, conv_w, conv_b, rg_w_a, rg_b_a, rg_w_x, rg_b_x, rg_lam,
                 w_o_att, w_o_lru, w_out):
    xn = rms_norm(x, norm_g)
    proj = xn @ w_in
    widths = [ATT_QKV_WIDTH, ATT_QKV_WIDTH, ATT_QKV_WIDTH, ATT_OUT_WIDTH, LRU_WIDTH, LRU_WIDTH]
    cuts = [int(c) for c in np.cumsum(widths)]
    q, k, v, g_att, x_lru, g_lru, gate_logits = jnp.split(proj, cuts, axis=-1)
    y_att = dilated_attention_mixer(q, k, v) * jax.nn.silu(g_att)
    y_lru = recurrent_mixer(x_lru, conv_w, conv_b, rg_w_a, rg_b_a, rg_w_x, rg_b_x, rg_lam) * jax.nn.silu(g_lru)
    gates = jax.nn.sigmoid(gate_logits + b_gate)
    gate_att, gate_lru = gates[..., :D_MODEL], gates[..., D_MODEL:]
    merged = gate_att * (y_att @ w_o_att) + gate_lru * (y_lru @ w_o_lru)
    return x + merged @ w_out


def setup_inputs(seed: int = 0) -> dict:
    key = jax.random.key(seed)
    ks = jax.random.split(key, 16)
    f32 = jnp.float32
    nrm = lambda k, shp, scale: jax.random.normal(k, shp, f32) * scale
    a_init = jax.random.uniform(ks[11], (DEPTH, 2, LRU_WIDTH), f32, 0.9, 0.999)
    p0 = a_init ** (1.0 / RG_C)
    return {
        "x": nrm(ks[0], (BATCH, SEQ, D_MODEL), 1.0),
        "norm_g": 1.0 + nrm(ks[1], (DEPTH, D_MODEL), 0.1),
        "w_in": nrm(ks[2], (DEPTH, D_MODEL, IN_WIDTH), D_MODEL ** -0.5),
        "b_gate": nrm(ks[3], (DEPTH, 2 * D_MODEL), 0.1),
        "conv_w": nrm(ks[4], (DEPTH, CONV_WIDTH, LRU_WIDTH), CONV_WIDTH ** -0.5),
        "conv_b": nrm(ks[5], (DEPTH, LRU_WIDTH), 0.05),
        "rg_w_a": nrm(ks[6], (DEPTH, 2, LRU_BLOCKS, LRU_BLOCK_WIDTH, LRU_BLOCK_WIDTH), LRU_BLOCK_WIDTH ** -0.5),
        "rg_b_a": nrm(ks[7], (DEPTH, 2, LRU_WIDTH), 0.1),
        "rg_w_x": nrm(ks[8], (DEPTH, 2, LRU_BLOCKS, LRU_BLOCK_WIDTH, LRU_BLOCK_WIDTH), LRU_BLOCK_WIDTH ** -0.5),
        "rg_b_x": nrm(ks[9], (DEPTH, 2, LRU_WIDTH), 0.1),
        "rg_lam": jnp.log(p0) - jnp.log1p(-p0),
        "w_o_att": nrm(ks[12], (DEPTH, ATT_OUT_WIDTH, D_MODEL), ATT_OUT_WIDTH ** -0.5),
        "w_o_lru": nrm(ks[13], (DEPTH, LRU_WIDTH, D_MODEL), LRU_WIDTH ** -0.5),
        "w_out": nrm(ks[14], (DEPTH, D_MODEL, D_MODEL), D_MODEL ** -0.5),
        "final_g": 1.0 + nrm(ks[15], (D_MODEL,), 0.1),
    }


def reference(x, norm_g, w_in, b_gate, conv_w, conv_b, rg_w_a, rg_b_a, rg_w_x, rg_b_x, rg_lam,
              w_o_att, w_o_lru, w_out, final_g):
    for l in range(DEPTH):
        x = hybrid_layer(x, norm_g[l], w_in[l], b_gate[l], conv_w[l], conv_b[l], rg_w_a[l], rg_b_a[l],
                         rg_w_x[l], rg_b_x[l], rg_lam[l], w_o_att[l], w_o_lru[l], w_out[l])
    return rms_norm(x, final_g)
```

```cpp
#include <hip/hip_runtime.h>
#include <cstdio>
#include <cstdint>

#ifndef MK_N_LAUNCHES
#define MK_N_LAUNCHES 16
#endif

#define LAS __attribute__((address_space(3)))
#define GAS __attribute__((address_space(1)))
typedef unsigned short bf16_t;
typedef short bf16x8 __attribute__((ext_vector_type(8)));
typedef float f32x4 __attribute__((ext_vector_type(4)));
typedef float f32x2 __attribute__((ext_vector_type(2)));
typedef unsigned u32x4 __attribute__((ext_vector_type(4)));
typedef unsigned u32x2 __attribute__((ext_vector_type(2)));

constexpr int BATCH = 2, SEQ = 8192, DM = 1024, M = BATCH * SEQ, DEPTH = 2;
constexpr int NIN = 9216, NH = 12, HD = 128;
constexpr int NCOL_A = 5120, NCOL_B = 4096;
constexpr float LOG2E = 1.4426950408889634f;
constexpr float QSCALE = 0.08838834764831845f * LOG2E;
constexpr float NORM_EPS = 1e-6f;

constexpr size_t MiB = 1u << 20;
constexpr size_t WS_CTL = 0, CTL_ZERO_BYTES = 1 * MiB;
constexpr size_t WS_LSE = 1 * MiB;
constexpr size_t WS_TIL = 2 * MiB;
constexpr size_t WS_W   = 8 * MiB;
constexpr size_t W_IN_T = 0;
constexpr size_t W_OATT_T = W_IN_T + (size_t)2 * NIN * DM * 2;
constexpr size_t W_OLRU_T = W_OATT_T + (size_t)2 * DM * 512 * 2;
constexpr size_t W_OUT_T  = W_OLRU_T + (size_t)2 * DM * DM * 2;
constexpr size_t W_RG_T   = W_OUT_T + (size_t)2 * DM * DM * 2;
constexpr size_t W_END    = W_RG_T + (size_t)2 * 16 * 65536 * 2;
static_assert(W_END == 50 * MiB, "weight map");
constexpr size_t WS_XB  = 58 * MiB;
constexpr size_t WS_Q   = 90 * MiB;
constexpr size_t WS_K   = 138 * MiB;
constexpr size_t WS_V   = 186 * MiB;
constexpr size_t WS_XLRU = WS_K;
constexpr size_t WS_SGL  = WS_K + 32 * MiB;
constexpr size_t WS_GATE = WS_K + 64 * MiB;
constexpr size_t WS_SGA  = 266 * MiB;
constexpr size_t WS_END  = 282 * MiB;
static_assert(WS_V - WS_K == WS_K - WS_Q, "q/k/v spacing");
constexpr int CW_BAR = 4096;
constexpr int CW_SS = 65536;
static_assert((CW_SS + 3 * M) * 4 <= (int)CTL_ZERO_BYTES, "ctl");

constexpr int RING_BYTES = 131072;
constexpr int LRU_PITCH = 528;
constexpr int LRU_IMG = 256 * LRU_PITCH;
constexpr int LRU_XCH = LRU_IMG;
constexpr int LDSCTL_OFF = 147456;
constexpr int LDS_BYTES = 148480;
static_assert(LRU_XCH + 4096 <= LDSCTL_OFF, "lds");

#define RLX_AGENT __ATOMIC_RELAXED, __HIP_MEMORY_SCOPE_AGENT
#define LDS_WAIT() asm volatile("s_waitcnt lgkmcnt(0)" ::: "memory")
#define VM_WAIT() asm volatile("s_waitcnt vmcnt(0)" ::: "memory")

__device__ __forceinline__ unsigned cvt_pk_bf16(float lo, float hi) { unsigned r; asm volatile("v_cvt_pk_bf16_f32 %0, %1, %2" : "=v"(r) : "v"(lo), "v"(hi)); return r; }
__device__ __forceinline__ float bf_lo(unsigned w) { return __uint_as_float(w << 16); }
__device__ __forceinline__ float bf_hi(unsigned w) { return __uint_as_float(w & 0xffff0000u); }
__device__ __forceinline__ float fast_sigmoid(float v) { return __builtin_amdgcn_rcpf(1.0f + __builtin_amdgcn_exp2f(-LOG2E * v)); }
__device__ __forceinline__ float fast_silu(float v) { return v * fast_sigmoid(v); }

namespace pg8 {
constexpr int BM = 256, BK = 64, HALF = 128, HTB = HALF * BK * 2, STAGE_BYTES = 8 * HTB, NXCD = 8, WGM = 8;
__host__ __device__ __forceinline__ int lds_byte(int r, int c) { const int st = (r >> 4) * 2 + (c >> 5), rr = r & 15, cc = c & 31, ob = rr * 64 + cc * 2; return st * 1024 + (ob ^ (((ob >> 9) & 1) << 5)); }
__host__ __device__ __forceinline__ void stage_rc(int b, int& R, int& C) { const int st = b / 1024, sb = b % 1024, swz = sb ^ (((sb >> 9) & 1) << 5); R = (st >> 1) * 16 + swz / 64; C = (st & 1) * 32 + (swz % 64) / 2; }
__host__ __device__ __forceinline__ int perm32(int rho) { const int n = rho >> 4, i = rho & 15; return 8 * (i >> 2) + 4 * n + (i & 3); }

struct Unit { int pm, pn; int abyte, bbyte; };
struct Gemm { const bf16_t* A; const bf16_t* Bt; int lda, ldb, K; };

struct StaticOrder {
    int nM, nN, nwg, G, c, ta, tb;
    __device__ void init(int Mr, int N, int G_, int c_, int lda, int ldb) { nM = Mr / BM; nN = N / BM; nwg = nM * nN; G = G_; c = c_; ta = BM * lda * 2; tb = BM * ldb * 2; }
    __device__ bool next(int i, Unit& u) const {
        const long L = (long)i * G + c; if (L >= nwg) return false;
        int wgid = (int)L; { const int q = nwg / NXCD, r = nwg % NXCD, xcd = wgid % NXCD, off = wgid / NXCD; wgid = (xcd < r ? xcd * (q + 1) : r * (q + 1) + (xcd - r) * q) + off; }
        const int nig = WGM * nN, gid = wgid / nig, fm = gid * WGM, gsz = (nM - fm) < WGM ? (nM - fm) : WGM;
        u.pm = fm + ((wgid % nig) % gsz); u.pn = (wgid % nig) / gsz; u.abyte = u.pm * ta; u.bbyte = u.pn * tb; return true;
    }
};
struct SingleUnit {
    Unit u0;
    __device__ bool next(int i, Unit& u) const { if (i != 0) return false; u = u0; return true; }
};

template <class Epi, class Sched>
__device__ __forceinline__ void gemm_phase(int tid_in, LAS unsigned char* lds, const Gemm g, const Sched& S, const Epi& E) {
    int tid = tid_in; asm volatile("" : "+v"(tid));
    const int wid = __builtin_amdgcn_readfirstlane(tid >> 6), lane = tid & 63, wr = wid >> 2, wc = wid & 3, fr = lane & 15, fq = lane >> 4;
    const int K = g.K, nt = K / BK;
    unsigned voffA[2], voffB[2];
#pragma unroll
    for (int i = 0; i < 2; ++i) { int R, C; stage_rc(tid * 16 + i * 8192, R, C); const int Rb = Epi::PERM ? ((R & ~31) + perm32(R & 31)) : R;
        voffA[i] = (unsigned)(R * g.lda + C) * 2u; voffB[i] = (unsigned)(Rb * g.ldb + C) * 2u; }
    const int kstep = BK * 2;
    const int hstepA = HALF * g.lda * 2, hstepB = HALF * g.ldb * 2;
    const __amdgpu_buffer_rsrc_t rsA = __builtin_amdgcn_make_buffer_rsrc((void*)g.A, 0, 0x7ffffff0, 0x00020000);
    const __amdgpu_buffer_rsrc_t rsB = __builtin_amdgcn_make_buffer_rsrc((void*)g.Bt, 0, 0x7ffffff0, 0x00020000);
    const unsigned ldsw = (unsigned)wid * 1024u;
    const int aoff = lds_byte(wr * 64 + fr, fq * 8), boff = lds_byte(wc * 32 + fr, fq * 8);
#define PG8_SA(b, h) (((b) * 2 + (h)) * HTB)
#define PG8_SB(b, h) ((4 + (b) * 2 + (h)) * HTB)
#define PG8_STAGEA(bufoff, soff) do { _Pragma("unroll") for (int _i = 0; _i < 2; ++_i) \
        __builtin_amdgcn_raw_ptr_buffer_load_lds(rsA, (LAS void*)(lds + (bufoff) + ldsw + _i * 8192), 16, (int)voffA[_i], (soff), 0, 0); } while (0)
#define PG8_STAGEB(bufoff, soff) do { _Pragma("unroll") for (int _i = 0; _i < 2; ++_i) \
        __builtin_amdgcn_raw_ptr_buffer_load_lds(rsB, (LAS void*)(lds + (bufoff) + ldsw + _i * 8192), 16, (int)voffB[_i], (soff), 0, 0); } while (0)
#define PG8_LDA(dst, b, h) do { _Pragma("unroll") for (int m = 0; m < 4; ++m) _Pragma("unroll") for (int k = 0; k < 2; ++k) dst[m][k] = *(const LAS bf16x8*)(lds + PG8_SA(b, h) + aoff + m * 2048 + k * 1024); } while (0)
#define PG8_LDB(dst, b, h) do { _Pragma("unroll") for (int n = 0; n < 2; ++n) _Pragma("unroll") for (int k = 0; k < 2; ++k) dst[n][k] = *(const LAS bf16x8*)(lds + PG8_SB(b, h) + boff + n * 2048 + k * 1024); } while (0)
#define PG8_MMA(ai, bj, At, Bt) do { __builtin_amdgcn_s_setprio(1); _Pragma("unroll") for (int m = 0; m < 4; ++m) _Pragma("unroll") for (int n = 0; n < 2; ++n) _Pragma("unroll") for (int k = 0; k < 2; ++k) \
        acc[ai][bj][m][n] = __builtin_amdgcn_mfma_f32_16x16x32_bf16(Bt[n][k], At[m][k], acc[ai][bj][m][n], 0, 0, 0); __builtin_amdgcn_s_setprio(0); } while (0)
#define PG8_WAIT_V(n) asm volatile("s_waitcnt vmcnt(" #n ")" ::: "memory")
#define PG8_WAIT_L(n) asm volatile("s_waitcnt lgkmcnt(" #n ")" ::: "memory")
#define PG8_BAR __builtin_amdgcn_s_barrier()
#define PG8_SCHED __builtin_amdgcn_sched_barrier(0)
    Unit cur, nxt; int ui = 0;
    if (!S.next(0, cur)) return;
    f32x4 acc[2][2][4][2];
#pragma unroll
    for (int a = 0; a < 2; ++a)
#pragma unroll
        for (int b = 0; b < 2; ++b)
#pragma unroll
            for (int m = 0; m < 4; ++m)
#pragma unroll
                for (int n = 0; n < 2; ++n) acc[a][b][m][n] = (f32x4){0.f, 0.f, 0.f, 0.f};
    bf16x8 At[4][2], B0[2][2], B1[2][2];
    int cA = cur.abyte, cB = cur.bbyte;
    PG8_STAGEB(PG8_SB(0, 0), cB); PG8_STAGEB(PG8_SB(0, 1), cB + hstepB); PG8_STAGEA(PG8_SA(0, 0), cA); PG8_STAGEA(PG8_SA(0, 1), cA + hstepA);
    if (wr == 1) PG8_BAR;
    PG8_WAIT_V(2); PG8_BAR;
    PG8_STAGEB(PG8_SB(1, 0), cB + kstep); PG8_STAGEA(PG8_SA(1, 0), cA + kstep); PG8_STAGEB(PG8_SB(1, 1), cB + hstepB + kstep);
    PG8_WAIT_V(6); PG8_BAR;
    for (;;) {
        const bool has_next = S.next(ui + 1, nxt);
        const int nA = has_next ? nxt.abyte : cA, nB = has_next ? nxt.bbyte : cB;
#pragma unroll 1
        for (int t = 0; t < nt; t += 2) {
            const bool last = (t == nt - 2);
            const int a1 = cA + (t + 1) * kstep;
            const int a2 = last ? nA : cA + (t + 2) * kstep, b2 = last ? nB : cB + (t + 2) * kstep;
            const int a3 = a2 + kstep, b3 = b2 + kstep;
            PG8_LDB(B0, 0, 0); PG8_LDB(B1, 0, 1); PG8_SCHED; PG8_LDA(At, 0, 0); PG8_STAGEA(PG8_SA(1, 1), a1 + hstepA);
            PG8_WAIT_V(8); PG8_WAIT_L(0); PG8_BAR; PG8_MMA(0, 0, At, B0); PG8_MMA(0, 1, At, B1); PG8_BAR; PG8_SCHED;
            PG8_LDA(At, 0, 1); PG8_STAGEB(PG8_SB(0, 0), b2); PG8_STAGEB(PG8_SB(0, 1), b2 + hstepB); PG8_STAGEA(PG8_SA(0, 0), a2);
            PG8_WAIT_V(8); PG8_WAIT_L(0); PG8_BAR; PG8_MMA(1, 0, At, B0); PG8_MMA(1, 1, At, B1); PG8_BAR; PG8_SCHED;
            PG8_LDB(B0, 1, 0); PG8_LDB(B1, 1, 1); PG8_SCHED; PG8_LDA(At, 1, 0); PG8_STAGEA(PG8_SA(0, 1), a2 + hstepA);
            PG8_WAIT_V(8); PG8_WAIT_L(0); PG8_BAR; PG8_MMA(0, 0, At, B0); PG8_MMA(0, 1, At, B1); PG8_BAR; PG8_SCHED;
            PG8_LDA(At, 1, 1); PG8_STAGEB(PG8_SB(1, 0), b3); PG8_STAGEB(PG8_SB(1, 1), b3 + hstepB); PG8_STAGEA(PG8_SA(1, 0), a3);
            PG8_WAIT_V(8); PG8_WAIT_L(0); PG8_BAR; PG8_MMA(1, 0, At, B0); PG8_MMA(1, 1, At, B1); PG8_BAR; PG8_SCHED;
        }
        if constexpr (!Epi::AFTER_DRAIN) { if (wr == 0) PG8_BAR; int l2 = lane; asm volatile("" : "+v"(l2)); int w2 = wid; asm volatile("" : "+s"(w2)); E(acc, cur, w2 >> 2, w2 & 3, l2 & 15, l2 >> 4); }
        if (!has_next) break;
#pragma unroll
        for (int a = 0; a < 2; ++a)
#pragma unroll
            for (int b = 0; b < 2; ++b)
#pragma unroll
                for (int m = 0; m < 4; ++m)
#pragma unroll
                    for (int n = 0; n < 2; ++n) acc[a][b][m][n] = (f32x4){0.f, 0.f, 0.f, 0.f};
        cur = nxt; cA = nA; cB = nB; ++ui;
        if constexpr (!Epi::AFTER_DRAIN) { if (wr == 1) PG8_BAR; }
    }
    PG8_WAIT_V(0);
    if constexpr (Epi::AFTER_DRAIN) { if (wr == 0) PG8_BAR; }
    PG8_BAR;
    if constexpr (Epi::AFTER_DRAIN) { int l2 = lane; asm volatile("" : "+v"(l2)); int w2 = wid; asm volatile("" : "+s"(w2)); E.fused(acc, cur, w2 >> 2, w2 & 3, l2 & 15, l2 >> 4, lds, w2, l2); }
#undef PG8_SA
#undef PG8_SB
#undef PG8_STAGEA
#undef PG8_STAGEB
#undef PG8_LDA
#undef PG8_LDB
#undef PG8_MMA
#undef PG8_WAIT_V
#undef PG8_WAIT_L
#undef PG8_BAR
#undef PG8_SCHED
}
}

#define XB_TMO      128
#define XB_XCNT(j)  (256  + 64 * (j))
#define XB_XSUB(j)  (1280 + 64 * (j))
#define XB_XGEN(j)  (2304 + 64 * (j))
#define XB_TOP      3328
#define XB_TOPGEN   3392
#define XCD_BAR_WORDS 3456
#define XB_SPIN_CAP (1u << 18)
__device__ __forceinline__ unsigned xb_ld(unsigned* p)              { return __hip_atomic_load(p, __ATOMIC_RELAXED, __HIP_MEMORY_SCOPE_AGENT); }
__device__ __forceinline__ unsigned xb_add(unsigned* p, unsigned v) { return __hip_atomic_fetch_add(p, v, __ATOMIC_RELAXED, __HIP_MEMORY_SCOPE_AGENT); }
__device__ __forceinline__ unsigned xb_xcc_id() { return (unsigned)__builtin_amdgcn_s_getreg((3 << 11) | 20) & 0xFu; }
#define XB_SPIN(cond, bar) do { unsigned _sp = 0; while (cond) { __builtin_amdgcn_s_sleep(1); \
    if ((++_sp & 255u) == 0u) { if (xb_ld(&(bar)[XB_TMO])) break; if (_sp > XB_SPIN_CAP) { atomicAdd(&(bar)[XB_TMO], 1u); break; } } } } while (0)
struct XcdBarrier { unsigned* bar; unsigned x; volatile LAS unsigned* st; };
__device__ __forceinline__ XcdBarrier xcd_barrier_post(unsigned* bar, volatile LAS unsigned* st) {
    XcdBarrier b; b.bar = bar; b.x = xb_xcc_id(); b.st = st;
    if (threadIdx.x == 0) (void)xb_add(&bar[XB_XCNT(b.x)], 1u);
    return b;
}
__device__ __forceinline__ void xcd_barrier_complete(unsigned* bar, unsigned x, unsigned& nloc, unsigned& nx) {
    const unsigned G = gridDim.x * gridDim.y * gridDim.z;
    unsigned sum, cnt, mine, sp = 0u;
    for (;;) {
        sum = 0u; cnt = 0u; mine = 0u;
#pragma unroll
        for (unsigned j = 0; j < 16; ++j) { const unsigned c = xb_ld(&bar[XB_XCNT(j)]); sum += c; cnt += (c > 0u) ? 1u : 0u; mine = (j == x) ? c : mine; }
        if (sum == G) break;
        __builtin_amdgcn_s_sleep(1);
        if ((++sp & 255u) == 0u) { if (xb_ld(&bar[XB_TMO])) break; if (sp > XB_SPIN_CAP) { atomicAdd(&bar[XB_TMO], 1u); break; } }
    }
    nloc = mine > 0u ? mine : 1u; nx = cnt > 0u ? cnt : 1u;
}
__device__ __forceinline__ void xcd_barrier(const XcdBarrier& b) {
    asm volatile("s_waitcnt vmcnt(0)" ::: "memory");
    __syncthreads();
    if (threadIdx.x == 0) {
        unsigned* bar = b.bar;
        __builtin_amdgcn_s_waitcnt(0);
        unsigned nloc = b.st[0], nx = b.st[1];
        if (nloc == 0u) { xcd_barrier_complete(bar, b.x, nloc, nx); b.st[0] = nloc; b.st[1] = nx; }
        const unsigned old = xb_add(&bar[XB_XSUB(b.x)], 1u);
        const unsigned gen = old / nloc;
        if (old + 1u == (gen + 1u) * nloc) {
            __builtin_amdgcn_fence(__ATOMIC_RELEASE, "agent");
            asm volatile("s_waitcnt vmcnt(0)" ::: "memory");
            const unsigned og = xb_add(&bar[XB_TOP], 1u);
            const unsigned tg = og / nx;
            if (og + 1u == (tg + 1u) * nx) xb_add(&bar[XB_TOPGEN], 1u);
            else XB_SPIN(xb_ld(&bar[XB_TOPGEN]) == tg, bar);
            __builtin_amdgcn_fence(__ATOMIC_ACQUIRE, "agent");
            xb_add(&bar[XB_XGEN(b.x)], 1u);
            asm volatile("s_waitcnt vmcnt(0)" ::: "memory");
        } else {
            XB_SPIN(xb_ld(&bar[XB_XGEN(b.x)]) == gen, bar);
            __builtin_amdgcn_fence(__ATOMIC_ACQUIRE, "agent");
            asm volatile("s_waitcnt vmcnt(0)" ::: "memory");
        }
    }
    __syncthreads();
}

struct Frame {
    LAS unsigned char* lds;
    unsigned* ctl;
    int tid, lane, wave, vcu, G;
    unsigned char* ws;
};
struct Args { const float* in[15]; float* out; unsigned char* ws; int ph_lo, ph_hi, li, pad; };

__device__ __forceinline__ int fresh(int v) { asm volatile("" : "+v"(v)); return v; }
__device__ __forceinline__ float wave_sum(float v) {
#pragma unroll
    for (int o = 1; o < 64; o <<= 1) v += __shfl_xor(v, o);
    return v;
}
__device__ __forceinline__ float wave_max(float v) {
#pragma unroll
    for (int o = 1; o < 64; o <<= 1) v = fmaxf(v, __shfl_xor(v, o));
    return v;
}

template <class RowFn>
__device__ __forceinline__ void p0_transpose_item(const float* W, int K, int N, const float* kscale, const RowFn& rowptr, LAS float* scr, int item, int lane) {
    const int nblk = N / 32, kb = item / nblk, nb = item % nblk, k0 = 64 * kb, n0 = 32 * nb;
#pragma unroll 8
    for (int i = 0; i < 32; ++i) { const int kk = 2 * i + (lane >> 5); const float sc = kscale ? kscale[k0 + kk] : 1.0f; scr[kk * 33 + (lane & 31)] = W[(size_t)(k0 + kk) * N + n0 + (lane & 31)] * sc; }
    LDS_WAIT(); asm volatile("" ::: "memory");
    const int c = lane & 7;
#pragma unroll
    for (int j = 0; j < 4; ++j) { const int n = (lane >> 3) + 8 * j; const LAS float* s = scr + (8 * c) * 33 + n;
        u32x4 o; o.x = cvt_pk_bf16(s[0 * 33], s[1 * 33]); o.y = cvt_pk_bf16(s[2 * 33], s[3 * 33]); o.z = cvt_pk_bf16(s[4 * 33], s[5 * 33]); o.w = cvt_pk_bf16(s[6 * 33], s[7 * 33]);
        *(u32x4*)(rowptr(n0 + n) + k0 + 8 * c) = o; }
    LDS_WAIT(); asm volatile("" ::: "memory");
}

__device__ __forceinline__ void p0_prologue(Frame& F, const Args& a) {
    LAS float* scr = (LAS float*)(F.lds + F.wave * 16384);
    const int gw = F.vcu * 8 + F.wave, NGW = F.G * 8;
    bf16_t* Wb = (bf16_t*)(F.ws + WS_W);
    constexpr int I_IN = (DM / 64) * (NIN / 32), I_OA = (512 / 64) * (DM / 32), I_OL = (DM / 64) * (DM / 32), I_RG = (256 / 64) * (256 / 32);
    constexpr int PER_LAYER = I_IN + I_OA + 2 * I_OL + 16 * I_RG;
    for (int it = gw; it < DEPTH * PER_LAYER; it += NGW) {
        const int l = it / PER_LAYER; int r = it % PER_LAYER;
        if (r < I_IN) { bf16_t* dst = Wb + W_IN_T / 2 + (size_t)l * NIN * DM;
            p0_transpose_item(a.in[2] + (size_t)l * DM * NIN, DM, NIN, a.in[1] + l * DM, [=](int n) { return dst + (size_t)n * DM; }, scr, r, F.lane); continue; } r -= I_IN;
        if (r < I_OA) { bf16_t* dst = Wb + W_OATT_T / 2 + (size_t)l * DM * 512;
            p0_transpose_item(a.in[11] + (size_t)l * 512 * DM, 512, DM, nullptr, [=](int n) { return dst + (size_t)n * 512; }, scr, r, F.lane); continue; } r -= I_OA;
        if (r < I_OL) { bf16_t* dst = Wb + W_OLRU_T / 2 + (size_t)l * DM * DM;
            p0_transpose_item(a.in[12] + (size_t)l * DM * DM, DM, DM, nullptr, [=](int n) { return dst + (size_t)n * DM; }, scr, r, F.lane); continue; } r -= I_OL;
        if (r < I_OL) { bf16_t* dst = Wb + W_OUT_T / 2 + (size_t)l * DM * DM;
            p0_transpose_item(a.in[13] + (size_t)l * DM * DM, DM, DM, nullptr, [=](int n) { return dst + (size_t)n * DM; }, scr, r, F.lane); continue; } r -= I_OL;
        {
            const int s = r / I_RG, item = r % I_RG, dir = s >> 3, kind = (s >> 2) & 1, n = s & 3;
            const float* src = (kind ? a.in[8] : a.in[6]) + ((size_t)((l * 2 + dir) * 4 + n)) * 65536;
            bf16_t* dst = Wb + W_RG_T / 2 + (size_t)(l * 4 + n) * 4 * 65536;
            p0_transpose_item(src, 256, 256, nullptr, [=](int j) { return dst + (size_t)(j >> 6) * 65536 + (size_t)(128 * dir + 32 * ((j >> 4) & 3) + 16 * kind + (j & 15)) * 256; }, scr, item, F.lane);
        }
    }
    const float* x = a.in[0]; bf16_t* XB = (bf16_t*)(F.ws + WS_XB); float* ss = (float*)(F.ctl + CW_SS);
    for (int m = gw; m < M; m += NGW) {
        const f32x4* xr = (const f32x4*)(x + (size_t)m * DM) + F.lane; float s = 0.f;
        unsigned long long* o8 = (unsigned long long*)(XB + (size_t)m * DM) + F.lane;
#pragma unroll
        for (int j = 0; j < 4; ++j) { const f32x4 v = xr[64 * j]; s += (v.x * v.x + v.y * v.y) + (v.z * v.z + v.w * v.w);
            o8[64 * j] = (unsigned long long)cvt_pk_bf16(v.x, v.y) | ((unsigned long long)cvt_pk_bf16(v.z, v.w) << 32); }
        s = wave_sum(s);
        if (F.lane == 0) ss[m] = s;
    }
}

struct EpiProjA {
    static constexpr bool PERM = true, AFTER_DRAIN = false;
    unsigned char* ws; const float* ss;
    __device__ __forceinline__ void operator()(const f32x4 (&acc)[2][2][4][2], const pg8::Unit& u, int wr, int wc, int fr, int fq) const {
        const int kind = u.pn / 6;
        float rs[2][4];
#pragma unroll
        for (int ai = 0; ai < 2; ++ai)
#pragma unroll
            for (int m = 0; m < 4; ++m) rs[ai][m] = ss[u.pm * 256 + ai * 128 + wr * 64 + m * 16 + fr];
#pragma unroll
        for (int ai = 0; ai < 2; ++ai)
#pragma unroll
            for (int m = 0; m < 4; ++m) {
                const int row = u.pm * 256 + ai * 128 + wr * 64 + m * 16 + fr;
                const float rstd = __builtin_amdgcn_rsqf(rs[ai][m] * (1.0f / DM) + NORM_EPS);
                if (kind < 3) {
                    const int b = row >> 13, p = row & 8191; const float sc = (kind == 0) ? rstd * QSCALE : rstd;
                    bf16_t* base = (bf16_t*)(ws + WS_Q + (size_t)kind * (WS_K - WS_Q));
#pragma unroll
                    for (int bj = 0; bj < 2; ++bj) {
                        const int hh = 2 * (u.pn - 6 * kind) + bj, sh = 2 * (hh >> 2);
                        const int rho = ((p & ((1 << sh) - 1)) << (13 - sh)) + (p >> sh);
                        bf16_t* dst = base + ((size_t)(b * NH + hh) * SEQ + rho) * HD + wc * 32 + 8 * fq;
                        const f32x4 v0 = acc[ai][bj][m][0] * sc, v1 = acc[ai][bj][m][1] * sc;
                        u32x4 w; w.x = cvt_pk_bf16(v0[0], v0[1]); w.y = cvt_pk_bf16(v0[2], v0[3]); w.z = cvt_pk_bf16(v1[0], v1[1]); w.w = cvt_pk_bf16(v1[2], v1[3]);
                        *(u32x4*)dst = w;
                    }
                } else {
#pragma unroll
                    for (int bj = 0; bj < 2; ++bj) {
                        bf16_t* dst = (bf16_t*)(ws + WS_SGA) + (size_t)row * 512 + (u.pn - 18) * 256 + bj * 128 + wc * 32 + 8 * fq;
                        const f32x4 v0 = acc[ai][bj][m][0] * rstd, v1 = acc[ai][bj][m][1] * rstd;
                        u32x4 w; w.x = cvt_pk_bf16(fast_silu(v0[0]), fast_silu(v0[1])); w.y = cvt_pk_bf16(fast_silu(v0[2]), fast_silu(v0[3]));
                        w.z = cvt_pk_bf16(fast_silu(v1[0]), fast_silu(v1[1])); w.w = cvt_pk_bf16(fast_silu(v1[2]), fast_silu(v1[3]));
                        *(u32x4*)dst = w;
                    }
                }
            }
    }
};
struct EpiProjB {
    static constexpr bool PERM = true, AFTER_DRAIN = false;
    unsigned char* ws; const float* ss; const float* bgate;
    __device__ __forceinline__ void operator()(const f32x4 (&acc)[2][2][4][2], const pg8::Unit& u, int wr, int wc, int fr, int fq) const {
        const int kind = u.pn < 4 ? 0 : (u.pn < 8 ? 1 : 2);
        f32x4 bv[2][2];
#pragma unroll
        for (int bj = 0; bj < 2; ++bj)
#pragma unroll
            for (int n = 0; n < 2; ++n) bv[bj][n] = (kind == 2) ? *(const f32x4*)(bgate + (u.pn - 8) * 256 + bj * 128 + wc * 32 + 8 * fq + 4 * n) : (f32x4){0.f, 0.f, 0.f, 0.f};
        float rs[2][4];
#pragma unroll
        for (int ai = 0; ai < 2; ++ai)
#pragma unroll
            for (int m = 0; m < 4; ++m) rs[ai][m] = ss[u.pm * 256 + ai * 128 + wr * 64 + m * 16 + fr];
#pragma unroll
        for (int ai = 0; ai < 2; ++ai)
#pragma unroll
            for (int m = 0; m < 4; ++m) {
                const int row = u.pm * 256 + ai * 128 + wr * 64 + m * 16 + fr;
                const float rstd = __builtin_amdgcn_rsqf(rs[ai][m] * (1.0f / DM) + NORM_EPS);
#pragma unroll
                for (int bj = 0; bj < 2; ++bj) {
                    const int cin = bj * 128 + wc * 32 + 8 * fq;
                    f32x4 v0 = acc[ai][bj][m][0] * rstd, v1 = acc[ai][bj][m][1] * rstd;
                    bf16_t* dst;
                    if (kind == 0) dst = (bf16_t*)(ws + WS_XLRU) + (size_t)row * DM + u.pn * 256 + cin;
                    else if (kind == 1) { dst = (bf16_t*)(ws + WS_SGL) + (size_t)row * DM + (u.pn - 4) * 256 + cin;
#pragma unroll
                        for (int e = 0; e < 4; ++e) { v0[e] = fast_silu(v0[e]); v1[e] = fast_silu(v1[e]); } }
                    else { dst = (bf16_t*)(ws + WS_GATE) + (size_t)row * 2048 + (u.pn - 8) * 256 + cin; v0 += bv[bj][0]; v1 += bv[bj][1];
#pragma unroll
                        for (int e = 0; e < 4; ++e) { v0[e] = fast_sigmoid(v0[e]); v1[e] = fast_sigmoid(v1[e]); } }
                    u32x4 w; w.x = cvt_pk_bf16(v0[0], v0[1]); w.y = cvt_pk_bf16(v0[2], v0[3]); w.z = cvt_pk_bf16(v1[0], v1[1]); w.w = cvt_pk_bf16(v1[2], v1[3]);
                    *(u32x4*)dst = w;
                }
            }
    }
};
template <bool FIRST> struct EpiMerge {
    static constexpr bool PERM = true, AFTER_DRAIN = false;
    bf16_t* MG; const bf16_t* GATE;
    __device__ __forceinline__ void operator()(const f32x4 (&acc)[2][2][4][2], const pg8::Unit& u, int wr, int wc, int fr, int fq) const {
#pragma unroll
        for (int ai = 0; ai < 2; ++ai) {
            u32x4 gw[4][2], pw[4][2];
#pragma unroll
            for (int m = 0; m < 4; ++m)
#pragma unroll
                for (int bj = 0; bj < 2; ++bj) {
                    const int row = u.pm * 256 + ai * 128 + wr * 64 + m * 16 + fr, col = u.pn * 256 + bj * 128 + wc * 32 + 8 * fq;
                    gw[m][bj] = *(const u32x4*)(GATE + (size_t)row * 2048 + col);
                    if (!FIRST) pw[m][bj] = *(const u32x4*)(MG + (size_t)row * DM + col);
                }
#pragma unroll
            for (int m = 0; m < 4; ++m)
#pragma unroll
                for (int bj = 0; bj < 2; ++bj) {
                    const int row = u.pm * 256 + ai * 128 + wr * 64 + m * 16 + fr, col = u.pn * 256 + bj * 128 + wc * 32 + 8 * fq;
                    const u32x4 g4 = gw[m][bj];
                    f32x4 v0 = acc[ai][bj][m][0], v1 = acc[ai][bj][m][1];
                    v0[0] *= bf_lo(g4.x); v0[1] *= bf_hi(g4.x); v0[2] *= bf_lo(g4.y); v0[3] *= bf_hi(g4.y);
                    v1[0] *= bf_lo(g4.z); v1[1] *= bf_hi(g4.z); v1[2] *= bf_lo(g4.w); v1[3] *= bf_hi(g4.w);
                    if (!FIRST) { const u32x4 p4 = pw[m][bj];
                        v0[0] += bf_lo(p4.x); v0[1] += bf_hi(p4.x); v0[2] += bf_lo(p4.y); v0[3] += bf_hi(p4.y);
                        v1[0] += bf_lo(p4.z); v1[1] += bf_hi(p4.z); v1[2] += bf_lo(p4.w); v1[3] += bf_hi(p4.w); }
                    u32x4 w; w.x = cvt_pk_bf16(v0[0], v0[1]); w.y = cvt_pk_bf16(v0[2], v0[3]); w.z = cvt_pk_bf16(v1[0], v1[1]); w.w = cvt_pk_bf16(v1[2], v1[3]);
                    *(u32x4*)(MG + (size_t)row * DM + col) = w;
                }
        }
    }
};
struct EpiResid {
    static constexpr bool PERM = false, AFTER_DRAIN = false;
    const float* xin; float* xout; bf16_t* XB; float* ssn;
    __device__ __forceinline__ void operator()(const f32x4 (&acc)[2][2][4][2], const pg8::Unit& u, int wr, int wc, int fr, int fq) const {
#pragma unroll
        for (int ai = 0; ai < 2; ++ai)
#pragma unroll
            for (int mp = 0; mp < 2; ++mp) {
                f32x4 xi[2][2][2];
#pragma unroll
                for (int mm = 0; mm < 2; ++mm)
#pragma unroll
                    for (int bj = 0; bj < 2; ++bj)
#pragma unroll
                        for (int n = 0; n < 2; ++n) {
                            const int row = u.pm * 256 + ai * 128 + wr * 64 + (mp * 2 + mm) * 16 + fr;
                            xi[mm][bj][n] = *(const f32x4*)(xin + (size_t)row * DM + u.pn * 256 + bj * 128 + wc * 32 + n * 16 + 4 * fq);
                        }
#pragma unroll
                for (int mm = 0; mm < 2; ++mm) {
                    const int m = mp * 2 + mm, row = u.pm * 256 + ai * 128 + wr * 64 + m * 16 + fr; float s = 0.f;
#pragma unroll
                    for (int bj = 0; bj < 2; ++bj)
#pragma unroll
                        for (int n = 0; n < 2; ++n) {
                            const size_t off = (size_t)row * DM + u.pn * 256 + bj * 128 + wc * 32 + n * 16 + 4 * fq;
                            const f32x4 v = xi[mm][bj][n] + acc[ai][bj][m][n];
                            *(f32x4*)(xout + off) = v;
                            u32x2 w; w.x = cvt_pk_bf16(v[0], v[1]); w.y = cvt_pk_bf16(v[2], v[3]); *(u32x2*)(XB + off) = w;
                            s += (v[0] * v[0] + v[1] * v[1]) + (v[2] * v[2] + v[3] * v[3]);
                        }
                    s += __shfl_xor(s, 16); s += __shfl_xor(s, 32);
                    if (fq == 0) atomicAdd(ssn + row, s);
                }
            }
    }
};

__device__ __forceinline__ void attn_naive(Frame& F) {
    bf16_t* Q = (bf16_t*)(F.ws + WS_Q); const bf16_t* Kb = (const bf16_t*)(F.ws + WS_K); const bf16_t* Vb = (const bf16_t*)(F.ws + WS_V);
    float* LSE = (float*)(F.ws + WS_LSE);
    const int gw = F.vcu * 8 + F.wave, NGW = F.G * 8, lane = F.lane;
    for (int item = gw; item < BATCH * NH * SEQ; item += NGW) {
        const int bh = item >> 13, rho = item & 8191, hh = bh % NH, sh = 2 * (hh >> 2), ng = SEQ >> sh;
        const int idx = rho & (ng - 1);
        const size_t rowq = (size_t)bh * SEQ + rho;
        const float slope2 = exp2f(-8.0f * (float)(hh + 1) / 12.0f) * (float)(1 << sh) * LOG2E;
        float s[3]; bool ok[3];
#pragma unroll
        for (int t = 0; t < 3; ++t) {
            const int j = lane - 64 + 64 * t; ok[t] = (j <= 64) && (idx + j >= 0) && (idx + j < ng); s[t] = -1e30f;
            if (ok[t]) {
                const u32x4* kp = (const u32x4*)(Kb + (rowq + j) * HD); const u32x4* qp = (const u32x4*)(Q + rowq * HD); float d = 0.f;
#pragma unroll 4
                for (int c = 0; c < 16; ++c) { const u32x4 kv = kp[c], qv = qp[c];
                    d += bf_lo(kv.x) * bf_lo(qv.x) + bf_hi(kv.x) * bf_hi(qv.x) + bf_lo(kv.y) * bf_lo(qv.y) + bf_hi(kv.y) * bf_hi(qv.y)
                       + bf_lo(kv.z) * bf_lo(qv.z) + bf_hi(kv.z) * bf_hi(qv.z) + bf_lo(kv.w) * bf_lo(qv.w) + bf_hi(kv.w) * bf_hi(qv.w); }
                s[t] = d - slope2 * fabsf((float)j);
            }
        }
        const float mx = wave_max(fmaxf(fmaxf(s[0], s[1]), s[2]));
        float p[3];
#pragma unroll
        for (int t = 0; t < 3; ++t) p[t] = ok[t] ? exp2f(s[t] - mx) : 0.f;
        const float den = wave_sum(p[0] + p[1] + p[2]);
        float o0 = 0.f, o1 = 0.f;
#pragma unroll
        for (int t = 0; t < 3; ++t)
            for (int src = 0; src < 64; ++src) {
                const int j = src - 64 + 64 * t; if (j > 64) break;
                if (idx + j < 0 || idx + j >= ng) continue;
                const float pj = __shfl(p[t], src);
                const unsigned vv = *(const unsigned*)(Vb + (rowq + j) * HD + 2 * lane);
                o0 += pj * bf_lo(vv); o1 += pj * bf_hi(vv);
            }
        const float inv = 1.0f / den;
        *(unsigned*)(Q + rowq * HD + 2 * lane) = cvt_pk_bf16(o0 * inv, o1 * inv);
        if (lane == 0) LSE[rowq] = mx + log2f(den);
    }
}

__device__ __forceinline__ void attn_mix(Frame& F, int pm, int slot) {
    const bf16_t* O = (const bf16_t*)(F.ws + WS_Q); const float* LSE = (const float*)(F.ws + WS_LSE); bf16_t* SGA = (bf16_t*)(F.ws + WS_SGA);
    for (int it = fresh(threadIdx.x); it < 256 * 16; it += 512) {
        const int row = pm * 256 + (it >> 4), ch = it & 15, b = row >> 13, p = row & 8191;
        float l[3]; u32x4 o[3];
#pragma unroll
        for (int g = 0; g < 3; ++g) { const int sh = 2 * g, hh = 4 * g + slot; const int rho = ((p & ((1 << sh) - 1)) << (13 - sh)) + (p >> sh);
            const size_t r = (size_t)(b * NH + hh) * SEQ + rho; l[g] = LSE[r]; o[g] = *(const u32x4*)(O + r * HD + 8 * ch); }
        const float mx = fmaxf(fmaxf(l[0], l[1]), l[2]);
        float w0 = exp2f(l[0] - mx), w1 = exp2f(l[1] - mx), w2 = exp2f(l[2] - mx); const float inv = 1.0f / (w0 + w1 + w2); w0 *= inv; w1 *= inv; w2 *= inv;
        bf16_t* dst = SGA + (size_t)row * 512 + slot * 128 + 8 * ch; const u32x4 sg = *(const u32x4*)dst;
        u32x4 y;
#define MIXW(f) { const float lo = (w0 * bf_lo(o[0].f) + w1 * bf_lo(o[1].f) + w2 * bf_lo(o[2].f)) * bf_lo(sg.f); const float hi = (w0 * bf_hi(o[0].f) + w1 * bf_hi(o[1].f) + w2 * bf_hi(o[2].f)) * bf_hi(sg.f); y.f = cvt_pk_bf16(lo, hi); }
        MIXW(x) MIXW(y) MIXW(z) MIXW(w)
#undef MIXW
        *(u32x4*)dst = y;
    }
}

__device__ __forceinline__ void lru_conv(Frame& F, int pm, int n, const float* conv_w, const float* conv_b) {
    const bf16_t* XL = (const bf16_t*)(F.ws + WS_XLRU); bf16_t* XC = (bf16_t*)(F.ws + WS_XB);
    for (int it = fresh(threadIdx.x); it < 256 * 32; it += 512) {
        const int row = pm * 256 + (it >> 5), c0 = n * 256 + (it & 31) * 8, t = row & 8191;
        float acc[8];
        { const f32x4 b0 = *(const f32x4*)(conv_b + c0), b1 = *(const f32x4*)(conv_b + c0 + 4); acc[0] = b0[0]; acc[1] = b0[1]; acc[2] = b0[2]; acc[3] = b0[3]; acc[4] = b1[0]; acc[5] = b1[1]; acc[6] = b1[2]; acc[7] = b1[3]; }
#pragma unroll
        for (int j = 0; j < 4; ++j) { const int tt = t + j - 2; if (tt < 0 || tt >= SEQ) continue;
            const u32x4 xv = *(const u32x4*)(XL + (size_t)(row + j - 2) * DM + c0);
            const f32x4 w0 = *(const f32x4*)(conv_w + j * DM + c0), w1 = *(const f32x4*)(conv_w + j * DM + c0 + 4);
            acc[0] += w0[0] * bf_lo(xv.x); acc[1] += w0[1] * bf_hi(xv.x); acc[2] += w0[2] * bf_lo(xv.y); acc[3] += w0[3] * bf_hi(xv.y);
            acc[4] += w1[0] * bf_lo(xv.z); acc[5] += w1[1] * bf_hi(xv.z); acc[6] += w1[2] * bf_lo(xv.w); acc[7] += w1[3] * bf_hi(xv.w); }
        u32x4 o; o.x = cvt_pk_bf16(acc[0], acc[1]); o.y = cvt_pk_bf16(acc[2], acc[3]); o.z = cvt_pk_bf16(acc[4], acc[5]); o.w = cvt_pk_bf16(acc[6], acc[7]);
        *(u32x4*)(XC + (size_t)row * DM + c0) = o;
    }
}
template <int PASS> struct EpiLru {
    static constexpr bool PERM = false, AFTER_DRAIN = true;
    const bf16_t* XC; const float *ba, *bx, *lam;
    float* TIL; const bf16_t* SGL; bf16_t* YL; int n, qq;
    __device__ __forceinline__ void fused(f32x4 (&acc)[2][2][4][2], const pg8::Unit& u, int wr, int wc, int fr, int fq, LAS unsigned char* lds, int wid, int lane) const {
        const int cu0 = 16 * wc + 4 * fq, ch0 = 256 * n + 64 * qq + cu0;
#pragma unroll
        for (int d = 0; d < 2; ++d) {
            float cba[4], cbx[4], c2[4];
            { const f32x4 a4 = *(const f32x4*)(ba + d * DM + ch0), x4 = *(const f32x4*)(bx + d * DM + ch0), l4 = *(const f32x4*)(lam + d * DM + ch0);
#pragma unroll
              for (int e = 0; e < 4; ++e) { cba[e] = a4[e]; cbx[e] = x4[e]; c2[e] = -8.0f * LOG2E * log1pf(expf(-l4[e])); } }
#pragma unroll
            for (int ai = 0; ai < 2; ++ai)
#pragma unroll
                for (int m = 0; m < 4; ++m) {
                    const int rl = ai * 128 + wr * 64 + m * 16 + fr, row = u.pm * 256 + rl, t = row & 8191;
                    const u32x2 xw = *(const u32x2*)(XC + (size_t)row * DM + ch0);
                    const float xc[4] = {bf_lo(xw.x), bf_hi(xw.x), bf_lo(xw.y), bf_hi(xw.y)};
                    const bool first = (d == 0) ? (t == 0) : (t == SEQ - 1);
                    u32x4 w;
#pragma unroll
                    for (int e = 0; e < 4; ++e) {
                        const float r = fast_sigmoid(acc[ai][d][m][0][e] + cba[e]), ig = fast_sigmoid(acc[ai][d][m][1][e] + cbx[e]);
                        const float l2a = r * c2[e];
                        const float a2 = __builtin_amdgcn_exp2f(2.0f * l2a);
                        const float mult = first ? 1.0f : __builtin_amdgcn_sqrtf(fmaxf(1.0f - a2, 0.0f));
                        w[e] = cvt_pk_bf16(l2a, mult * ig * xc[e]);
                    }
                    *(LAS u32x4*)(lds + rl * LRU_PITCH + d * 256 + cu0 * 4) = w;
                    __builtin_amdgcn_sched_barrier(0);
                }
        }
        LDS_WAIT(); __builtin_amdgcn_s_barrier(); asm volatile("" ::: "memory");
        const int tid = wid * 64 + lane, seg = tid >> 7, dir = (tid >> 6) & 1, cu = tid & 63, ch = 256 * n + 64 * qq + cu;
        LAS unsigned char* col = lds + dir * 256 + cu * 4;
        const int r0 = dir ? (seg * 64 + 63) : seg * 64, rstep = dir ? -LRU_PITCH : LRU_PITCH;
        float P = 1.0f, H = 0.0f;
        { LAS unsigned char* pp = col + r0 * LRU_PITCH;
#pragma unroll 8
          for (int i = 0; i < 64; ++i) { const unsigned w = *(LAS unsigned*)pp; pp += rstep; const float a = __builtin_amdgcn_exp2f(bf_lo(w)); H = a * H + bf_hi(w); P *= a; } }
        LAS f32x2* xch = (LAS f32x2*)(lds + LRU_XCH);
        xch[(dir * 4 + seg) * 64 + cu] = (f32x2){P, H};
        LDS_WAIT(); __builtin_amdgcn_s_barrier(); asm volatile("" ::: "memory");
        if constexpr (PASS == 1) {
            if (seg == 0) {
                float Pt = 1.0f, Ht = 0.0f;
#pragma unroll
                for (int s = 0; s < 4; ++s) { const f32x2 v = xch[(dir * 4 + (dir ? 3 - s : s)) * 64 + cu]; Ht = v.x * Ht + v.y; Pt *= v.x; }
                *(f32x2*)(TIL + ((size_t)(u.pm * 2 + dir) * DM + ch) * 2) = (f32x2){Pt, Ht};
            }
        } else {
            float h = 0.0f;
            const int pb = u.pm & ~31;
            if (dir == 0) { for (int q = pb; q < u.pm; ++q) { const f32x2 v = *(const f32x2*)(TIL + ((size_t)(q * 2 + 0) * DM + ch) * 2); h = v.x * h + v.y; } }
            else { for (int q = pb + 31; q > u.pm; --q) { const f32x2 v = *(const f32x2*)(TIL + ((size_t)(q * 2 + 1) * DM + ch) * 2); h = v.x * h + v.y; } }
            if (dir == 0) { for (int s = 0; s < seg; ++s) { const f32x2 v = xch[(0 * 4 + s) * 64 + cu]; h = v.x * h + v.y; } }
            else { for (int s = 3; s > seg; --s) { const f32x2 v = xch[(1 * 4 + s) * 64 + cu]; h = v.x * h + v.y; } }
            { LAS unsigned char* pp = col + r0 * LRU_PITCH;
#pragma unroll 8
              for (int i = 0; i < 64; ++i) { const unsigned w = *(LAS unsigned*)pp; const float a = __builtin_amdgcn_exp2f(bf_lo(w)); h = a * h + bf_hi(w); *(LAS float*)pp = h; pp += rstep; } }
            LDS_WAIT(); __builtin_amdgcn_s_barrier(); asm volatile("" ::: "memory");
            const int qd = tid & 15, rg = tid >> 4;
#pragma unroll 4
            for (int i = 0; i < 8; ++i) {
                const int rl = i * 32 + rg, row = u.pm * 256 + rl;
                const f32x4 hf = *(const LAS f32x4*)(lds + rl * LRU_PITCH + qd * 16), hb = *(const LAS f32x4*)(lds + rl * LRU_PITCH + 256 + qd * 16);
                const size_t off = (size_t)row * DM + 256 * n + 64 * qq + 4 * qd;
                const u32x2 sg = *(const u32x2*)(SGL + off);
                u32x2 y; y.x = cvt_pk_bf16((hf[0] + hb[0]) * bf_lo(sg.x), (hf[1] + hb[1]) * bf_hi(sg.x)); y.y = cvt_pk_bf16((hf[2] + hb[2]) * bf_lo(sg.y), (hf[3] + hb[3]) * bf_hi(sg.y));
                *(u32x2*)(YL + off) = y;
            }
        }
        LDS_WAIT(); __builtin_amdgcn_s_barrier(); asm volatile("" ::: "memory");
    }
};

__device__ __forceinline__ void final_norm(Frame& F, float* out, const float* ss, const float* g) {
    const int gw = F.vcu * 8 + F.wave, NGW = F.G * 8;
    f32x4 gv[4];
#pragma unroll
    for (int j = 0; j < 4; ++j) gv[j] = ((const f32x4*)g)[F.lane + 64 * j];
    for (int m = gw; m < M; m += NGW) {
        const float rstd = 1.0f / sqrtf(ss[m] * (1.0f / DM) + NORM_EPS);
        f32x4* xr = (f32x4*)(out + (size_t)m * DM) + F.lane;
#pragma unroll
        for (int j = 0; j < 4; ++j) { const f32x4 v = xr[64 * j]; xr[64 * j] = v * rstd * gv[j]; }
    }
}

constexpr int N_PHASES = 16;
__global__ void __launch_bounds__(512, 2) hybrid_fwd(Args args) {
    extern __shared__ __attribute__((aligned(16))) unsigned char lds_raw[];
    Frame F;
    F.lds = (LAS unsigned char*)lds_raw;
    F.tid = threadIdx.x; F.lane = F.tid & 63; F.wave = __builtin_amdgcn_readfirstlane(F.tid >> 6);
    F.G = gridDim.x; { const int bx = blockIdx.x; F.vcu = (F.G % 8 == 0) ? (bx % 8) * (F.G / 8) + bx / 8 : bx; }
    F.ws = args.ws; F.ctl = (unsigned*)(args.ws + WS_CTL);
    volatile LAS unsigned* MISC = (volatile LAS unsigned*)(F.lds + LDSCTL_OFF);
    if (F.tid < 64) MISC[F.tid] = 0u;
    __syncthreads();
    XcdBarrier bar; bar.bar = F.ctl + CW_BAR; bar.x = 0; bar.st = nullptr;
    if (MK_N_LAUNCHES == 1) bar = xcd_barrier_post(F.ctl + CW_BAR, MISC + 8);
    bf16_t* Wb = (bf16_t*)(F.ws + WS_W);
    float* ss = (float*)(F.ctl + CW_SS);

#ifndef PHMASK
#define PHMASK 0x3ff
#endif
    for (int ph = args.ph_lo; ph < args.ph_hi; ++ph) {
        { int tv = threadIdx.x; asm volatile("" : "+v"(tv)); F.tid = tv; F.lane = tv & 63; F.wave = __builtin_amdgcn_readfirstlane(tv >> 6); }
        if (ph == 0) { if (PHMASK & 1) p0_prologue(F, args); }
        else if (ph == 15) { if (PHMASK & 2) final_norm(F, args.out, ss + 2 * M, args.in[14]); }
        else {
            const int l = (ph - 1) / 7, sub = (ph - 1) % 7;
            const bf16_t* XB = (const bf16_t*)(F.ws + WS_XB);
            if (sub == 0 && (PHMASK & 4)) {
                pg8::Gemm g{XB, Wb + W_IN_T / 2 + (size_t)l * NIN * DM, DM, DM, DM};
                pg8::StaticOrder S; S.init(M, NCOL_A, F.G, (int)blockIdx.x, DM, DM);
                EpiProjA E{F.ws, ss + l * M};
                pg8::gemm_phase(fresh(threadIdx.x), F.lds, g, S, E);
            } else if (sub == 1 && (PHMASK & 8)) {
                attn_naive(F);
            } else if (sub == 2 && (PHMASK & 16)) {
                pg8::Gemm g{XB, Wb + W_IN_T / 2 + ((size_t)l * NIN + NCOL_A) * DM, DM, DM, DM};
                pg8::StaticOrder S; S.init(M, NCOL_B, F.G, (int)blockIdx.x, DM, DM);
                EpiProjB E{F.ws, ss + l * M, args.in[3] + l * 2048};
                pg8::gemm_phase(fresh(threadIdx.x), F.lds, g, S, E);
            } else if ((sub == 3 && (PHMASK & 32)) || (sub == 4 && (PHMASK & 64))) {
                for (int task = F.vcu; task < 256; task += F.G) {
                    const int pm = task >> 2, n = task & 3;
                    if (sub == 3) { lru_conv(F, pm, n, args.in[4] + l * 4 * DM, args.in[5] + l * DM); VM_WAIT(); __syncthreads(); }
                    for (int qq = 0; qq < 4; ++qq) {
                        pg8::Gemm g{XB, Wb + W_RG_T / 2, DM, 256, 256};
                        pg8::SingleUnit S; S.u0.pm = pm; S.u0.pn = qq; S.u0.abyte = (pm * 256 * DM + n * 256) * 2; S.u0.bbyte = ((l * 4 + n) * 4 + qq) * 65536 * 2;
                        if (sub == 3) { EpiLru<1> E{XB, args.in[7] + l * 2048, args.in[9] + l * 2048, args.in[10] + l * 2048, (float*)(F.ws + WS_TIL), nullptr, nullptr, n, qq}; pg8::gemm_phase(fresh(threadIdx.x), F.lds, g, S, E); }
                        else { EpiLru<2> E{XB, args.in[7] + l * 2048, args.in[9] + l * 2048, args.in[10] + l * 2048, (float*)(F.ws + WS_TIL), (const bf16_t*)(F.ws + WS_SGL), (bf16_t*)(F.ws + WS_XLRU), n, qq}; pg8::gemm_phase(fresh(threadIdx.x), F.lds, g, S, E); }
                    }
                    if (sub == 4) attn_mix(F, pm, n);
                }
            } else if (sub == 5 && (PHMASK & 128)) {
                { pg8::Gemm g{(const bf16_t*)(F.ws + WS_SGA), Wb + W_OATT_T / 2 + (size_t)l * DM * 512, 512, 512, 512};
                  pg8::StaticOrder S; S.init(M, DM, F.G, (int)blockIdx.x, 512, 512);
                  EpiMerge<true> E{(bf16_t*)(F.ws + WS_Q), (const bf16_t*)(F.ws + WS_GATE)};
                  pg8::gemm_phase(fresh(threadIdx.x), F.lds, g, S, E); }
                VM_WAIT(); __syncthreads();
                { pg8::Gemm g{(const bf16_t*)(F.ws + WS_XLRU), Wb + W_OLRU_T / 2 + (size_t)l * DM * DM, DM, DM, DM};
                  pg8::StaticOrder S; S.init(M, DM, F.G, (int)blockIdx.x, DM, DM);
                  EpiMerge<false> E{(bf16_t*)(F.ws + WS_Q), (const bf16_t*)(F.ws + WS_GATE) + 1024};
                  pg8::gemm_phase(fresh(threadIdx.x), F.lds, g, S, E); }
            } else if (sub == 6 && (PHMASK & 256)) {
                pg8::Gemm g{(const bf16_t*)(F.ws + WS_Q), Wb + W_OUT_T / 2 + (size_t)l * DM * DM, DM, DM, DM};
                pg8::StaticOrder S; S.init(M, DM, F.G, (int)blockIdx.x, DM, DM);
                EpiResid E{l == 0 ? args.in[0] : args.out, args.out, (bf16_t*)(F.ws + WS_XB), ss + (l + 1) * M};
                pg8::gemm_phase(fresh(threadIdx.x), F.lds, g, S, E);
            }
        }
        if (ph + 1 < args.ph_hi) xcd_barrier(bar);
    }
}

extern "C" void kernel_launch(void* const* d_in, const int* in_sizes, int n_in, void* d_out, int out_size, void* d_ws, size_t ws_size, hipStream_t stream) {
    static int grid = 0;
    if (grid == 0) {
        if (n_in != 15 || in_sizes[0] != M * DM || out_size != M * DM || ws_size < WS_END) { fprintf(stderr, "kernel_launch: unexpected shapes / workspace (%d inputs, ws %zu < %zu)\n", n_in, ws_size, (size_t)WS_END); grid = -1; return; }
        int dev = 0, cus = 0, per_cu = 0;
        if (hipGetDevice(&dev) != hipSuccess || hipDeviceGetAttribute(&cus, hipDeviceAttributeMultiprocessorCount, dev) != hipSuccess) { grid = -1; return; }
        if (hipFuncSetAttribute((const void*)hybrid_fwd, hipFuncAttributeMaxDynamicSharedMemorySize, LDS_BYTES) != hipSuccess) { fprintf(stderr, "kernel_launch: hipFuncSetAttribute failed\n"); grid = -1; return; }
        if (hipOccupancyMaxActiveBlocksPerMultiprocessor(&per_cu, (const void*)hybrid_fwd, 512, LDS_BYTES) != hipSuccess || per_cu < 1) { fprintf(stderr, "kernel_launch: occupancy query says %d\n", per_cu); grid = -1; return; }
        (void)hipGetLastError();
        grid = cus;
    }
    if (grid < 0) return;
    (void)hipMemsetAsync((char*)d_ws + WS_CTL, 0, CTL_ZERO_BYTES, stream);
    Args a{};
    for (int i = 0; i < 15; ++i) a.in[i] = (const float*)d_in[i];
    a.out = (float*)d_out; a.ws = (unsigned char*)d_ws;
    if (MK_N_LAUNCHES == 1) { a.ph_lo = 0; a.ph_hi = N_PHASES; a.li = 0; hipLaunchKernelGGL(hybrid_fwd, dim3(grid), dim3(512), LDS_BYTES, stream, a); }
    else for (int ph = 0; ph < N_PHASES; ++ph) { a.ph_lo = ph; a.ph_hi = ph + 1; a.li = ph; hipLaunchKernelGGL(hybrid_fwd, dim3(grid), dim3(512), LDS_BYTES, stream, a); }
}
```

```cpp
#include <hip/hip_runtime.h>
#include <cstdio>
#include <cstdint>

#ifndef MK_N_LAUNCHES
#define MK_N_LAUNCHES 1
#endif

#define LAS __attribute__((address_space(3)))
#define GAS __attribute__((address_space(1)))
typedef unsigned short bf16_t;
typedef short bf16x8 __attribute__((ext_vector_type(8)));
typedef float f32x4 __attribute__((ext_vector_type(4)));
typedef float f32x2 __attribute__((ext_vector_type(2)));
typedef unsigned u32x4 __attribute__((ext_vector_type(4)));
typedef unsigned u32x2 __attribute__((ext_vector_type(2)));

constexpr int BATCH = 2, SEQ = 8192, DM = 1024, M = BATCH * SEQ, DEPTH = 2;
constexpr int NIN = 9216, NH = 12, HD = 128;
constexpr int NCOL_A = 5120, NCOL_B = 4096;
constexpr float LOG2E = 1.4426950408889634f;
constexpr float QSCALE = 0.08838834764831845f * LOG2E;
constexpr float NORM_EPS = 1e-6f;

constexpr size_t MiB = 1u << 20;
constexpr size_t WS_CTL = 0, CTL_ZERO_BYTES = 1 * MiB;
constexpr size_t WS_LSE = 1 * MiB;
constexpr size_t WS_TIL = 2 * MiB;
constexpr size_t WS_W   = 8 * MiB;
constexpr size_t W_IN_T = 0;
constexpr size_t W_OATT_T = W_IN_T + (size_t)2 * NIN * DM * 2;
constexpr size_t W_OLRU_T = W_OATT_T + (size_t)2 * DM * 512 * 2;
constexpr size_t W_OUT_T  = W_OLRU_T + (size_t)2 * DM * DM * 2;
constexpr size_t W_RG_T   = W_OUT_T + (size_t)2 * DM * DM * 2;
constexpr size_t W_END    = W_RG_T + (size_t)2 * 16 * 65536 * 2;
static_assert(W_END == 50 * MiB, "weight map");
constexpr size_t WS_XB  = 58 * MiB;
constexpr size_t WS_Q   = 90 * MiB;
constexpr size_t WS_K   = 138 * MiB;
constexpr size_t WS_V   = 186 * MiB;
constexpr size_t WS_XLRU = WS_K;
constexpr size_t WS_SGL  = WS_K + 32 * MiB;
constexpr size_t WS_GATE = WS_K + 64 * MiB;
constexpr size_t WS_SGA  = 266 * MiB;
constexpr size_t WS_END  = 282 * MiB;
static_assert(WS_V - WS_K == WS_K - WS_Q, "q/k/v spacing");
constexpr int CW_BAR = 4096;
constexpr int CW_SS = 65536;
static_assert((CW_SS + 3 * M) * 4 <= (int)CTL_ZERO_BYTES, "ctl");

constexpr int RING_BYTES = 131072;
constexpr int LRU_PITCH = 528;
constexpr int LRU_IMG = 256 * LRU_PITCH;
constexpr int LRU_XCH = LRU_IMG;
constexpr int LDSCTL_OFF = 147456;
constexpr int LDS_BYTES = 148480;
static_assert(LRU_XCH + 4096 <= LDSCTL_OFF, "lds");

#define RLX_AGENT __ATOMIC_RELAXED, __HIP_MEMORY_SCOPE_AGENT
#define LDS_WAIT() asm volatile("s_waitcnt lgkmcnt(0)" ::: "memory")
#define VM_WAIT() asm volatile("s_waitcnt vmcnt(0)" ::: "memory")

__device__ __forceinline__ unsigned cvt_pk_bf16(float lo, float hi) { unsigned r; asm volatile("v_cvt_pk_bf16_f32 %0, %1, %2" : "=v"(r) : "v"(lo), "v"(hi)); return r; }
__device__ __forceinline__ float bf_lo(unsigned w) { return __uint_as_float(w << 16); }
__device__ __forceinline__ float bf_hi(unsigned w) { return __uint_as_float(w & 0xffff0000u); }
__device__ __forceinline__ float fast_sigmoid(float v) { return __builtin_amdgcn_rcpf(1.0f + __builtin_amdgcn_exp2f(-LOG2E * v)); }
__device__ __forceinline__ float fast_silu(float v) { return v * fast_sigmoid(v); }

namespace pg8 {
constexpr int BM = 256, BK = 64, HALF = 128, HTB = HALF * BK * 2, STAGE_BYTES = 8 * HTB, NXCD = 8, WGM = 8;
__host__ __device__ __forceinline__ int lds_byte(int r, int c) { const int st = (r >> 4) * 2 + (c >> 5), rr = r & 15, cc = c & 31, ob = rr * 64 + cc * 2; return st * 1024 + (ob ^ (((ob >> 9) & 1) << 5)); }
__host__ __device__ __forceinline__ void stage_rc(int b, int& R, int& C) { const int st = b / 1024, sb = b % 1024, swz = sb ^ (((sb >> 9) & 1) << 5); R = (st >> 1) * 16 + swz / 64; C = (st & 1) * 32 + (swz % 64) / 2; }
__host__ __device__ __forceinline__ int perm32(int rho) { const int n = rho >> 4, i = rho & 15; return 8 * (i >> 2) + 4 * n + (i & 3); }

struct Unit { int pm, pn; int abyte, bbyte; };
struct Gemm { const bf16_t* A; const bf16_t* Bt; int lda, ldb, K; };

struct StaticOrder {
    int nM, nN, nwg, G, c, ta, tb;
    __device__ void init(int Mr, int N, int G_, int c_, int lda, int ldb) { nM = Mr / BM; nN = N / BM; nwg = nM * nN; G = G_; c = c_; ta = BM * lda * 2; tb = BM * ldb * 2; }
    __device__ bool next(int i, Unit& u) const {
        const long L = (long)i * G + c; if (L >= nwg) return false;
        int wgid = (int)L; { const int q = nwg / NXCD, r = nwg % NXCD, xcd = wgid % NXCD, off = wgid / NXCD; wgid = (xcd < r ? xcd * (q + 1) : r * (q + 1) + (xcd - r) * q) + off; }
        const int nig = WGM * nN, gid = wgid / nig, fm = gid * WGM, gsz = (nM - fm) < WGM ? (nM - fm) : WGM;
        u.pm = fm + ((wgid % nig) % gsz); u.pn = (wgid % nig) / gsz; u.abyte = u.pm * ta; u.bbyte = u.pn * tb; return true;
    }
};
struct SingleUnit {
    Unit u0;
    __device__ bool next(int i, Unit& u) const { if (i != 0) return false; u = u0; return true; }
};

template <class Epi, class Sched>
__device__ __forceinline__ void gemm_phase(int tid_in, LAS unsigned char* lds, const Gemm g, const Sched& S, const Epi& E) {
    int tid = tid_in; asm volatile("" : "+v"(tid));
    const int wid = __builtin_amdgcn_readfirstlane(tid >> 6), lane = tid & 63, wr = wid >> 2, wc = wid & 3, fr = lane & 15, fq = lane >> 4;
    const int K = g.K, nt = K / BK;
    unsigned voffA[2], voffB[2];
#pragma unroll
    for (int i = 0; i < 2; ++i) { int R, C; stage_rc(tid * 16 + i * 8192, R, C); const int Rb = Epi::PERM ? ((R & ~31) + perm32(R & 31)) : R;
        voffA[i] = (unsigned)(R * g.lda + C) * 2u; voffB[i] = (unsigned)(Rb * g.ldb + C) * 2u; }
    const int kstep = BK * 2;
    const int hstepA = HALF * g.lda * 2, hstepB = HALF * g.ldb * 2;
    const __amdgpu_buffer_rsrc_t rsA = __builtin_amdgcn_make_buffer_rsrc((void*)g.A, 0, 0x7ffffff0, 0x00020000);
    const __amdgpu_buffer_rsrc_t rsB = __builtin_amdgcn_make_buffer_rsrc((void*)g.Bt, 0, 0x7ffffff0, 0x00020000);
    const unsigned ldsw = (unsigned)wid * 1024u;
    const int aoff = lds_byte(wr * 64 + fr, fq * 8), boff = lds_byte(wc * 32 + fr, fq * 8);
#define PG8_SA(b, h) (((b) * 2 + (h)) * HTB)
#define PG8_SB(b, h) ((4 + (b) * 2 + (h)) * HTB)
#define PG8_STAGEA(bufoff, soff) do { _Pragma("unroll") for (int _i = 0; _i < 2; ++_i) \
        __builtin_amdgcn_raw_ptr_buffer_load_lds(rsA, (LAS void*)(lds + (bufoff) + ldsw + _i * 8192), 16, (int)voffA[_i], (soff), 0, 0); } while (0)
#define PG8_STAGEB(bufoff, soff) do { _Pragma("unroll") for (int _i = 0; _i < 2; ++_i) \
        __builtin_amdgcn_raw_ptr_buffer_load_lds(rsB, (LAS void*)(lds + (bufoff) + ldsw + _i * 8192), 16, (int)voffB[_i], (soff), 0, 0); } while (0)
#define PG8_LDA(dst, b, h) do { _Pragma("unroll") for (int m = 0; m < 4; ++m) _Pragma("unroll") for (int k = 0; k < 2; ++k) dst[m][k] = *(const LAS bf16x8*)(lds + PG8_SA(b, h) + aoff + m * 2048 + k * 1024); } while (0)
#define PG8_LDB(dst, b, h) do { _Pragma("unroll") for (int n = 0; n < 2; ++n) _Pragma("unroll") for (int k = 0; k < 2; ++k) dst[n][k] = *(const LAS bf16x8*)(lds + PG8_SB(b, h) + boff + n * 2048 + k * 1024); } while (0)
#define PG8_MMA(ai, bj, At, Bt) do { __builtin_amdgcn_s_setprio(1); _Pragma("unroll") for (int m = 0; m < 4; ++m) _Pragma("unroll") for (int n = 0; n < 2; ++n) _Pragma("unroll") for (int k = 0; k < 2; ++k) \
        acc[ai][bj][m][n] = __builtin_amdgcn_mfma_f32_16x16x32_bf16(Bt[n][k], At[m][k], acc[ai][bj][m][n], 0, 0, 0); __builtin_amdgcn_s_setprio(0); } while (0)
#define PG8_WAIT_V(n) asm volatile("s_waitcnt vmcnt(" #n ")" ::: "memory")
#define PG8_WAIT_L(n) asm volatile("s_waitcnt lgkmcnt(" #n ")" ::: "memory")
#define PG8_BAR __builtin_amdgcn_s_barrier()
#define PG8_SCHED __builtin_amdgcn_sched_barrier(0)
    Unit cur, nxt; int ui = 0;
    if (!S.next(0, cur)) return;
    f32x4 acc[2][2][4][2];
#pragma unroll
    for (int a = 0; a < 2; ++a)
#pragma unroll
        for (int b = 0; b < 2; ++b)
#pragma unroll
            for (int m = 0; m < 4; ++m)
#pragma unroll
                for (int n = 0; n < 2; ++n) acc[a][b][m][n] = (f32x4){0.f, 0.f, 0.f, 0.f};
    bf16x8 At[4][2], B0[2][2], B1[2][2];
    int cA = cur.abyte, cB = cur.bbyte;
    PG8_STAGEB(PG8_SB(0, 0), cB); PG8_STAGEB(PG8_SB(0, 1), cB + hstepB); PG8_STAGEA(PG8_SA(0, 0), cA); PG8_STAGEA(PG8_SA(0, 1), cA + hstepA);
    if (wr == 1) PG8_BAR;
    PG8_WAIT_V(2); PG8_BAR;
    PG8_STAGEB(PG8_SB(1, 0), cB + kstep); PG8_STAGEA(PG8_SA(1, 0), cA + kstep); PG8_STAGEB(PG8_SB(1, 1), cB + hstepB + kstep);
    PG8_WAIT_V(6); PG8_BAR;
    for (;;) {
        const bool has_next = S.next(ui + 1, nxt);
        const int nA = has_next ? nxt.abyte : cA, nB = has_next ? nxt.bbyte : cB;
#pragma unroll 1
        for (int t = 0; t < nt; t += 2) {
            const bool last = (t == nt - 2);
            const int a1 = cA + (t + 1) * kstep;
            const int a2 = last ? nA : cA + (t + 2) * kstep, b2 = last ? nB : cB + (t + 2) * kstep;
            const int a3 = a2 + kstep, b3 = b2 + kstep;
            PG8_LDB(B0, 0, 0); PG8_LDB(B1, 0, 1); PG8_SCHED; PG8_LDA(At, 0, 0); PG8_STAGEA(PG8_SA(1, 1), a1 + hstepA);
            PG8_WAIT_V(8); PG8_WAIT_L(0); PG8_BAR; PG8_MMA(0, 0, At, B0); PG8_MMA(0, 1, At, B1); PG8_BAR; PG8_SCHED;
            PG8_LDA(At, 0, 1); PG8_STAGEB(PG8_SB(0, 0), b2); PG8_STAGEB(PG8_SB(0, 1), b2 + hstepB); PG8_STAGEA(PG8_SA(0, 0), a2);
            PG8_WAIT_V(8); PG8_WAIT_L(0); PG8_BAR; PG8_MMA(1, 0, At, B0); PG8_MMA(1, 1, At, B1); PG8_BAR; PG8_SCHED;
            PG8_LDB(B0, 1, 0); PG8_LDB(B1, 1, 1); PG8_SCHED; PG8_LDA(At, 1, 0); PG8_STAGEA(PG8_SA(0, 1), a2 + hstepA);
            PG8_WAIT_V(8); PG8_WAIT_L(0); PG8_BAR; PG8_MMA(0, 0, At, B0); PG8_MMA(0, 1, At, B1); PG8_BAR; PG8_SCHED;
            PG8_LDA(At, 1, 1); PG8_STAGEB(PG8_SB(1, 0), b3); PG8_STAGEB(PG8_SB(1, 1), b3 + hstepB); PG8_STAGEA(PG8_SA(1, 0), a3);
            PG8_WAIT_V(8); PG8_WAIT_L(0); PG8_BAR; PG8_MMA(1, 0, At, B0); PG8_MMA(1, 1, At, B1); PG8_BAR; PG8_SCHED;
        }
        if constexpr (!Epi::AFTER_DRAIN) { if (wr == 0) PG8_BAR; int l2 = lane; asm volatile("" : "+v"(l2)); int w2 = wid; asm volatile("" : "+s"(w2)); E(acc, cur, w2 >> 2, w2 & 3, l2 & 15, l2 >> 4); }
        if (!has_next) break;
#pragma unroll
        for (int a = 0; a < 2; ++a)
#pragma unroll
            for (int b = 0; b < 2; ++b)
#pragma unroll
                for (int m = 0; m < 4; ++m)
#pragma unroll
                    for (int n = 0; n < 2; ++n) acc[a][b][m][n] = (f32x4){0.f, 0.f, 0.f, 0.f};
        cur = nxt; cA = nA; cB = nB; ++ui;
        if constexpr (!Epi::AFTER_DRAIN) { if (wr == 1) PG8_BAR; }
    }
    PG8_WAIT_V(0);
    if constexpr (Epi::AFTER_DRAIN) { if (wr == 0) PG8_BAR; }
    PG8_BAR;
    if constexpr (Epi::AFTER_DRAIN) { int l2 = lane; asm volatile("" : "+v"(l2)); int w2 = wid; asm volatile("" : "+s"(w2)); E.fused(acc, cur, w2 >> 2, w2 & 3, l2 & 15, l2 >> 4, lds, w2, l2); }
#undef PG8_SA
#undef PG8_SB
#undef PG8_STAGEA
#undef PG8_STAGEB
#undef PG8_LDA
#undef PG8_LDB
#undef PG8_MMA
#undef PG8_WAIT_V
#undef PG8_WAIT_L
#undef PG8_BAR
#undef PG8_SCHED
}
}

#define XB_TMO      128
#define XB_XCNT(j)  (256  + 64 * (j))
#define XB_XSUB(j)  (1280 + 64 * (j))
#define XB_XGEN(j)  (2304 + 64 * (j))
#define XB_TOP      3328
#define XB_TOPGEN   3392
#define XCD_BAR_WORDS 3456
#define XB_SPIN_CAP (1u << 18)
__device__ __forceinline__ unsigned xb_ld(unsigned* p)              { return __hip_atomic_load(p, __ATOMIC_RELAXED, __HIP_MEMORY_SCOPE_AGENT); }
__device__ __forceinline__ unsigned xb_add(unsigned* p, unsigned v) { return __hip_atomic_fetch_add(p, v, __ATOMIC_RELAXED, __HIP_MEMORY_SCOPE_AGENT); }
__device__ __forceinline__ unsigned xb_xcc_id() { return (unsigned)__builtin_amdgcn_s_getreg((3 << 11) | 20) & 0xFu; }
#define XB_SPIN(cond, bar) do { unsigned _sp = 0; while (cond) { __builtin_amdgcn_s_sleep(1); \
    if ((++_sp & 255u) == 0u) { if (xb_ld(&(bar)[XB_TMO])) break; if (_sp > XB_SPIN_CAP) { atomicAdd(&(bar)[XB_TMO], 1u); break; } } } } while (0)
struct XcdBarrier { unsigned* bar; unsigned x; volatile LAS unsigned* st; };
__device__ __forceinline__ XcdBarrier xcd_barrier_post(unsigned* bar, volatile LAS unsigned* st) {
    XcdBarrier b; b.bar = bar; b.x = xb_xcc_id(); b.st = st;
    if (threadIdx.x == 0) (void)xb_add(&bar[XB_XCNT(b.x)], 1u);
    return b;
}
__device__ __forceinline__ void xcd_barrier_complete(unsigned* bar, unsigned x, unsigned& nloc, unsigned& nx) {
    const unsigned G = gridDim.x * gridDim.y * gridDim.z;
    unsigned sum, cnt, mine, sp = 0u;
    for (;;) {
        sum = 0u; cnt = 0u; mine = 0u;
#pragma unroll
        for (unsigned j = 0; j < 16; ++j) { const unsigned c = xb_ld(&bar[XB_XCNT(j)]); sum += c; cnt += (c > 0u) ? 1u : 0u; mine = (j == x) ? c : mine; }
        if (sum == G) break;
        __builtin_amdgcn_s_sleep(1);
        if ((++sp & 255u) == 0u) { if (xb_ld(&bar[XB_TMO])) break; if (sp > XB_SPIN_CAP) { atomicAdd(&bar[XB_TMO], 1u); break; } }
    }
    nloc = mine > 0u ? mine : 1u; nx = cnt > 0u ? cnt : 1u;
}
__device__ __forceinline__ void xcd_barrier(const XcdBarrier& b) {
    asm volatile("s_waitcnt vmcnt(0)" ::: "memory");
    __syncthreads();
    if (threadIdx.x == 0) {
        unsigned* bar = b.bar;
        __builtin_amdgcn_s_waitcnt(0);
        unsigned nloc = b.st[0], nx = b.st[1];
        if (nloc == 0u) { xcd_barrier_complete(bar, b.x, nloc, nx); b.st[0] = nloc; b.st[1] = nx; }
        const unsigned old = xb_add(&bar[XB_XSUB(b.x)], 1u);
        const unsigned gen = old / nloc;
        if (old + 1u == (gen + 1u) * nloc) {
            __builtin_amdgcn_fence(__ATOMIC_RELEASE, "agent");
            asm volatile("s_waitcnt vmcnt(0)" ::: "memory");
            const unsigned og = xb_add(&bar[XB_TOP], 1u);
            const unsigned tg = og / nx;
            if (og + 1u == (tg + 1u) * nx) xb_add(&bar[XB_TOPGEN], 1u);
            else XB_SPIN(xb_ld(&bar[XB_TOPGEN]) == tg, bar);
            __builtin_amdgcn_fence(__ATOMIC_ACQUIRE, "agent");
            xb_add(&bar[XB_XGEN(b.x)], 1u);
            asm volatile("s_waitcnt vmcnt(0)" ::: "memory");
        } else {
            XB_SPIN(xb_ld(&bar[XB_XGEN(b.x)]) == gen, bar);
            __builtin_amdgcn_fence(__ATOMIC_ACQUIRE, "agent");
            asm volatile("s_waitcnt vmcnt(0)" ::: "memory");
        }
    }
    __syncthreads();
}

struct Frame {
    LAS unsigned char* lds;
    unsigned* ctl;
    int tid, lane, wave, vcu, G;
    unsigned char* ws;
};
struct Args { const float* in[15]; float* out; unsigned char* ws; int ph_lo, ph_hi, li, pad; };

__device__ __forceinline__ int fresh(int v) { asm volatile("" : "+v"(v)); return v; }
__device__ __forceinline__ float wave_sum(float v) {
#pragma unroll
    for (int o = 1; o < 64; o <<= 1) v += __shfl_xor(v, o);
    return v;
}
__device__ __forceinline__ float wave_max(float v) {
#pragma unroll
    for (int o = 1; o < 64; o <<= 1) v = fmaxf(v, __shfl_xor(v, o));
    return v;
}

template <class RowFn>
__device__ __forceinline__ void p0_transpose_item(const float* W, int K, int N, const float* kscale, const RowFn& rowptr, LAS float* scr, int item, int lane) {
    const int nblk = N / 32, kb = item / nblk, nb = item % nblk, k0 = 64 * kb, n0 = 32 * nb;
#pragma unroll 8
    for (int i = 0; i < 32; ++i) { const int kk = 2 * i + (lane >> 5); const float sc = kscale ? kscale[k0 + kk] : 1.0f; scr[kk * 33 + (lane & 31)] = W[(size_t)(k0 + kk) * N + n0 + (lane & 31)] * sc; }
    LDS_WAIT(); asm volatile("" ::: "memory");
    const int c = lane & 7;
#pragma unroll
    for (int j = 0; j < 4; ++j) { const int n = (lane >> 3) + 8 * j; const LAS float* s = scr + (8 * c) * 33 + n;
        u32x4 o; o.x = cvt_pk_bf16(s[0 * 33], s[1 * 33]); o.y = cvt_pk_bf16(s[2 * 33], s[3 * 33]); o.z = cvt_pk_bf16(s[4 * 33], s[5 * 33]); o.w = cvt_pk_bf16(s[6 * 33], s[7 * 33]);
        *(u32x4*)(rowptr(n0 + n) + k0 + 8 * c) = o; }
    LDS_WAIT(); asm volatile("" ::: "memory");
}

__device__ __forceinline__ void p0_prologue(Frame& F, const Args& a) {
    LAS float* scr = (LAS float*)(F.lds + F.wave * 16384);
    const int gw = F.vcu * 8 + F.wave, NGW = F.G * 8;
    bf16_t* Wb = (bf16_t*)(F.ws + WS_W);
    constexpr int I_IN = (DM / 64) * (NIN / 32), I_OA = (512 / 64) * (DM / 32), I_OL = (DM / 64) * (DM / 32), I_RG = (256 / 64) * (256 / 32);
    constexpr int PER_LAYER = I_IN + I_OA + 2 * I_OL + 16 * I_RG;
    for (int it = gw; it < DEPTH * PER_LAYER; it += NGW) {
        const int l = it / PER_LAYER; int r = it % PER_LAYER;
        if (r < I_IN) { bf16_t* dst = Wb + W_IN_T / 2 + (size_t)l * NIN * DM;
            p0_transpose_item(a.in[2] + (size_t)l * DM * NIN, DM, NIN, a.in[1] + l * DM, [=](int n) { return dst + (size_t)n * DM; }, scr, r, F.lane); continue; } r -= I_IN;
        if (r < I_OA) { bf16_t* dst = Wb + W_OATT_T / 2 + (size_t)l * DM * 512;
            p0_transpose_item(a.in[11] + (size_t)l * 512 * DM, 512, DM, nullptr, [=](int n) { return dst + (size_t)n * 512; }, scr, r, F.lane); continue; } r -= I_OA;
        if (r < I_OL) { bf16_t* dst = Wb + W_OLRU_T / 2 + (size_t)l * DM * DM;
            p0_transpose_item(a.in[12] + (size_t)l * DM * DM, DM, DM, nullptr, [=](int n) { return dst + (size_t)n * DM; }, scr, r, F.lane); continue; } r -= I_OL;
        if (r < I_OL) { bf16_t* dst = Wb + W_OUT_T / 2 + (size_t)l * DM * DM;
            p0_transpose_item(a.in[13] + (size_t)l * DM * DM, DM, DM, nullptr, [=](int n) { return dst + (size_t)n * DM; }, scr, r, F.lane); continue; } r -= I_OL;
        {
            const int s = r / I_RG, item = r % I_RG, dir = s >> 3, kind = (s >> 2) & 1, n = s & 3;
            const float* src = (kind ? a.in[8] : a.in[6]) + ((size_t)((l * 2 + dir) * 4 + n)) * 65536;
            bf16_t* dst = Wb + W_RG_T / 2 + (size_t)(l * 4 + n) * 4 * 65536;
            p0_transpose_item(src, 256, 256, nullptr, [=](int j) { return dst + (size_t)(j >> 6) * 65536 + (size_t)(128 * dir + 32 * ((j >> 4) & 3) + 16 * kind + (j & 15)) * 256; }, scr, item, F.lane);
        }
    }
    const float* x = a.in[0]; bf16_t* XB = (bf16_t*)(F.ws + WS_XB); float* ss = (float*)(F.ctl + CW_SS);
    for (int m = gw; m < M; m += NGW) {
        const f32x4* xr = (const f32x4*)(x + (size_t)m * DM) + F.lane; float s = 0.f;
        unsigned long long* o8 = (unsigned long long*)(XB + (size_t)m * DM) + F.lane;
#pragma unroll
        for (int j = 0; j < 4; ++j) { const f32x4 v = xr[64 * j]; s += (v.x * v.x + v.y * v.y) + (v.z * v.z + v.w * v.w);
            o8[64 * j] = (unsigned long long)cvt_pk_bf16(v.x, v.y) | ((unsigned long long)cvt_pk_bf16(v.z, v.w) << 32); }
        s = wave_sum(s);
        if (F.lane == 0) ss[m] = s;
    }
}

struct EpiProjA {
    static constexpr bool PERM = true, AFTER_DRAIN = false;
    unsigned char* ws; const float* ss;
    __device__ __forceinline__ void operator()(const f32x4 (&acc)[2][2][4][2], const pg8::Unit& u, int wr, int wc, int fr, int fq) const {
        const int kind = u.pn / 6;
        float rs[2][4];
#pragma unroll
        for (int ai = 0; ai < 2; ++ai)
#pragma unroll
            for (int m = 0; m < 4; ++m) rs[ai][m] = ss[u.pm * 256 + ai * 128 + wr * 64 + m * 16 + fr];
#pragma unroll
        for (int ai = 0; ai < 2; ++ai)
#pragma unroll
            for (int m = 0; m < 4; ++m) {
                const int row = u.pm * 256 + ai * 128 + wr * 64 + m * 16 + fr;
                const float rstd = __builtin_amdgcn_rsqf(rs[ai][m] * (1.0f / DM) + NORM_EPS);
                if (kind < 3) {
                    const int b = row >> 13, p = row & 8191; const float sc = (kind == 0) ? rstd * QSCALE : rstd;
                    bf16_t* base = (bf16_t*)(ws + WS_Q + (size_t)kind * (WS_K - WS_Q));
#pragma unroll
                    for (int bj = 0; bj < 2; ++bj) {
                        const int hh = 2 * (u.pn - 6 * kind) + bj, sh = 2 * (hh >> 2);
                        const int rho = ((p & ((1 << sh) - 1)) << (13 - sh)) + (p >> sh);
                        bf16_t* dst = base + ((size_t)(b * NH + hh) * SEQ + rho) * HD + wc * 32 + 8 * fq;
                        const f32x4 v0 = acc[ai][bj][m][0] * sc, v1 = acc[ai][bj][m][1] * sc;
                        u32x4 w; w.x = cvt_pk_bf16(v0[0], v0[1]); w.y = cvt_pk_bf16(v0[2], v0[3]); w.z = cvt_pk_bf16(v1[0], v1[1]); w.w = cvt_pk_bf16(v1[2], v1[3]);
                        *(u32x4*)dst = w;
                    }
                } else {
#pragma unroll
                    for (int bj = 0; bj < 2; ++bj) {
                        bf16_t* dst = (bf16_t*)(ws + WS_SGA) + (size_t)row * 512 + (u.pn - 18) * 256 + bj * 128 + wc * 32 + 8 * fq;
                        const f32x4 v0 = acc[ai][bj][m][0] * rstd, v1 = acc[ai][bj][m][1] * rstd;
                        u32x4 w; w.x = cvt_pk_bf16(fast_silu(v0[0]), fast_silu(v0[1])); w.y = cvt_pk_bf16(fast_silu(v0[2]), fast_silu(v0[3]));
                        w.z = cvt_pk_bf16(fast_silu(v1[0]), fast_silu(v1[1])); w.w = cvt_pk_bf16(fast_silu(v1[2]), fast_silu(v1[3]));
                        *(u32x4*)dst = w;
                    }
                }
            }
    }
};
struct EpiProjB {
    static constexpr bool PERM = true, AFTER_DRAIN = false;
    unsigned char* ws; const float* ss; const float* bgate;
    __device__ __forceinline__ void operator()(const f32x4 (&acc)[2][2][4][2], const pg8::Unit& u, int wr, int wc, int fr, int fq) const {
        const int kind = u.pn < 4 ? 0 : (u.pn < 8 ? 1 : 2);
        f32x4 bv[2][2];
#pragma unroll
        for (int bj = 0; bj < 2; ++bj)
#pragma unroll
            for (int n = 0; n < 2; ++n) bv[bj][n] = (kind == 2) ? *(const f32x4*)(bgate + (u.pn - 8) * 256 + bj * 128 + wc * 32 + 8 * fq + 4 * n) : (f32x4){0.f, 0.f, 0.f, 0.f};
        float rs[2][4];
#pragma unroll
        for (int ai = 0; ai < 2; ++ai)
#pragma unroll
            for (int m = 0; m < 4; ++m) rs[ai][m] = ss[u.pm * 256 + ai * 128 + wr * 64 + m * 16 + fr];
#pragma unroll
        for (int ai = 0; ai < 2; ++ai)
#pragma unroll
            for (int m = 0; m < 4; ++m) {
                const int row = u.pm * 256 + ai * 128 + wr * 64 + m * 16 + fr;
                const float rstd = __builtin_amdgcn_rsqf(rs[ai][m] * (1.0f / DM) + NORM_EPS);
#pragma unroll
                for (int bj = 0; bj < 2; ++bj) {
                    const int cin = bj * 128 + wc * 32 + 8 * fq;
                    f32x4 v0 = acc[ai][bj][m][0] * rstd, v1 = acc[ai][bj][m][1] * rstd;
                    bf16_t* dst;
                    if (kind == 0) dst = (bf16_t*)(ws + WS_XLRU) + (size_t)row * DM + u.pn * 256 + cin;
                    else if (kind == 1) { dst = (bf16_t*)(ws + WS_SGL) + (size_t)row * DM + (u.pn - 4) * 256 + cin;
#pragma unroll
                        for (int e = 0; e < 4; ++e) { v0[e] = fast_silu(v0[e]); v1[e] = fast_silu(v1[e]); } }
                    else { dst = (bf16_t*)(ws + WS_GATE) + (size_t)row * 2048 + (u.pn - 8) * 256 + cin; v0 += bv[bj][0]; v1 += bv[bj][1];
#pragma unroll
                        for (int e = 0; e < 4; ++e) { v0[e] = fast_sigmoid(v0[e]); v1[e] = fast_sigmoid(v1[e]); } }
                    u32x4 w; w.x = cvt_pk_bf16(v0[0], v0[1]); w.y = cvt_pk_bf16(v0[2], v0[3]); w.z = cvt_pk_bf16(v1[0], v1[1]); w.w = cvt_pk_bf16(v1[2], v1[3]);
                    *(u32x4*)dst = w;
                }
            }
    }
};
template <bool FIRST> struct EpiMerge {
    static constexpr bool PERM = true, AFTER_DRAIN = false;
    bf16_t* MG; const bf16_t* GATE;
    __device__ __forceinline__ void operator()(const f32x4 (&acc)[2][2][4][2], const pg8::Unit& u, int wr, int wc, int fr, int fq) const {
#pragma unroll
        for (int ai = 0; ai < 2; ++ai) {
            u32x4 gw[4][2], pw[4][2];
#pragma unroll
            for (int m = 0; m < 4; ++m)
#pragma unroll
                for (int bj = 0; bj < 2; ++bj) {
                    const int row = u.pm * 256 + ai * 128 + wr * 64 + m * 16 + fr, col = u.pn * 256 + bj * 128 + wc * 32 + 8 * fq;
                    gw[m][bj] = *(const u32x4*)(GATE + (size_t)row * 2048 + col);
                    if (!FIRST) pw[m][bj] = *(const u32x4*)(MG + (size_t)row * DM + col);
                }
#pragma unroll
            for (int m = 0; m < 4; ++m)
#pragma unroll
                for (int bj = 0; bj < 2; ++bj) {
                    const int row = u.pm * 256 + ai * 128 + wr * 64 + m * 16 + fr, col = u.pn * 256 + bj * 128 + wc * 32 + 8 * fq;
                    const u32x4 g4 = gw[m][bj];
                    f32x4 v0 = acc[ai][bj][m][0], v1 = acc[ai][bj][m][1];
                    v0[0] *= bf_lo(g4.x); v0[1] *= bf_hi(g4.x); v0[2] *= bf_lo(g4.y); v0[3] *= bf_hi(g4.y);
                    v1[0] *= bf_lo(g4.z); v1[1] *= bf_hi(g4.z); v1[2] *= bf_lo(g4.w); v1[3] *= bf_hi(g4.w);
                    if (!FIRST) { const u32x4 p4 = pw[m][bj];
                        v0[0] += bf_lo(p4.x); v0[1] += bf_hi(p4.x); v0[2] += bf_lo(p4.y); v0[3] += bf_hi(p4.y);
                        v1[0] += bf_lo(p4.z); v1[1] += bf_hi(p4.z); v1[2] += bf_lo(p4.w); v1[3] += bf_hi(p4.w); }
                    u32x4 w; w.x = cvt_pk_bf16(v0[0], v0[1]); w.y = cvt_pk_bf16(v0[2], v0[3]); w.z = cvt_pk_bf16(v1[0], v1[1]); w.w = cvt_pk_bf16(v1[2], v1[3]);
                    *(u32x4*)(MG + (size_t)row * DM + col) = w;
                }
        }
    }
};
struct EpiResid {
    static constexpr bool PERM = false, AFTER_DRAIN = false;
    const float* xin; float* xout; bf16_t* XB; float* ssn;
    __device__ __forceinline__ void operator()(const f32x4 (&acc)[2][2][4][2], const pg8::Unit& u, int wr, int wc, int fr, int fq) const {
#pragma unroll
        for (int ai = 0; ai < 2; ++ai)
#pragma unroll
            for (int mp = 0; mp < 2; ++mp) {
                f32x4 xi[2][2][2];
#pragma unroll
                for (int mm = 0; mm < 2; ++mm)
#pragma unroll
                    for (int bj = 0; bj < 2; ++bj)
#pragma unroll
                        for (int n = 0; n < 2; ++n) {
                            const int row = u.pm * 256 + ai * 128 + wr * 64 + (mp * 2 + mm) * 16 + fr;
                            xi[mm][bj][n] = *(const f32x4*)(xin + (size_t)row * DM + u.pn * 256 + bj * 128 + wc * 32 + n * 16 + 4 * fq);
                        }
#pragma unroll
                for (int mm = 0; mm < 2; ++mm) {
                    const int m = mp * 2 + mm, row = u.pm * 256 + ai * 128 + wr * 64 + m * 16 + fr; float s = 0.f;
#pragma unroll
                    for (int bj = 0; bj < 2; ++bj)
#pragma unroll
                        for (int n = 0; n < 2; ++n) {
                            const size_t off = (size_t)row * DM + u.pn * 256 + bj * 128 + wc * 32 + n * 16 + 4 * fq;
                            const f32x4 v = xi[mm][bj][n] + acc[ai][bj][m][n];
                            *(f32x4*)(xout + off) = v;
                            u32x2 w; w.x = cvt_pk_bf16(v[0], v[1]); w.y = cvt_pk_bf16(v[2], v[3]); *(u32x2*)(XB + off) = w;
                            s += (v[0] * v[0] + v[1] * v[1]) + (v[2] * v[2] + v[3] * v[3]);
                        }
                    s += __shfl_xor(s, 16); s += __shfl_xor(s, 32);
                    if (fq == 0) atomicAdd(ssn + row, s);
                }
            }
    }
};

__device__ __forceinline__ void attn_naive(Frame& F) {
    bf16_t* Q = (bf16_t*)(F.ws + WS_Q); const bf16_t* Kb = (const bf16_t*)(F.ws + WS_K); const bf16_t* Vb = (const bf16_t*)(F.ws + WS_V);
    float* LSE = (float*)(F.ws + WS_LSE);
    const int gw = F.vcu * 8 + F.wave, NGW = F.G * 8, lane = F.lane;
    for (int item = gw; item < BATCH * NH * SEQ; item += NGW) {
        const int bh = item >> 13, rho = item & 8191, hh = bh % NH, sh = 2 * (hh >> 2), ng = SEQ >> sh;
        const int idx = rho & (ng - 1);
        const size_t rowq = (size_t)bh * SEQ + rho;
        const float slope2 = exp2f(-8.0f * (float)(hh + 1) / 12.0f) * (float)(1 << sh) * LOG2E;
        float s[3]; bool ok[3];
#pragma unroll
        for (int t = 0; t < 3; ++t) {
            const int j = lane - 64 + 64 * t; ok[t] = (j <= 64) && (idx + j >= 0) && (idx + j < ng); s[t] = -1e30f;
            if (ok[t]) {
                const u32x4* kp = (const u32x4*)(Kb + (rowq + j) * HD); const u32x4* qp = (const u32x4*)(Q + rowq * HD); float d = 0.f;
#pragma unroll 4
                for (int c = 0; c < 16; ++c) { const u32x4 kv = kp[c], qv = qp[c];
                    d += bf_lo(kv.x) * bf_lo(qv.x) + bf_hi(kv.x) * bf_hi(qv.x) + bf_lo(kv.y) * bf_lo(qv.y) + bf_hi(kv.y) * bf_hi(qv.y)
                       + bf_lo(kv.z) * bf_lo(qv.z) + bf_hi(kv.z) * bf_hi(qv.z) + bf_lo(kv.w) * bf_lo(qv.w) + bf_hi(kv.w) * bf_hi(qv.w); }
                s[t] = d - slope2 * fabsf((float)j);
            }
        }
        const float mx = wave_max(fmaxf(fmaxf(s[0], s[1]), s[2]));
        float p[3];
#pragma unroll
        for (int t = 0; t < 3; ++t) p[t] = ok[t] ? exp2f(s[t] - mx) : 0.f;
        const float den = wave_sum(p[0] + p[1] + p[2]);
        float o0 = 0.f, o1 = 0.f;
#pragma unroll
        for (int t = 0; t < 3; ++t)
            for (int src = 0; src < 64; ++src) {
                const int j = src - 64 + 64 * t; if (j > 64) break;
                if (idx + j < 0 || idx + j >= ng) continue;
                const float pj = __shfl(p[t], src);
                const unsigned vv = *(const unsigned*)(Vb + (rowq + j) * HD + 2 * lane);
                o0 += pj * bf_lo(vv); o1 += pj * bf_hi(vv);
            }
        const float inv = 1.0f / den;
        *(unsigned*)(Q + rowq * HD + 2 * lane) = cvt_pk_bf16(o0 * inv, o1 * inv);
        if (lane == 0) LSE[rowq] = mx + log2f(den);
    }
}

__device__ __forceinline__ void attn_mix(Frame& F, int pm, int slot) {
    const bf16_t* O = (const bf16_t*)(F.ws + WS_Q); const float* LSE = (const float*)(F.ws + WS_LSE); bf16_t* SGA = (bf16_t*)(F.ws + WS_SGA);
    for (int it = fresh(threadIdx.x); it < 256 * 16; it += 512) {
        const int row = pm * 256 + (it >> 4), ch = it & 15, b = row >> 13, p = row & 8191;
        float l[3]; u32x4 o[3];
#pragma unroll
        for (int g = 0; g < 3; ++g) { const int sh = 2 * g, hh = 4 * g + slot; const int rho = ((p & ((1 << sh) - 1)) << (13 - sh)) + (p >> sh);
            const size_t r = (size_t)(b * NH + hh) * SEQ + rho; l[g] = LSE[r]; o[g] = *(const u32x4*)(O + r * HD + 8 * ch); }
        const float mx = fmaxf(fmaxf(l[0], l[1]), l[2]);
        float w0 = exp2f(l[0] - mx), w1 = exp2f(l[1] - mx), w2 = exp2f(l[2] - mx); const float inv = 1.0f / (w0 + w1 + w2); w0 *= inv; w1 *= inv; w2 *= inv;
        bf16_t* dst = SGA + (size_t)row * 512 + slot * 128 + 8 * ch; const u32x4 sg = *(const u32x4*)dst;
        u32x4 y;
#define MIXW(f) { const float lo = (w0 * bf_lo(o[0].f) + w1 * bf_lo(o[1].f) + w2 * bf_lo(o[2].f)) * bf_lo(sg.f); const float hi = (w0 * bf_hi(o[0].f) + w1 * bf_hi(o[1].f) + w2 * bf_hi(o[2].f)) * bf_hi(sg.f); y.f = cvt_pk_bf16(lo, hi); }
        MIXW(x) MIXW(y) MIXW(z) MIXW(w)
#undef MIXW
        *(u32x4*)dst = y;
    }
}

__device__ __forceinline__ void lru_conv(Frame& F, int pm, int n, const float* conv_w, const float* conv_b) {
    const bf16_t* XL = (const bf16_t*)(F.ws + WS_XLRU); bf16_t* XC = (bf16_t*)(F.ws + WS_XB);
    for (int it = fresh(threadIdx.x); it < 256 * 32; it += 512) {
        const int row = pm * 256 + (it >> 5), c0 = n * 256 + (it & 31) * 8, t = row & 8191;
        float acc[8];
        { const f32x4 b0 = *(const f32x4*)(conv_b + c0), b1 = *(const f32x4*)(conv_b + c0 + 4); acc[0] = b0[0]; acc[1] = b0[1]; acc[2] = b0[2]; acc[3] = b0[3]; acc[4] = b1[0]; acc[5] = b1[1]; acc[6] = b1[2]; acc[7] = b1[3]; }
#pragma unroll
        for (int j = 0; j < 4; ++j) { const int tt = t + j - 2; if (tt < 0 || tt >= SEQ) continue;
            const u32x4 xv = *(const u32x4*)(XL + (size_t)(row + j - 2) * DM + c0);
            const f32x4 w0 = *(const f32x4*)(conv_w + j * DM + c0), w1 = *(const f32x4*)(conv_w + j * DM + c0 + 4);
            acc[0] += w0[0] * bf_lo(xv.x); acc[1] += w0[1] * bf_hi(xv.x); acc[2] += w0[2] * bf_lo(xv.y); acc[3] += w0[3] * bf_hi(xv.y);
            acc[4] += w1[0] * bf_lo(xv.z); acc[5] += w1[1] * bf_hi(xv.z); acc[6] += w1[2] * bf_lo(xv.w); acc[7] += w1[3] * bf_hi(xv.w); }
        u32x4 o; o.x = cvt_pk_bf16(acc[0], acc[1]); o.y = cvt_pk_bf16(acc[2], acc[3]); o.z = cvt_pk_bf16(acc[4], acc[5]); o.w = cvt_pk_bf16(acc[6], acc[7]);
        *(u32x4*)(XC + (size_t)row * DM + c0) = o;
    }
}
template <int PASS> struct EpiLru {
    static constexpr bool PERM = false, AFTER_DRAIN = true;
    const bf16_t* XC; const float *ba, *bx, *lam;
    float* TIL; const bf16_t* SGL; bf16_t* YL; int n, qq;
    __device__ __forceinline__ void fused(f32x4 (&acc)[2][2][4][2], const pg8::Unit& u, int wr, int wc, int fr, int fq, LAS unsigned char* lds, int wid, int lane) const {
        const int cu0 = 16 * wc + 4 * fq, ch0 = 256 * n + 64 * qq + cu0;
#pragma unroll
        for (int d = 0; d < 2; ++d) {
            float cba[4], cbx[4], c2[4];
            { const f32x4 a4 = *(const f32x4*)(ba + d * DM + ch0), x4 = *(const f32x4*)(bx + d * DM + ch0), l4 = *(const f32x4*)(lam + d * DM + ch0);
#pragma unroll
              for (int e = 0; e < 4; ++e) { cba[e] = a4[e]; cbx[e] = x4[e]; c2[e] = -8.0f * LOG2E * log1pf(expf(-l4[e])); } }
#pragma unroll
            for (int ai = 0; ai < 2; ++ai)
#pragma unroll
                for (int m = 0; m < 4; ++m) {
                    const int rl = ai * 128 + wr * 64 + m * 16 + fr, row = u.pm * 256 + rl, t = row & 8191;
                    const u32x2 xw = *(const u32x2*)(XC + (size_t)row * DM + ch0);
                    const float xc[4] = {bf_lo(xw.x), bf_hi(xw.x), bf_lo(xw.y), bf_hi(xw.y)};
                    const bool first = (d == 0) ? (t == 0) : (t == SEQ - 1);
                    u32x4 w;
#pragma unroll
                    for (int e = 0; e < 4; ++e) {
                        const float r = fast_sigmoid(acc[ai][d][m][0][e] + cba[e]), ig = fast_sigmoid(acc[ai][d][m][1][e] + cbx[e]);
                        const float l2a = r * c2[e];
                        const float a2 = __builtin_amdgcn_exp2f(2.0f * l2a);
                        const float mult = first ? 1.0f : __builtin_amdgcn_sqrtf(fmaxf(1.0f - a2, 0.0f));
                        w[e] = cvt_pk_bf16(l2a, mult * ig * xc[e]);
                    }
                    *(LAS u32x4*)(lds + rl * LRU_PITCH + d * 256 + cu0 * 4) = w;
                    __builtin_amdgcn_sched_barrier(0);
                }
        }
        LDS_WAIT(); __builtin_amdgcn_s_barrier(); asm volatile("" ::: "memory");
        const int tid = wid * 64 + lane, seg = tid >> 7, dir = (tid >> 6) & 1, cu = tid & 63, ch = 256 * n + 64 * qq + cu;
        LAS unsigned char* col = lds + dir * 256 + cu * 4;
        const int r0 = dir ? (seg * 64 + 63) : seg * 64, rstep = dir ? -LRU_PITCH : LRU_PITCH;
        float P = 1.0f, H = 0.0f;
        { LAS unsigned char* pp = col + r0 * LRU_PITCH;
#pragma unroll 8
          for (int i = 0; i < 64; ++i) { const unsigned w = *(LAS unsigned*)pp; pp += rstep; const float a = __builtin_amdgcn_exp2f(bf_lo(w)); H = a * H + bf_hi(w); P *= a; } }
        LAS f32x2* xch = (LAS f32x2*)(lds + LRU_XCH);
        xch[(dir * 4 + seg) * 64 + cu] = (f32x2){P, H};
        LDS_WAIT(); __builtin_amdgcn_s_barrier(); asm volatile("" ::: "memory");
        if constexpr (PASS == 1) {
            if (seg == 0) {
                float Pt = 1.0f, Ht = 0.0f;
#pragma unroll
                for (int s = 0; s < 4; ++s) { const f32x2 v = xch[(dir * 4 + (dir ? 3 - s : s)) * 64 + cu]; Ht = v.x * Ht + v.y; Pt *= v.x; }
                *(f32x2*)(TIL + ((size_t)(u.pm * 2 + dir) * DM + ch) * 2) = (f32x2){Pt, Ht};
            }
        } else {
            float h = 0.0f;
            const int pb = u.pm & ~31;
            if (dir == 0) { for (int q = pb; q < u.pm; ++q) { const f32x2 v = *(const f32x2*)(TIL + ((size_t)(q * 2 + 0) * DM + ch) * 2); h = v.x * h + v.y; } }
            else { for (int q = pb + 31; q > u.pm; --q) { const f32x2 v = *(const f32x2*)(TIL + ((size_t)(q * 2 + 1) * DM + ch) * 2); h = v.x * h + v.y; } }
            if (dir == 0) { for (int s = 0; s < seg; ++s) { const f32x2 v = xch[(0 * 4 + s) * 64 + cu]; h = v.x * h + v.y; } }
            else { for (int s = 3; s > seg; --s) { const f32x2 v = xch[(1 * 4 + s) * 64 + cu]; h = v.x * h + v.y; } }
            { LAS unsigned char* pp = col + r0 * LRU_PITCH;
#pragma unroll 8
              for (int i = 0; i < 64; ++i) { const unsigned w = *(LAS unsigned*)pp; const float a = __builtin_amdgcn_exp2f(bf_lo(w)); h = a * h + bf_hi(w); *(LAS float*)pp = h; pp += rstep; } }
            LDS_WAIT(); __builtin_amdgcn_s_barrier(); asm volatile("" ::: "memory");
            const int qd = tid & 15, rg = tid >> 4;
#pragma unroll 4
            for (int i = 0; i < 8; ++i) {
                const int rl = i * 32 + rg, row = u.pm * 256 + rl;
                const f32x4 hf = *(const LAS f32x4*)(lds + rl * LRU_PITCH + qd * 16), hb = *(const LAS f32x4*)(lds + rl * LRU_PITCH + 256 + qd * 16);
                const size_t off = (size_t)row * DM + 256 * n + 64 * qq + 4 * qd;
                const u32x2 sg = *(const u32x2*)(SGL + off);
                u32x2 y; y.x = cvt_pk_bf16((hf[0] + hb[0]) * bf_lo(sg.x), (hf[1] + hb[1]) * bf_hi(sg.x)); y.y = cvt_pk_bf16((hf[2] + hb[2]) * bf_lo(sg.y), (hf[3] + hb[3]) * bf_hi(sg.y));
                *(u32x2*)(YL + off) = y;
            }
        }
        LDS_WAIT(); __builtin_amdgcn_s_barrier(); asm volatile("" ::: "memory");
    }
};

__device__ __forceinline__ void final_norm(Frame& F, float* out, const float* ss, const float* g) {
    const int gw = F.vcu * 8 + F.wave, NGW = F.G * 8;
    f32x4 gv[4];
#pragma unroll
    for (int j = 0; j < 4; ++j) gv[j] = ((const f32x4*)g)[F.lane + 64 * j];
    for (int m = gw; m < M; m += NGW) {
        const float rstd = 1.0f / sqrtf(ss[m] * (1.0f / DM) + NORM_EPS);
        f32x4* xr = (f32x4*)(out + (size_t)m * DM) + F.lane;
#pragma unroll
        for (int j = 0; j < 4; ++j) { const f32x4 v = xr[64 * j]; xr[64 * j] = v * rstd * gv[j]; }
    }
}

constexpr int N_PHASES = 16;
__global__ void __launch_bounds__(512, 2) hybrid_fwd(Args args) {
    extern __shared__ __attribute__((aligned(16))) unsigned char lds_raw[];
    Frame F;
    F.lds = (LAS unsigned char*)lds_raw;
    F.tid = threadIdx.x; F.lane = F.tid & 63; F.wave = __builtin_amdgcn_readfirstlane(F.tid >> 6);
    F.G = gridDim.x; { const int bx = blockIdx.x; F.vcu = (F.G % 8 == 0) ? (bx % 8) * (F.G / 8) + bx / 8 : bx; }
    F.ws = args.ws; F.ctl = (unsigned*)(args.ws + WS_CTL);
    volatile LAS unsigned* MISC = (volatile LAS unsigned*)(F.lds + LDSCTL_OFF);
    if (F.tid < 64) MISC[F.tid] = 0u;
    __syncthreads();
    XcdBarrier bar; bar.bar = F.ctl + CW_BAR; bar.x = 0; bar.st = nullptr;
    if (MK_N_LAUNCHES == 1) bar = xcd_barrier_post(F.ctl + CW_BAR, MISC + 8);
    bf16_t* Wb = (bf16_t*)(F.ws + WS_W);
    float* ss = (float*)(F.ctl + CW_SS);

#ifndef PHMASK
#define PHMASK 0x3ff
#endif
    for (int ph = args.ph_lo; ph < args.ph_hi; ++ph) {
        { int tv = threadIdx.x; asm volatile("" : "+v"(tv)); F.tid = tv; F.lane = tv & 63; F.wave = __builtin_amdgcn_readfirstlane(tv >> 6); }
        if (ph == 0) { if (PHMASK & 1) p0_prologue(F, args); }
        else if (ph == 15) { if (PHMASK & 2) final_norm(F, args.out, ss + 2 * M, args.in[14]); }
        else {
            const int l = (ph - 1) / 7, sub = (ph - 1) % 7;
            const bf16_t* XB = (const bf16_t*)(F.ws + WS_XB);
            if (sub == 0 && (PHMASK & 4)) {
                pg8::Gemm g{XB, Wb + W_IN_T / 2 + (size_t)l * NIN * DM, DM, DM, DM};
                pg8::StaticOrder S; S.init(M, NCOL_A, F.G, (int)blockIdx.x, DM, DM);
                EpiProjA E{F.ws, ss + l * M};
                pg8::gemm_phase(fresh(threadIdx.x), F.lds, g, S, E);
            } else if (sub == 1 && (PHMASK & 8)) {
                attn_naive(F);
            } else if (sub == 2 && (PHMASK & 16)) {
                pg8::Gemm g{XB, Wb + W_IN_T / 2 + ((size_t)l * NIN + NCOL_A) * DM, DM, DM, DM};
                pg8::StaticOrder S; S.init(M, NCOL_B, F.G, (int)blockIdx.x, DM, DM);
                EpiProjB E{F.ws, ss + l * M, args.in[3] + l * 2048};
                pg8::gemm_phase(fresh(threadIdx.x), F.lds, g, S, E);
            } else if ((sub == 3 && (PHMASK & 32)) || (sub == 4 && (PHMASK & 64))) {
                for (int task = F.vcu; task < 256; task += F.G) {
                    const int pm = task >> 2, n = task & 3;
                    if (sub == 3) { lru_conv(F, pm, n, args.in[4] + l * 4 * DM, args.in[5] + l * DM); VM_WAIT(); __syncthreads(); }
                    for (int qq = 0; qq < 4; ++qq) {
                        pg8::Gemm g{XB, Wb + W_RG_T / 2, DM, 256, 256};
                        pg8::SingleUnit S; S.u0.pm = pm; S.u0.pn = qq; S.u0.abyte = (pm * 256 * DM + n * 256) * 2; S.u0.bbyte = ((l * 4 + n) * 4 + qq) * 65536 * 2;
                        if (sub == 3) { EpiLru<1> E{XB, args.in[7] + l * 2048, args.in[9] + l * 2048, args.in[10] + l * 2048, (float*)(F.ws + WS_TIL), nullptr, nullptr, n, qq}; pg8::gemm_phase(fresh(threadIdx.x), F.lds, g, S, E); }
                        else { EpiLru<2> E{XB, args.in[7] + l * 2048, args.in[9] + l * 2048, args.in[10] + l * 2048, (float*)(F.ws + WS_TIL), (const bf16_t*)(F.ws + WS_SGL), (bf16_t*)(F.ws + WS_XLRU), n, qq}; pg8::gemm_phase(fresh(threadIdx.x), F.lds, g, S, E); }
                    }
                    if (sub == 4) attn_mix(F, pm, n);
                }
            } else if (sub == 5 && (PHMASK & 128)) {
                { pg8::Gemm g{(const bf16_t*)(F.ws + WS_SGA), Wb + W_OATT_T / 2 + (size_t)l * DM * 512, 512, 512, 512};
                  pg8::StaticOrder S; S.init(M, DM, F.G, (int)blockIdx.x, 512, 512);
                  EpiMerge<true> E{(bf16_t*)(F.ws + WS_Q), (const bf16_t*)(F.ws + WS_GATE)};
                  pg8::gemm_phase(fresh(threadIdx.x), F.lds, g, S, E); }
                VM_WAIT(); __syncthreads();
                { pg8::Gemm g{(const bf16_t*)(F.ws + WS_XLRU), Wb + W_OLRU_T / 2 + (size_t)l * DM * DM, DM, DM, DM};
                  pg8::StaticOrder S; S.init(M, DM, F.G, (int)blockIdx.x, DM, DM);
                  EpiMerge<false> E{(bf16_t*)(F.ws + WS_Q), (const bf16_t*)(F.ws + WS_GATE) + 1024};
                  pg8::gemm_phase(fresh(threadIdx.x), F.lds, g, S, E); }
            } else if (sub == 6 && (PHMASK & 256)) {
                pg8::Gemm g{(const bf16_t*)(F.ws + WS_Q), Wb + W_OUT_T / 2 + (size_t)l * DM * DM, DM, DM, DM};
                pg8::StaticOrder S; S.init(M, DM, F.G, (int)blockIdx.x, DM, DM);
                EpiResid E{l == 0 ? args.in[0] : args.out, args.out, (bf16_t*)(F.ws + WS_XB), ss + (l + 1) * M};
                pg8::gemm_phase(fresh(threadIdx.x), F.lds, g, S, E);
            }
        }
        if (ph + 1 < args.ph_hi) xcd_barrier(bar);
    }
}

extern "C" void kernel_launch(void* const* d_in, const int* in_sizes, int n_in, void* d_out, int out_size, void* d_ws, size_t ws_size, hipStream_t stream) {
    static int grid = 0;
    if (grid == 0) {
        if (n_in != 15 || in_sizes[0] != M * DM || out_size != M * DM || ws_size < WS_END) { fprintf(stderr, "kernel_launch: unexpected shapes / workspace (%d inputs, ws %zu < %zu)\n", n_in, ws_size, (size_t)WS_END); grid = -1; return; }
        int dev = 0, cus = 0, per_cu = 0;
        if (hipGetDevice(&dev) != hipSuccess || hipDeviceGetAttribute(&cus, hipDeviceAttributeMultiprocessorCount, dev) != hipSuccess) { grid = -1; return; }
        if (hipFuncSetAttribute((const void*)hybrid_fwd, hipFuncAttributeMaxDynamicSharedMemorySize, LDS_BYTES) != hipSuccess) { fprintf(stderr, "kernel_launch: hipFuncSetAttribute failed\n"); grid = -1; return; }
        if (hipOccupancyMaxActiveBlocksPerMultiprocessor(&per_cu, (const void*)hybrid_fwd, 512, LDS_BYTES) != hipSuccess || per_cu < 1) { fprintf(stderr, "kernel_launch: occupancy query says %d\n", per_cu); grid = -1; return; }
        (void)hipGetLastError();
        grid = cus;
    }
    if (grid < 0) return;
    (void)hipMemsetAsync((char*)d_ws + WS_CTL, 0, CTL_ZERO_BYTES, stream);
    Args a{};
    for (int i = 0; i < 15; ++i) a.in[i] = (const float*)d_in[i];
    a.out = (float*)d_out; a.ws = (unsigned char*)d_ws;
    if (MK_N_LAUNCHES == 1) { a.ph_lo = 0; a.ph_hi = N_PHASES; a.li = 0; hipLaunchKernelGGL(hybrid_fwd, dim3(grid), dim3(512), LDS_BYTES, stream, a); }
    else for (int ph = 0; ph < N_PHASES; ++ph) { a.ph_lo = ph; a.ph_hi = ph + 1; a.li = ph; hipLaunchKernelGGL(hybrid_fwd, dim3(grid), dim3(512), LDS_BYTES, stream, a); }
}
```

```cpp
#include <hip/hip_runtime.h>
#include <cstdio>
#include <cstdint>

#ifndef MK_N_LAUNCHES
#define MK_N_LAUNCHES 1
#endif

#define LAS __attribute__((address_space(3)))
#define GAS __attribute__((address_space(1)))
typedef unsigned short bf16_t;
typedef short bf16x8 __attribute__((ext_vector_type(8)));
typedef float f32x4 __attribute__((ext_vector_type(4)));
typedef float f32x2 __attribute__((ext_vector_type(2)));
typedef unsigned u32x4 __attribute__((ext_vector_type(4)));
typedef unsigned u32x2 __attribute__((ext_vector_type(2)));

constexpr int BATCH = 2, SEQ = 8192, DM = 1024, M = BATCH * SEQ, DEPTH = 2;
constexpr int NIN = 9216, NH = 12, HD = 128;
constexpr int NCOL_A = 5120, NCOL_B = 4096;
constexpr float LOG2E = 1.4426950408889634f;
constexpr float QSCALE = 0.08838834764831845f * LOG2E;
constexpr float NORM_EPS = 1e-6f;

constexpr size_t MiB = 1u << 20;
constexpr size_t WS_CTL = 0, CTL_ZERO_BYTES = 1 * MiB;
constexpr size_t WS_LSE = 1 * MiB;
constexpr size_t WS_TIL = 2 * MiB;
constexpr size_t WS_W   = 8 * MiB;
constexpr size_t W_IN_T = 0;
constexpr size_t W_OATT_T = W_IN_T + (size_t)2 * NIN * DM * 2;
constexpr size_t W_OLRU_T = W_OATT_T + (size_t)2 * DM * 512 * 2;
constexpr size_t W_OUT_T  = W_OLRU_T + (size_t)2 * DM * DM * 2;
constexpr size_t W_RG_T   = W_OUT_T + (size_t)2 * DM * DM * 2;
constexpr size_t W_END    = W_RG_T + (size_t)2 * 16 * 65536 * 2;
static_assert(W_END == 50 * MiB, "weight map");
constexpr size_t WS_XB  = 58 * MiB;
constexpr size_t WS_Q   = 90 * MiB;
constexpr size_t WS_K   = 138 * MiB;
constexpr size_t WS_V   = 186 * MiB;
constexpr size_t WS_XLRU = WS_K;
constexpr size_t WS_SGL  = WS_K + 32 * MiB;
constexpr size_t WS_GATE = WS_K + 64 * MiB;
constexpr size_t WS_SGA  = 266 * MiB;
constexpr size_t WS_END  = 282 * MiB;
static_assert(WS_V - WS_K == WS_K - WS_Q, "q/k/v spacing");
constexpr int CW_BAR = 4096;
constexpr int CW_SS = 65536;
static_assert((CW_SS + 3 * M) * 4 <= (int)CTL_ZERO_BYTES, "ctl");

constexpr int RING_BYTES = 131072;
constexpr int LRU_PITCH = 528;
constexpr int LRU_IMG = 256 * LRU_PITCH;
constexpr int LRU_XCH = LRU_IMG;
constexpr int LDSCTL_OFF = 147456;
constexpr int LDS_BYTES = 148480;
static_assert(LRU_XCH + 4096 <= LDSCTL_OFF, "lds");

#define RLX_AGENT __ATOMIC_RELAXED, __HIP_MEMORY_SCOPE_AGENT
#define LDS_WAIT() asm volatile("s_waitcnt lgkmcnt(0)" ::: "memory")
#define VM_WAIT() asm volatile("s_waitcnt vmcnt(0)" ::: "memory")

__device__ __forceinline__ unsigned cvt_pk_bf16(float lo, float hi) { unsigned r; asm volatile("v_cvt_pk_bf16_f32 %0, %1, %2" : "=v"(r) : "v"(lo), "v"(hi)); return r; }
__device__ __forceinline__ float bf_lo(unsigned w) { return __uint_as_float(w << 16); }
__device__ __forceinline__ float bf_hi(unsigned w) { return __uint_as_float(w & 0xffff0000u); }
__device__ __forceinline__ float fast_sigmoid(float v) { return __builtin_amdgcn_rcpf(1.0f + __builtin_amdgcn_exp2f(-LOG2E * v)); }
__device__ __forceinline__ float fast_silu(float v) { return v * fast_sigmoid(v); }

namespace pg8 {
constexpr int BM = 256, BK = 64, HALF = 128, HTB = HALF * BK * 2, STAGE_BYTES = 8 * HTB, NXCD = 8, WGM = 8;
__host__ __device__ __forceinline__ int lds_byte(int r, int c) { const int st = (r >> 4) * 2 + (c >> 5), rr = r & 15, cc = c & 31, ob = rr * 64 + cc * 2; return st * 1024 + (ob ^ (((ob >> 9) & 1) << 5)); }
__host__ __device__ __forceinline__ void stage_rc(int b, int& R, int& C) { const int st = b / 1024, sb = b % 1024, swz = sb ^ (((sb >> 9) & 1) << 5); R = (st >> 1) * 16 + swz / 64; C = (st & 1) * 32 + (swz % 64) / 2; }
__host__ __device__ __forceinline__ int perm32(int rho) { const int n = rho >> 4, i = rho & 15; return 8 * (i >> 2) + 4 * n + (i & 3); }

struct Unit { int pm, pn; int abyte, bbyte; };
struct Gemm { const bf16_t* A; const bf16_t* Bt; int lda, ldb, K; };

struct StaticOrder {
    int nM, nN, nwg, G, c, ta, tb;
    __device__ void init(int Mr, int N, int G_, int c_, int lda, int ldb) { nM = Mr / BM; nN = N / BM; nwg = nM * nN; G = G_; c = c_; ta = BM * lda * 2; tb = BM * ldb * 2; }
    __device__ bool next(int i, Unit& u) const {
        const long L = (long)i * G + c; if (L >= nwg) return false;
        int wgid = (int)L; { const int q = nwg / NXCD, r = nwg % NXCD, xcd = wgid % NXCD, off = wgid / NXCD; wgid = (xcd < r ? xcd * (q + 1) : r * (q + 1) + (xcd - r) * q) + off; }
        const int nig = WGM * nN, gid = wgid / nig, fm = gid * WGM, gsz = (nM - fm) < WGM ? (nM - fm) : WGM;
        u.pm = fm + ((wgid % nig) % gsz); u.pn = (wgid % nig) / gsz; u.abyte = u.pm * ta; u.bbyte = u.pn * tb; return true;
    }
};
struct SingleUnit {
    Unit u0;
    __device__ bool next(int i, Unit& u) const { if (i != 0) return false; u = u0; return true; }
};

template <class Epi, class Sched>
__device__ __forceinline__ void gemm_phase(int tid_in, LAS unsigned char* lds, const Gemm g, const Sched& S, const Epi& E) {
    int tid = tid_in; asm volatile("" : "+v"(tid));
    const int wid = __builtin_amdgcn_readfirstlane(tid >> 6), lane = tid & 63, wr = wid >> 2, wc = wid & 3, fr = lane & 15, fq = lane >> 4;
    const int K = g.K, nt = K / BK;
    unsigned voffA[2], voffB[2];
#pragma unroll
    for (int i = 0; i < 2; ++i) { int R, C; stage_rc(tid * 16 + i * 8192, R, C); const int Rb = Epi::PERM ? ((R & ~31) + perm32(R & 31)) : R;
        voffA[i] = (unsigned)(R * g.lda + C) * 2u; voffB[i] = (unsigned)(Rb * g.ldb + C) * 2u; }
    const int kstep = BK * 2;
    const int hstepA = HALF * g.lda * 2, hstepB = HALF * g.ldb * 2;
    const __amdgpu_buffer_rsrc_t rsA = __builtin_amdgcn_make_buffer_rsrc((void*)g.A, 0, 0x7ffffff0, 0x00020000);
    const __amdgpu_buffer_rsrc_t rsB = __builtin_amdgcn_make_buffer_rsrc((void*)g.Bt, 0, 0x7ffffff0, 0x00020000);
    const unsigned ldsw = (unsigned)wid * 1024u;
    const int aoff = lds_byte(wr * 64 + fr, fq * 8), boff = lds_byte(wc * 32 + fr, fq * 8);
#define PG8_SA(b, h) (((b) * 2 + (h)) * HTB)
#define PG8_SB(b, h) ((4 + (b) * 2 + (h)) * HTB)
#define PG8_STAGEA(bufoff, soff) do { _Pragma("unroll") for (int _i = 0; _i < 2; ++_i) \
        __builtin_amdgcn_raw_ptr_buffer_load_lds(rsA, (LAS void*)(lds + (bufoff) + ldsw + _i * 8192), 16, (int)voffA[_i], (soff), 0, 0); } while (0)
#define PG8_STAGEB(bufoff, soff) do { _Pragma("unroll") for (int _i = 0; _i < 2; ++_i) \
        __builtin_amdgcn_raw_ptr_buffer_load_lds(rsB, (LAS void*)(lds + (bufoff) + ldsw + _i * 8192), 16, (int)voffB[_i], (soff), 0, 0); } while (0)
#define PG8_LDA(dst, b, h) do { _Pragma("unroll") for (int m = 0; m < 4; ++m) _Pragma("unroll") for (int k = 0; k < 2; ++k) dst[m][k] = *(const LAS bf16x8*)(lds + PG8_SA(b, h) + aoff + m * 2048 + k * 1024); } while (0)
#define PG8_LDB(dst, b, h) do { _Pragma("unroll") for (int n = 0; n < 2; ++n) _Pragma("unroll") for (int k = 0; k < 2; ++k) dst[n][k] = *(const LAS bf16x8*)(lds + PG8_SB(b, h) + boff + n * 2048 + k * 1024); } while (0)
#define PG8_MMA(ai, bj, At, Bt) do { __builtin_amdgcn_s_setprio(1); _Pragma("unroll") for (int m = 0; m < 4; ++m) _Pragma("unroll") for (int n = 0; n < 2; ++n) _Pragma("unroll") for (int k = 0; k < 2; ++k) \
        acc[ai][bj][m][n] = __builtin_amdgcn_mfma_f32_16x16x32_bf16(Bt[n][k], At[m][k], acc[ai][bj][m][n], 0, 0, 0); __builtin_amdgcn_s_setprio(0); } while (0)
#define PG8_WAIT_V(n) asm volatile("s_waitcnt vmcnt(" #n ")" ::: "memory")
#define PG8_WAIT_L(n) asm volatile("s_waitcnt lgkmcnt(" #n ")" ::: "memory")
#define PG8_BAR __builtin_amdgcn_s_barrier()
#define PG8_SCHED __builtin_amdgcn_sched_barrier(0)
    Unit cur, nxt; int ui = 0;
    if (!S.next(0, cur)) return;
    f32x4 acc[2][2][4][2];
#pragma unroll
    for (int a = 0; a < 2; ++a)
#pragma unroll
        for (int b = 0; b < 2; ++b)
#pragma unroll
            for (int m = 0; m < 4; ++m)
#pragma unroll
                for (int n = 0; n < 2; ++n) acc[a][b][m][n] = (f32x4){0.f, 0.f, 0.f, 0.f};
    bf16x8 At[4][2], B0[2][2], B1[2][2];
    int cA = cur.abyte, cB = cur.bbyte;
    PG8_STAGEB(PG8_SB(0, 0), cB); PG8_STAGEB(PG8_SB(0, 1), cB + hstepB); PG8_STAGEA(PG8_SA(0, 0), cA); PG8_STAGEA(PG8_SA(0, 1), cA + hstepA);
    if (wr == 1) PG8_BAR;
    PG8_WAIT_V(2); PG8_BAR;
    PG8_STAGEB(PG8_SB(1, 0), cB + kstep); PG8_STAGEA(PG8_SA(1, 0), cA + kstep); PG8_STAGEB(PG8_SB(1, 1), cB + hstepB + kstep);
    PG8_WAIT_V(6); PG8_BAR;
    for (;;) {
        const bool has_next = S.next(ui + 1, nxt);
        const int nA = has_next ? nxt.abyte : cA, nB = has_next ? nxt.bbyte : cB;
#pragma unroll 1
        for (int t = 0; t < nt; t += 2) {
            const bool last = (t == nt - 2);
            const int a1 = cA + (t + 1) * kstep;
            const int a2 = last ? nA : cA + (t + 2) * kstep, b2 = last ? nB : cB + (t + 2) * kstep;
            const int a3 = a2 + kstep, b3 = b2 + kstep;
            PG8_LDB(B0, 0, 0); PG8_LDB(B1, 0, 1); PG8_SCHED; PG8_LDA(At, 0, 0); PG8_STAGEA(PG8_SA(1, 1), a1 + hstepA);
            PG8_WAIT_V(8); PG8_WAIT_L(0); PG8_BAR; PG8_MMA(0, 0, At, B0); PG8_MMA(0, 1, At, B1); PG8_BAR; PG8_SCHED;
            PG8_LDA(At, 0, 1); PG8_STAGEB(PG8_SB(0, 0), b2); PG8_STAGEB(PG8_SB(0, 1), b2 + hstepB); PG8_STAGEA(PG8_SA(0, 0), a2);
            PG8_WAIT_V(8); PG8_WAIT_L(0); PG8_BAR; PG8_MMA(1, 0, At, B0); PG8_MMA(1, 1, At, B1); PG8_BAR; PG8_SCHED;
            PG8_LDB(B0, 1, 0); PG8_LDB(B1, 1, 1); PG8_SCHED; PG8_LDA(At, 1, 0); PG8_STAGEA(PG8_SA(0, 1), a2 + hstepA);
            PG8_WAIT_V(8); PG8_WAIT_L(0); PG8_BAR; PG8_MMA(0, 0, At, B0); PG8_MMA(0, 1, At, B1); PG8_BAR; PG8_SCHED;
            PG8_LDA(At, 1, 1); PG8_STAGEB(PG8_SB(1, 0), b3); PG8_STAGEB(PG8_SB(1, 1), b3 + hstepB); PG8_STAGEA(PG8_SA(1, 0), a3);
            PG8_WAIT_V(8); PG8_WAIT_L(0); PG8_BAR; PG8_MMA(1, 0, At, B0); PG8_MMA(1, 1, At, B1); PG8_BAR; PG8_SCHED;
        }
        if constexpr (!Epi::AFTER_DRAIN) { if (wr == 0) PG8_BAR; int l2 = lane; asm volatile("" : "+v"(l2)); int w2 = wid; asm volatile("" : "+s"(w2)); E(acc, cur, w2 >> 2, w2 & 3, l2 & 15, l2 >> 4); }
        if (!has_next) break;
#pragma unroll
        for (int a = 0; a < 2; ++a)
#pragma unroll
            for (int b = 0; b < 2; ++b)
#pragma unroll
                for (int m = 0; m < 4; ++m)
#pragma unroll
                    for (int n = 0; n < 2; ++n) acc[a][b][m][n] = (f32x4){0.f, 0.f, 0.f, 0.f};
        cur = nxt; cA = nA; cB = nB; ++ui;
        if constexpr (!Epi::AFTER_DRAIN) { if (wr == 1) PG8_BAR; }
    }
    PG8_WAIT_V(0);
    if constexpr (Epi::AFTER_DRAIN) { if (wr == 0) PG8_BAR; }
    PG8_BAR;
    if constexpr (Epi::AFTER_DRAIN) { int l2 = lane; asm volatile("" : "+v"(l2)); int w2 = wid; asm volatile("" : "+s"(w2)); E.fused(acc, cur, w2 >> 2, w2 & 3, l2 & 15, l2 >> 4, lds, w2, l2); }
#undef PG8_SA
#undef PG8_SB
#undef PG8_STAGEA
#undef PG8_STAGEB
#undef PG8_LDA
#undef PG8_LDB
#undef PG8_MMA
#undef PG8_WAIT_V
#undef PG8_WAIT_L
#undef PG8_BAR
#undef PG8_SCHED
}
}

#define XB_TMO      128
#define XB_XCNT(j)  (256  + 64 * (j))
#define XB_XSUB(j)  (1280 + 64 * (j))
#define XB_XGEN(j)  (2304 + 64 * (j))
#define XB_TOP      3328
#define XB_TOPGEN   3392
#define XCD_BAR_WORDS 3456
#define XB_SPIN_CAP (1u << 18)
__device__ __forceinline__ unsigned xb_ld(unsigned* p)              { return __hip_atomic_load(p, __ATOMIC_RELAXED, __HIP_MEMORY_SCOPE_AGENT); }
__device__ __forceinline__ unsigned xb_add(unsigned* p, unsigned v) { return __hip_atomic_fetch_add(p, v, __ATOMIC_RELAXED, __HIP_MEMORY_SCOPE_AGENT); }
__device__ __forceinline__ unsigned xb_xcc_id() { return (unsigned)__builtin_amdgcn_s_getreg((3 << 11) | 20) & 0xFu; }
#define XB_SPIN(cond, bar) do { unsigned _sp = 0; while (cond) { __builtin_amdgcn_s_sleep(1); \
    if ((++_sp & 255u) == 0u) { if (xb_ld(&(bar)[XB_TMO])) break; if (_sp > XB_SPIN_CAP) { atomicAdd(&(bar)[XB_TMO], 1u); break; } } } } while (0)
struct XcdBarrier { unsigned* bar; unsigned x; volatile LAS unsigned* st; };
__device__ __forceinline__ XcdBarrier xcd_barrier_post(unsigned* bar, volatile LAS unsigned* st) {
    XcdBarrier b; b.bar = bar; b.x = xb_xcc_id(); b.st = st;
    if (threadIdx.x == 0) (void)xb_add(&bar[XB_XCNT(b.x)], 1u);
    return b;
}
__device__ __forceinline__ void xcd_barrier_complete(unsigned* bar, unsigned x, unsigned& nloc, unsigned& nx) {
    const unsigned G = gridDim.x * gridDim.y * gridDim.z;
    unsigned sum, cnt, mine, sp = 0u;
    for (;;) {
        sum = 0u; cnt = 0u; mine = 0u;
#pragma unroll
        for (unsigned j = 0; j < 16; ++j) { const unsigned c = xb_ld(&bar[XB_XCNT(j)]); sum += c; cnt += (c > 0u) ? 1u : 0u; mine = (j == x) ? c : mine; }
        if (sum == G) break;
        __builtin_amdgcn_s_sleep(1);
        if ((++sp & 255u) == 0u) { if (xb_ld(&bar[XB_TMO])) break; if (sp > XB_SPIN_CAP) { atomicAdd(&bar[XB_TMO], 1u); break; } }
    }
    nloc = mine > 0u ? mine : 1u; nx = cnt > 0u ? cnt : 1u;
}
__device__ __forceinline__ void xcd_barrier(const XcdBarrier& b) {
    asm volatile("s_waitcnt vmcnt(0)" ::: "memory");
    __syncthreads();
    if (threadIdx.x == 0) {
        unsigned* bar = b.bar;
        __builtin_amdgcn_s_waitcnt(0);
        unsigned nloc = b.st[0], nx = b.st[1];
        if (nloc == 0u) { xcd_barrier_complete(bar, b.x, nloc, nx); b.st[0] = nloc; b.st[1] = nx; }
        const unsigned old = xb_add(&bar[XB_XSUB(b.x)], 1u);
        const unsigned gen = old / nloc;
        if (old + 1u == (gen + 1u) * nloc) {
            __builtin_amdgcn_fence(__ATOMIC_RELEASE, "agent");
            asm volatile("s_waitcnt vmcnt(0)" ::: "memory");
            const unsigned og = xb_add(&bar[XB_TOP], 1u);
            const unsigned tg = og / nx;
            if (og + 1u == (tg + 1u) * nx) xb_add(&bar[XB_TOPGEN], 1u);
            else XB_SPIN(xb_ld(&bar[XB_TOPGEN]) == tg, bar);
            __builtin_amdgcn_fence(__ATOMIC_ACQUIRE, "agent");
            xb_add(&bar[XB_XGEN(b.x)], 1u);
            asm volatile("s_waitcnt vmcnt(0)" ::: "memory");
        } else {
            XB_SPIN(xb_ld(&bar[XB_XGEN(b.x)]) == gen, bar);
            __builtin_amdgcn_fence(__ATOMIC_ACQUIRE, "agent");
            asm volatile("s_waitcnt vmcnt(0)" ::: "memory");
        }
    }
    __syncthreads();
}

struct Frame {
    LAS unsigned char* lds;
    unsigned* ctl;
    int tid, lane, wave, vcu, G;
    unsigned char* ws;
};
struct Args { const float* in[15]; float* out; unsigned char* ws; int ph_lo, ph_hi, li, pad; };

__device__ __forceinline__ int fresh(int v) { asm volatile("" : "+v"(v)); return v; }
__device__ __forceinline__ float wave_sum(float v) {
#pragma unroll
    for (int o = 1; o < 64; o <<= 1) v += __shfl_xor(v, o);
    return v;
}
__device__ __forceinline__ float wave_max(float v) {
#pragma unroll
    for (int o = 1; o < 64; o <<= 1) v = fmaxf(v, __shfl_xor(v, o));
    return v;
}

template <class RowFn>
__device__ __forceinline__ void p0_transpose_item(const float* W, int K, int N, const float* kscale, const RowFn& rowptr, LAS float* scr, int item, int lane) {
    const int nblk = N / 32, kb = item / nblk, nb = item % nblk, k0 = 64 * kb, n0 = 32 * nb;
#pragma unroll 8
    for (int i = 0; i < 32; ++i) { const int kk = 2 * i + (lane >> 5); const float sc = kscale ? kscale[k0 + kk] : 1.0f; scr[kk * 33 + (lane & 31)] = W[(size_t)(k0 + kk) * N + n0 + (lane & 31)] * sc; }
    LDS_WAIT(); asm volatile("" ::: "memory");
    const int c = lane & 7;
#pragma unroll
    for (int j = 0; j < 4; ++j) { const int n = (lane >> 3) + 8 * j; const LAS float* s = scr + (8 * c) * 33 + n;
        u32x4 o; o.x = cvt_pk_bf16(s[0 * 33], s[1 * 33]); o.y = cvt_pk_bf16(s[2 * 33], s[3 * 33]); o.z = cvt_pk_bf16(s[4 * 33], s[5 * 33]); o.w = cvt_pk_bf16(s[6 * 33], s[7 * 33]);
        *(u32x4*)(rowptr(n0 + n) + k0 + 8 * c) = o; }
    LDS_WAIT(); asm volatile("" ::: "memory");
}

__device__ __forceinline__ void p0_prologue(Frame& F, const Args& a) {
    LAS float* scr = (LAS float*)(F.lds + F.wave * 16384);
    const int gw = F.vcu * 8 + F.wave, NGW = F.G * 8;
    bf16_t* Wb = (bf16_t*)(F.ws + WS_W);
    constexpr int I_IN = (DM / 64) * (NIN / 32), I_OA = (512 / 64) * (DM / 32), I_OL = (DM / 64) * (DM / 32), I_RG = (256 / 64) * (256 / 32);
    constexpr int PER_LAYER = I_IN + I_OA + 2 * I_OL + 16 * I_RG;
    for (int it = gw; it < DEPTH * PER_LAYER; it += NGW) {
        const int l = it / PER_LAYER; int r = it % PER_LAYER;
        if (r < I_IN) { bf16_t* dst = Wb + W_IN_T / 2 + (size_t)l * NIN * DM;
            p0_transpose_item(a.in[2] + (size_t)l * DM * NIN, DM, NIN, a.in[1] + l * DM, [=](int n) { return dst + (size_t)n * DM; }, scr, r, F.lane); continue; } r -= I_IN;
        if (r < I_OA) { bf16_t* dst = Wb + W_OATT_T / 2 + (size_t)l * DM * 512;
            p0_transpose_item(a.in[11] + (size_t)l * 512 * DM, 512, DM, nullptr, [=](int n) { return dst + (size_t)n * 512; }, scr, r, F.lane); continue; } r -= I_OA;
        if (r < I_OL) { bf16_t* dst = Wb + W_OLRU_T / 2 + (size_t)l * DM * DM;
            p0_transpose_item(a.in[12] + (size_t)l * DM * DM, DM, DM, nullptr, [=](int n) { return dst + (size_t)n * DM; }, scr, r, F.lane); continue; } r -= I_OL;
        if (r < I_OL) { bf16_t* dst = Wb + W_OUT_T / 2 + (size_t)l * DM * DM;
            p0_transpose_item(a.in[13] + (size_t)l * DM * DM, DM, DM, nullptr, [=](int n) { return dst + (size_t)n * DM; }, scr, r, F.lane); continue; } r -= I_OL;
        {
            const int s = r / I_RG, item = r % I_RG, dir = s >> 3, kind = (s >> 2) & 1, n = s & 3;
            const float* src = (kind ? a.in[8] : a.in[6]) + ((size_t)((l * 2 + dir) * 4 + n)) * 65536;
            bf16_t* dst = Wb + W_RG_T / 2 + (size_t)(l * 4 + n) * 4 * 65536;
            p0_transpose_item(src, 256, 256, nullptr, [=](int j) { return dst + (size_t)(j >> 6) * 65536 + (size_t)(128 * dir + 32 * ((j >> 4) & 3) + 16 * kind + (j & 15)) * 256; }, scr, item, F.lane);
        }
    }
    const float* x = a.in[0]; bf16_t* XB = (bf16_t*)(F.ws + WS_XB); float* ss = (float*)(F.ctl + CW_SS);
    for (int m = gw; m < M; m += NGW) {
        const f32x4* xr = (const f32x4*)(x + (size_t)m * DM) + F.lane; float s = 0.f;
        unsigned long long* o8 = (unsigned long long*)(XB + (size_t)m * DM) + F.lane;
#pragma unroll
        for (int j = 0; j < 4; ++j) { const f32x4 v = xr[64 * j]; s += (v.x * v.x + v.y * v.y) + (v.z * v.z + v.w * v.w);
            o8[64 * j] = (unsigned long long)cvt_pk_bf16(v.x, v.y) | ((unsigned long long)cvt_pk_bf16(v.z, v.w) << 32); }
        s = wave_sum(s);
        if (F.lane == 0) ss[m] = s;
    }
}

struct EpiProjA {
    static constexpr bool PERM = true, AFTER_DRAIN = false;
    unsigned char* ws; const float* ss;
    __device__ __forceinline__ void operator()(const f32x4 (&acc)[2][2][4][2], const pg8::Unit& u, int wr, int wc, int fr, int fq) const {
        const int kind = u.pn / 6;
        float rs[2][4];
#pragma unroll
        for (int ai = 0; ai < 2; ++ai)
#pragma unroll
            for (int m = 0; m < 4; ++m) rs[ai][m] = ss[u.pm * 256 + ai * 128 + wr * 64 + m * 16 + fr];
#pragma unroll
        for (int ai = 0; ai < 2; ++ai)
#pragma unroll
            for (int m = 0; m < 4; ++m) {
                const int row = u.pm * 256 + ai * 128 + wr * 64 + m * 16 + fr;
                const float rstd = __builtin_amdgcn_rsqf(rs[ai][m] * (1.0f / DM) + NORM_EPS);
                if (kind < 3) {
                    const int b = row >> 13, p = row & 8191; const float sc = (kind == 0) ? rstd * QSCALE : rstd;
                    bf16_t* base = (bf16_t*)(ws + WS_Q + (size_t)kind * (WS_K - WS_Q));
#pragma unroll
                    for (int bj = 0; bj < 2; ++bj) {
                        const int hh = 2 * (u.pn - 6 * kind) + bj, sh = 2 * (hh >> 2);
                        const int rho = ((p & ((1 << sh) - 1)) << (13 - sh)) + (p >> sh);
                        bf16_t* dst = base + ((size_t)(b * NH + hh) * SEQ + rho) * HD + wc * 32 + 8 * fq;
                        const f32x4 v0 = acc[ai][bj][m][0] * sc, v1 = acc[ai][bj][m][1] * sc;
                        u32x4 w; w.x = cvt_pk_bf16(v0[0], v0[1]); w.y = cvt_pk_bf16(v0[2], v0[3]); w.z = cvt_pk_bf16(v1[0], v1[1]); w.w = cvt_pk_bf16(v1[2], v1[3]);
                        *(u32x4*)dst = w;
                    }
                } else {
#pragma unroll
                    for (int bj = 0; bj < 2; ++bj) {
                        bf16_t* dst = (bf16_t*)(ws + WS_SGA) + (size_t)row * 512 + (u.pn - 18) * 256 + bj * 128 + wc * 32 + 8 * fq;
                        const f32x4 v0 = acc[ai][bj][m][0] * rstd, v1 = acc[ai][bj][m][1] * rstd;
                        u32x4 w; w.x = cvt_pk_bf16(fast_silu(v0[0]), fast_silu(v0[1])); w.y = cvt_pk_bf16(fast_silu(v0[2]), fast_silu(v0[3]));
                        w.z = cvt_pk_bf16(fast_silu(v1[0]), fast_silu(v1[1])); w.w = cvt_pk_bf16(fast_silu(v1[2]), fast_silu(v1[3]));
                        *(u32x4*)dst = w;
                    }
                }
            }
    }
};
struct EpiProjB {
    static constexpr bool PERM = true, AFTER_DRAIN = false;
    unsigned char* ws; const float* ss; const float* bgate;
    __device__ __forceinline__ void operator()(const f32x4 (&acc)[2][2][4][2], const pg8::Unit& u, int wr, int wc, int fr, int fq) const {
        const int kind = u.pn < 4 ? 0 : (u.pn < 8 ? 1 : 2);
        f32x4 bv[2][2];
#pragma unroll
        for (int bj = 0; bj < 2; ++bj)
#pragma unroll
            for (int n = 0; n < 2; ++n) bv[bj][n] = (kind == 2) ? *(const f32x4*)(bgate + (u.pn - 8) * 256 + bj * 128 + wc * 32 + 8 * fq + 4 * n) : (f32x4){0.f, 0.f, 0.f, 0.f};
        float rs[2][4];
#pragma unroll
        for (int ai = 0; ai < 2; ++ai)
#pragma unroll
            for (int m = 0; m < 4; ++m) rs[ai][m] = ss[u.pm * 256 + ai * 128 + wr * 64 + m * 16 + fr];
#pragma unroll
        for (int ai = 0; ai < 2; ++ai)
#pragma unroll
            for (int m = 0; m < 4; ++m) {
                const int row = u.pm * 256 + ai * 128 + wr * 64 + m * 16 + fr;
                const float rstd = __builtin_amdgcn_rsqf(rs[ai][m] * (1.0f / DM) + NORM_EPS);
#pragma unroll
                for (int bj = 0; bj < 2; ++bj) {
                    const int cin = bj * 128 + wc * 32 + 8 * fq;
                    f32x4 v0 = acc[ai][bj][m][0] * rstd, v1 = acc[ai][bj][m][1] * rstd;
                    bf16_t* dst;
                    if (kind == 0) dst = (bf16_t*)(ws + WS_XLRU) + (size_t)row * DM + u.pn * 256 + cin;
                    else if (kind == 1) { dst = (bf16_t*)(ws + WS_SGL) + (size_t)row * DM + (u.pn - 4) * 256 + cin;
#pragma unroll
                        for (int e = 0; e < 4; ++e) { v0[e] = fast_silu(v0[e]); v1[e] = fast_silu(v1[e]); } }
                    else { dst = (bf16_t*)(ws + WS_GATE) + (size_t)row * 2048 + (u.pn - 8) * 256 + cin; v0 += bv[bj][0]; v1 += bv[bj][1];
#pragma unroll
                        for (int e = 0; e < 4; ++e) { v0[e] = fast_sigmoid(v0[e]); v1[e] = fast_sigmoid(v1[e]); } }
                    u32x4 w; w.x = cvt_pk_bf16(v0[0], v0[1]); w.y = cvt_pk_bf16(v0[2], v0[3]); w.z = cvt_pk_bf16(v1[0], v1[1]); w.w = cvt_pk_bf16(v1[2], v1[3]);
                    *(u32x4*)dst = w;
                }
            }
    }
};
template <bool FIRST> struct EpiMerge {
    static constexpr bool PERM = true, AFTER_DRAIN = false;
    bf16_t* MG; const bf16_t* GATE;
    __device__ __forceinline__ void operator()(const f32x4 (&acc)[2][2][4][2], const pg8::Unit& u, int wr, int wc, int fr, int fq) const {
#pragma unroll
        for (int ai = 0; ai < 2; ++ai) {
            u32x4 gw[4][2], pw[4][2];
#pragma unroll
            for (int m = 0; m < 4; ++m)
#pragma unroll
                for (int bj = 0; bj < 2; ++bj) {
                    const int row = u.pm * 256 + ai * 128 + wr * 64 + m * 16 + fr, col = u.pn * 256 + bj * 128 + wc * 32 + 8 * fq;
                    gw[m][bj] = *(const u32x4*)(GATE + (size_t)row * 2048 + col);
                    if (!FIRST) pw[m][bj] = *(const u32x4*)(MG + (size_t)row * DM + col);
                }
#pragma unroll
            for (int m = 0; m < 4; ++m)
#pragma unroll
                for (int bj = 0; bj < 2; ++bj) {
                    const int row = u.pm * 256 + ai * 128 + wr * 64 + m * 16 + fr, col = u.pn * 256 + bj * 128 + wc * 32 + 8 * fq;
                    const u32x4 g4 = gw[m][bj];
                    f32x4 v0 = acc[ai][bj][m][0], v1 = acc[ai][bj][m][1];
                    v0[0] *= bf_lo(g4.x); v0[1] *= bf_hi(g4.x); v0[2] *= bf_lo(g4.y); v0[3] *= bf_hi(g4.y);
                    v1[0] *= bf_lo(g4.z); v1[1] *= bf_hi(g4.z); v1[2] *= bf_lo(g4.w); v1[3] *= bf_hi(g4.w);
                    if (!FIRST) { const u32x4 p4 = pw[m][bj];
                        v0[0] += bf_lo(p4.x); v0[1] += bf_hi(p4.x); v0[2] += bf_lo(p4.y); v0[3] += bf_hi(p4.y);
                        v1[0] += bf_lo(p4.z); v1[1] += bf_hi(p4.z); v1[2] += bf_lo(p4.w); v1[3] += bf_hi(p4.w); }
                    u32x4 w; w.x = cvt_pk_bf16(v0[0], v0[1]); w.y = cvt_pk_bf16(v0[2], v0[3]); w.z = cvt_pk_bf16(v1[0], v1[1]); w.w = cvt_pk_bf16(v1[2], v1[3]);
                    *(u32x4*)(MG + (size_t)row * DM + col) = w;
                }
        }
    }
};
struct EpiResid {
    static constexpr bool PERM = false, AFTER_DRAIN = false;
    const float* xin; float* xout; bf16_t* XB; float* ssn;
    __device__ __forceinline__ void operator()(const f32x4 (&acc)[2][2][4][2], const pg8::Unit& u, int wr, int wc, int fr, int fq) const {
#pragma unroll
        for (int ai = 0; ai < 2; ++ai)
#pragma unroll
            for (int mp = 0; mp < 2; ++mp) {
                f32x4 xi[2][2][2];
#pragma unroll
                for (int mm = 0; mm < 2; ++mm)
#pragma unroll
                    for (int bj = 0; bj < 2; ++bj)
#pragma unroll
                        for (int n = 0; n < 2; ++n) {
                            const int row = u.pm * 256 + ai * 128 + wr * 64 + (mp * 2 + mm) * 16 + fr;
                            xi[mm][bj][n] = *(const f32x4*)(xin + (size_t)row * DM + u.pn * 256 + bj * 128 + wc * 32 + n * 16 + 4 * fq);
                        }
#pragma unroll
                for (int mm = 0; mm < 2; ++mm) {
                    const int m = mp * 2 + mm, row = u.pm * 256 + ai * 128 + wr * 64 + m * 16 + fr; float s = 0.f;
#pragma unroll
                    for (int bj = 0; bj < 2; ++bj)
#pragma unroll
                        for (int n = 0; n < 2; ++n) {
                            const size_t off = (size_t)row * DM + u.pn * 256 + bj * 128 + wc * 32 + n * 16 + 4 * fq;
                            const f32x4 v = xi[mm][bj][n] + acc[ai][bj][m][n];
                            *(f32x4*)(xout + off) = v;
                            u32x2 w; w.x = cvt_pk_bf16(v[0], v[1]); w.y = cvt_pk_bf16(v[2], v[3]); *(u32x2*)(XB + off) = w;
                            s += (v[0] * v[0] + v[1] * v[1]) + (v[2] * v[2] + v[3] * v[3]);
                        }
                    s += __shfl_xor(s, 16); s += __shfl_xor(s, 32);
                    if (fq == 0) atomicAdd(ssn + row, s);
                }
            }
    }
};

__device__ __forceinline__ void attn_naive(Frame& F) {
    bf16_t* Q = (bf16_t*)(F.ws + WS_Q); const bf16_t* Kb = (const bf16_t*)(F.ws + WS_K); const bf16_t* Vb = (const bf16_t*)(F.ws + WS_V);
    float* LSE = (float*)(F.ws + WS_LSE);
    const int gw = F.vcu * 8 + F.wave, NGW = F.G * 8, lane = F.lane;
    for (int item = gw; item < BATCH * NH * SEQ; item += NGW) {
        const int bh = item >> 13, rho = item & 8191, hh = bh % NH, sh = 2 * (hh >> 2), ng = SEQ >> sh;
        const int idx = rho & (ng - 1);
        const size_t rowq = (size_t)bh * SEQ + rho;
        const float slope2 = exp2f(-8.0f * (float)(hh + 1) / 12.0f) * (float)(1 << sh) * LOG2E;
        float s[3]; bool ok[3];
#pragma unroll
        for (int t = 0; t < 3; ++t) {
            const int j = lane - 64 + 64 * t; ok[t] = (j <= 64) && (idx + j >= 0) && (idx + j < ng); s[t] = -1e30f;
            if (ok[t]) {
                const u32x4* kp = (const u32x4*)(Kb + (rowq + j) * HD); const u32x4* qp = (const u32x4*)(Q + rowq * HD); float d = 0.f;
#pragma unroll 4
                for (int c = 0; c < 16; ++c) { const u32x4 kv = kp[c], qv = qp[c];
                    d += bf_lo(kv.x) * bf_lo(qv.x) + bf_hi(kv.x) * bf_hi(qv.x) + bf_lo(kv.y) * bf_lo(qv.y) + bf_hi(kv.y) * bf_hi(qv.y)
                       + bf_lo(kv.z) * bf_lo(qv.z) + bf_hi(kv.z) * bf_hi(qv.z) + bf_lo(kv.w) * bf_lo(qv.w) + bf_hi(kv.w) * bf_hi(qv.w); }
                s[t] = d - slope2 * fabsf((float)j);
            }
        }
        const float mx = wave_max(fmaxf(fmaxf(s[0], s[1]), s[2]));
        float p[3];
#pragma unroll
        for (int t = 0; t < 3; ++t) p[t] = ok[t] ? exp2f(s[t] - mx) : 0.f;
        const float den = wave_sum(p[0] + p[1] + p[2]);
        float o0 = 0.f, o1 = 0.f;
#pragma unroll
        for (int t = 0; t < 3; ++t)
            for (int src = 0; src < 64; ++src) {
                const int j = src - 64 + 64 * t; if (j > 64) break;
                if (idx + j < 0 || idx + j >= ng) continue;
                const float pj = __shfl(p[t], src);
                const unsigned vv = *(const unsigned*)(Vb + (rowq + j) * HD + 2 * lane);
                o0 += pj * bf_lo(vv); o1 += pj * bf_hi(vv);
            }
        const float inv = 1.0f / den;
        *(unsigned*)(Q + rowq * HD + 2 * lane) = cvt_pk_bf16(o0 * inv, o1 * inv);
        if (lane == 0) LSE[rowq] = mx + log2f(den);
    }
}

typedef float f32x16 __attribute__((ext_vector_type(16)));
typedef short s16x4 __attribute__((ext_vector_type(4)));
typedef __bf16 bf16x2_t __attribute__((ext_vector_type(2)));
__device__ __forceinline__ unsigned cvtpk_c(float lo, float hi) { f32x2 v = {lo, hi}; bf16x2_t b = __builtin_convertvector(v, bf16x2_t); return __builtin_bit_cast(unsigned, b); }
__device__ __forceinline__ int crow(int r, int hi) { return (r & 3) + 8 * (r >> 2) + 4 * hi; }
__device__ __forceinline__ void attn_dma(LAS unsigned char* img, const bf16_t* base, int U, int seq_lo, int seq_hi, int w, int lane) {
    const __amdgpu_buffer_rsrc_t rs = __builtin_amdgcn_make_buffer_rsrc((void*)base, 0, SEQ * 256, 0x00020000);
    const int rl0 = lane >> 4, cp = lane & 15;
#pragma unroll
    for (int i = 0; i < 12; ++i) {
        const int pc = w * 12 + i, row_local = 4 * pc + rl0;
        int grow = U - 64 + row_local; grow = grow < seq_lo ? seq_lo : grow; grow = grow > seq_hi - 1 ? seq_hi - 1 : grow;
        const int voff = grow * 256 + ((cp ^ ((rl0 << 2) | (i & 3))) << 4);
        __builtin_amdgcn_raw_ptr_buffer_load_lds(rs, (LAS void*)(img + pc * 1024), 16, voff, 0, 0, 0);
    }
}
__device__ __forceinline__ void attn_unit(Frame& F, int unit) {
    LAS unsigned char* img = F.lds;
    const int lane = F.lane, w = F.wave, c = lane & 31, hi = lane >> 5;
    const int bh = unit >> 5, qb = unit & 31, hh = bh % NH, sh = 2 * (hh >> 2), ng = SEQ >> sh;
    const int U = qb * 256, seq_lo = U & ~(ng - 1), seq_hi = seq_lo + ng;
    bf16_t* Qh = (bf16_t*)(F.ws + WS_Q) + (size_t)bh * SEQ * HD;
    const bf16_t* Kh = (const bf16_t*)(F.ws + WS_K) + (size_t)bh * SEQ * HD;
    const bf16_t* Vh = (const bf16_t*)(F.ws + WS_V) + (size_t)bh * SEQ * HD;
    attn_dma(img, Kh, U, seq_lo, seq_hi, w, lane);
    bf16x8 qf[8];
    { const bf16_t* qrow = Qh + (size_t)(U + 32 * w + c) * HD + 8 * hi;
#pragma unroll
      for (int s = 0; s < 8; ++s) qf[s] = *(const bf16x8*)(qrow + 16 * s); }
    const float slope2 = exp2f(-8.0f * (float)(hh + 1) / 12.0f) * (float)(1 << sh) * LOG2E;
    asm volatile("s_waitcnt vmcnt(0)" ::: "memory"); __builtin_amdgcn_s_barrier(); asm volatile("" ::: "memory");
    f32x16 p[5];
    {   const int lk = fresh(lane), ck = lk & 31, hk = lk >> 5;
        const unsigned swz = ((unsigned)(ck & 3) << 2) | ((unsigned)(ck >> 2) & 3u);
        unsigned kx[8];
#pragma unroll
        for (int s = 0; s < 8; ++s) kx[s] = 256u * (unsigned)(32 * w + ck) + 16u * (((unsigned)(2 * s + hk)) ^ swz);
#pragma unroll
        for (int i = 0; i < 5; ++i) {
            f32x16 a = {0.f, 0.f, 0.f, 0.f, 0.f, 0.f, 0.f, 0.f, 0.f, 0.f, 0.f, 0.f, 0.f, 0.f, 0.f, 0.f};
#pragma unroll
            for (int s = 0; s < 8; ++s) { const bf16x8 kf = *(const LAS bf16x8*)(img + kx[s] + 8192 * i); a = __builtin_amdgcn_mfma_f32_32x32x16_bf16(kf, qf[s], a, 0, 0, 0); }
            p[i] = a;
        }
    }
    const bool lo_edge = (U == seq_lo), hi_edge = (U + 256 == seq_hi);
    const int lm = fresh(lane);
    const float dbase = (float)(4 * (lm >> 5) - (lm & 31));
    float mx = -1e30f;
#pragma unroll
    for (int i = 0; i < 5; ++i) {
        const bool tile_dead = (lo_edge && (w + i < 2)) || (hi_edge && (w + i >= 10));
        const float pen = tile_dead ? -1e30f : 0.0f;
#pragma unroll
        for (int r = 0; r < 16; ++r) {
            const float ad = fabsf((float)(32 * i + (r & 3) + 8 * (r >> 2) - 64) + dbase);
            float s = p[i][r] - slope2 * ad + pen;
            if (i == 0 || i == 4) s = (ad <= 64.0f) ? s : -1e30f;
            p[i][r] = s; mx = fmaxf(mx, s);
        }
    }
    mx = fmaxf(mx, __shfl_xor(mx, 32));
    float l = 0.f;
#pragma unroll
    for (int i = 0; i < 5; ++i)
#pragma unroll
        for (int r = 0; r < 16; ++r) { const float e = __builtin_amdgcn_exp2f(p[i][r] - mx); p[i][r] = e; l += e; }
    l += __shfl_xor(l, 32);
    const float inv = 1.0f / l;
    if (hi == 0) ((float*)(F.ws + WS_LSE))[(size_t)bh * SEQ + U + 32 * w + c] = mx + log2f(l);
    u32x4 pa[5][2];
#pragma unroll
    for (int i = 0; i < 5; ++i)
#pragma unroll
        for (int s = 0; s < 2; ++s) {
            pa[i][s].x = cvtpk_c(p[i][8 * s + 0] * inv, p[i][8 * s + 1] * inv); pa[i][s].y = cvtpk_c(p[i][8 * s + 2] * inv, p[i][8 * s + 3] * inv);
            pa[i][s].z = cvtpk_c(p[i][8 * s + 4] * inv, p[i][8 * s + 5] * inv); pa[i][s].w = cvtpk_c(p[i][8 * s + 6] * inv, p[i][8 * s + 7] * inv);
        }
    asm volatile("s_waitcnt lgkmcnt(0)" ::: "memory"); __builtin_amdgcn_s_barrier(); asm volatile("" ::: "memory");
    attn_dma(img, Vh, U, seq_lo, seq_hi, w, lane);
    asm volatile("s_waitcnt vmcnt(0)" ::: "memory"); __builtin_amdgcn_s_barrier(); asm volatile("" ::: "memory");
    f32x16 o[4];
#pragma unroll
    for (int c4 = 0; c4 < 4; ++c4) o[c4] = (f32x16){0.f, 0.f, 0.f, 0.f, 0.f, 0.f, 0.f, 0.f, 0.f, 0.f, 0.f, 0.f, 0.f, 0.f, 0.f, 0.f};
    {   const int lv = fresh(lane), blk = (lv >> 4) & 1, q = (lv & 15) >> 2, pp = lv & 3, hv = lv >> 5;
        unsigned vx[4][2];
#pragma unroll
        for (int c4 = 0; c4 < 4; ++c4)
#pragma unroll
            for (int t = 0; t < 2; ++t)
                vx[c4][t] = 256u * (unsigned)(32 * w + 8 * t + 4 * hv + q) + 16u * ((((unsigned)(c4 ^ q)) << 2) | (((unsigned)(2 * blk + (pp >> 1))) ^ ((unsigned)(2 * t + hv)))) + 8u * (unsigned)(pp & 1);
#pragma unroll
        for (int i = 0; i < 5; ++i)
#pragma unroll
            for (int s = 0; s < 2; ++s) {
                const bf16x8 af = __builtin_bit_cast(bf16x8, pa[i][s]);
#pragma unroll
                for (int c4 = 0; c4 < 4; ++c4) {
                    const s16x4 v0 = __builtin_bit_cast(s16x4, __builtin_amdgcn_ds_read_tr16_b64_v4i16((LAS s16x4*)(img + vx[c4][0] + 8192 * i + 4096 * s)));
                    const s16x4 v1 = __builtin_bit_cast(s16x4, __builtin_amdgcn_ds_read_tr16_b64_v4i16((LAS s16x4*)(img + vx[c4][1] + 8192 * i + 4096 * s)));
                    const bf16x8 bfv = (bf16x8){v0[0], v0[1], v0[2], v0[3], v1[0], v1[1], v1[2], v1[3]};
                    o[c4] = __builtin_amdgcn_mfma_f32_32x32x16_bf16(af, bfv, o[c4], 0, 0, 0);
                }
            }
    }
    asm volatile("s_waitcnt lgkmcnt(0)" ::: "memory"); __builtin_amdgcn_s_barrier(); asm volatile("" ::: "memory");
    {   LAS bf16_t* stg = (LAS bf16_t*)(img + w * 8192);
#pragma unroll
        for (int c4 = 0; c4 < 4; ++c4)
#pragma unroll
            for (int r = 0; r < 16; ++r) stg[crow(r, hi) * 128 + 32 * c4 + c] = (bf16_t)(cvtpk_c(o[c4][r], 0.f) & 0xffffu);
        asm volatile("s_waitcnt lgkmcnt(0)" ::: "memory");
        bf16_t* orow = Qh + (size_t)(U + 32 * w) * HD;
#pragma unroll
        for (int it = 0; it < 8; ++it) { const int row = it * 4 + (lane >> 4), ch = lane & 15;
            const u32x4 v = *(const LAS u32x4*)((LAS unsigned char*)stg + row * 256 + ch * 16);
            *(u32x4*)(orow + (size_t)row * HD + ch * 8) = v; }
    }
    asm volatile("s_waitcnt lgkmcnt(0)" ::: "memory"); __builtin_amdgcn_s_barrier(); asm volatile("" ::: "memory");
}
__device__ __forceinline__ void attn_phase(Frame& F) {
    for (int unit = F.vcu; unit < BATCH * NH * 32; unit += F.G) attn_unit(F, unit);
}

__device__ __forceinline__ void attn_mix(Frame& F, int pm, int slot) {
    const bf16_t* O = (const bf16_t*)(F.ws + WS_Q); const float* LSE = (const float*)(F.ws + WS_LSE); bf16_t* SGA = (bf16_t*)(F.ws + WS_SGA);
    for (int it = fresh(threadIdx.x); it < 256 * 16; it += 512) {
        const int row = pm * 256 + (it >> 4), ch = it & 15, b = row >> 13, p = row & 8191;
        float l[3]; u32x4 o[3];
#pragma unroll
        for (int g = 0; g < 3; ++g) { const int sh = 2 * g, hh = 4 * g + slot; const int rho = ((p & ((1 << sh) - 1)) << (13 - sh)) + (p >> sh);
            const size_t r = (size_t)(b * NH + hh) * SEQ + rho; l[g] = LSE[r]; o[g] = *(const u32x4*)(O + r * HD + 8 * ch); }
        const float mx = fmaxf(fmaxf(l[0], l[1]), l[2]);
        float w0 = exp2f(l[0] - mx), w1 = exp2f(l[1] - mx), w2 = exp2f(l[2] - mx); const float inv = 1.0f / (w0 + w1 + w2); w0 *= inv; w1 *= inv; w2 *= inv;
        bf16_t* dst = SGA + (size_t)row * 512 + slot * 128 + 8 * ch; const u32x4 sg = *(const u32x4*)dst;
        u32x4 y;
#define MIXW(f) { const float lo = (w0 * bf_lo(o[0].f) + w1 * bf_lo(o[1].f) + w2 * bf_lo(o[2].f)) * bf_lo(sg.f); const float hi = (w0 * bf_hi(o[0].f) + w1 * bf_hi(o[1].f) + w2 * bf_hi(o[2].f)) * bf_hi(sg.f); y.f = cvt_pk_bf16(lo, hi); }
        MIXW(x) MIXW(y) MIXW(z) MIXW(w)
#undef MIXW
        *(u32x4*)dst = y;
    }
}

__device__ __forceinline__ void lru_conv(Frame& F, int pm, int n, const float* conv_w, const float* conv_b) {
    const bf16_t* XL = (const bf16_t*)(F.ws + WS_XLRU); bf16_t* XC = (bf16_t*)(F.ws + WS_XB);
    for (int it = fresh(threadIdx.x); it < 256 * 32; it += 512) {
        const int row = pm * 256 + (it >> 5), c0 = n * 256 + (it & 31) * 8, t = row & 8191;
        float acc[8];
        { const f32x4 b0 = *(const f32x4*)(conv_b + c0), b1 = *(const f32x4*)(conv_b + c0 + 4); acc[0] = b0[0]; acc[1] = b0[1]; acc[2] = b0[2]; acc[3] = b0[3]; acc[4] = b1[0]; acc[5] = b1[1]; acc[6] = b1[2]; acc[7] = b1[3]; }
#pragma unroll
        for (int j = 0; j < 4; ++j) { const int tt = t + j - 2; if (tt < 0 || tt >= SEQ) continue;
            const u32x4 xv = *(const u32x4*)(XL + (size_t)(row + j - 2) * DM + c0);
            const f32x4 w0 = *(const f32x4*)(conv_w + j * DM + c0), w1 = *(const f32x4*)(conv_w + j * DM + c0 + 4);
            acc[0] += w0[0] * bf_lo(xv.x); acc[1] += w0[1] * bf_hi(xv.x); acc[2] += w0[2] * bf_lo(xv.y); acc[3] += w0[3] * bf_hi(xv.y);
            acc[4] += w1[0] * bf_lo(xv.z); acc[5] += w1[1] * bf_hi(xv.z); acc[6] += w1[2] * bf_lo(xv.w); acc[7] += w1[3] * bf_hi(xv.w); }
        u32x4 o; o.x = cvt_pk_bf16(acc[0], acc[1]); o.y = cvt_pk_bf16(acc[2], acc[3]); o.z = cvt_pk_bf16(acc[4], acc[5]); o.w = cvt_pk_bf16(acc[6], acc[7]);
        *(u32x4*)(XC + (size_t)row * DM + c0) = o;
    }
}
template <int PASS> struct EpiLru {
    static constexpr bool PERM = false, AFTER_DRAIN = true;
    const bf16_t* XC; const float *ba, *bx, *lam;
    float* TIL; const bf16_t* SGL; bf16_t* YL; int n, qq;
    __device__ __forceinline__ void fused(f32x4 (&acc)[2][2][4][2], const pg8::Unit& u, int wr, int wc, int fr, int fq, LAS unsigned char* lds, int wid, int lane) const {
        const int cu0 = 16 * wc + 4 * fq, ch0 = 256 * n + 64 * qq + cu0;
#pragma unroll
        for (int d = 0; d < 2; ++d) {
            float cba[4], cbx[4], c2[4];
            { const f32x4 a4 = *(const f32x4*)(ba + d * DM + ch0), x4 = *(const f32x4*)(bx + d * DM + ch0), l4 = *(const f32x4*)(lam + d * DM + ch0);
#pragma unroll
              for (int e = 0; e < 4; ++e) { cba[e] = a4[e]; cbx[e] = x4[e]; c2[e] = -8.0f * LOG2E * log1pf(expf(-l4[e])); } }
#pragma unroll
            for (int ai = 0; ai < 2; ++ai)
#pragma unroll
                for (int m = 0; m < 4; ++m) {
                    const int rl = ai * 128 + wr * 64 + m * 16 + fr, row = u.pm * 256 + rl, t = row & 8191;
                    const u32x2 xw = *(const u32x2*)(XC + (size_t)row * DM + ch0);
                    const float xc[4] = {bf_lo(xw.x), bf_hi(xw.x), bf_lo(xw.y), bf_hi(xw.y)};
                    const bool first = (d == 0) ? (t == 0) : (t == SEQ - 1);
                    u32x4 w;
#pragma unroll
                    for (int e = 0; e < 4; ++e) {
                        const float r = fast_sigmoid(acc[ai][d][m][0][e] + cba[e]), ig = fast_sigmoid(acc[ai][d][m][1][e] + cbx[e]);
                        const float l2a = r * c2[e];
                        const float a2 = __builtin_amdgcn_exp2f(2.0f * l2a);
                        const float mult = first ? 1.0f : __builtin_amdgcn_sqrtf(fmaxf(1.0f - a2, 0.0f));
                        w[e] = cvt_pk_bf16(l2a, mult * ig * xc[e]);
                    }
                    *(LAS u32x4*)(lds + rl * LRU_PITCH + d * 256 + cu0 * 4) = w;
                    __builtin_amdgcn_sched_barrier(0);
                }
        }
        LDS_WAIT(); __builtin_amdgcn_s_barrier(); asm volatile("" ::: "memory");
        const int tid = wid * 64 + lane, seg = tid >> 7, dir = (tid >> 6) & 1, cu = tid & 63, ch = 256 * n + 64 * qq + cu;
        LAS unsigned char* col = lds + dir * 256 + cu * 4;
        const int r0 = dir ? (seg * 64 + 63) : seg * 64, rstep = dir ? -LRU_PITCH : LRU_PITCH;
        float P = 1.0f, H = 0.0f;
        { LAS unsigned char* pp = col + r0 * LRU_PITCH;
#pragma unroll 8
          for (int i = 0; i < 64; ++i) { const unsigned w = *(LAS unsigned*)pp; pp += rstep; const float a = __builtin_amdgcn_exp2f(bf_lo(w)); H = a * H + bf_hi(w); P *= a; } }
        LAS f32x2* xch = (LAS f32x2*)(lds + LRU_XCH);
        xch[(dir * 4 + seg) * 64 + cu] = (f32x2){P, H};
        LDS_WAIT(); __builtin_amdgcn_s_barrier(); asm volatile("" ::: "memory");
        if constexpr (PASS == 1) {
            if (seg == 0) {
                float Pt = 1.0f, Ht = 0.0f;
#pragma unroll
                for (int s = 0; s < 4; ++s) { const f32x2 v = xch[(dir * 4 + (dir ? 3 - s : s)) * 64 + cu]; Ht = v.x * Ht + v.y; Pt *= v.x; }
                *(f32x2*)(TIL + ((size_t)(u.pm * 2 + dir) * DM + ch) * 2) = (f32x2){Pt, Ht};
            }
        } else {
            float h = 0.0f;
            const int pb = u.pm & ~31;
            if (dir == 0) { for (int q = pb; q < u.pm; ++q) { const f32x2 v = *(const f32x2*)(TIL + ((size_t)(q * 2 + 0) * DM + ch) * 2); h = v.x * h + v.y; } }
            else { for (int q = pb + 31; q > u.pm; --q) { const f32x2 v = *(const f32x2*)(TIL + ((size_t)(q * 2 + 1) * DM + ch) * 2); h = v.x * h + v.y; } }
            if (dir == 0) { for (int s = 0; s < seg; ++s) { const f32x2 v = xch[(0 * 4 + s) * 64 + cu]; h = v.x * h + v.y; } }
            else { for (int s = 3; s > seg; --s) { const f32x2 v = xch[(1 * 4 + s) * 64 + cu]; h = v.x * h + v.y; } }
            { LAS unsigned char* pp = col + r0 * LRU_PITCH;
#pragma unroll 8
              for (int i = 0; i < 64; ++i) { const unsigned w = *(LAS unsigned*)pp; const float a = __builtin_amdgcn_exp2f(bf_lo(w)); h = a * h + bf_hi(w); *(LAS float*)pp = h; pp += rstep; } }
            LDS_WAIT(); __builtin_amdgcn_s_barrier(); asm volatile("" ::: "memory");
            const int qd = tid & 15, rg = tid >> 4;
#pragma unroll 4
            for (int i = 0; i < 8; ++i) {
                const int rl = i * 32 + rg, row = u.pm * 256 + rl;
                const f32x4 hf = *(const LAS f32x4*)(lds + rl * LRU_PITCH + qd * 16), hb = *(const LAS f32x4*)(lds + rl * LRU_PITCH + 256 + qd * 16);
                const size_t off = (size_t)row * DM + 256 * n + 64 * qq + 4 * qd;
                const u32x2 sg = *(const u32x2*)(SGL + off);
                u32x2 y; y.x = cvt_pk_bf16((hf[0] + hb[0]) * bf_lo(sg.x), (hf[1] + hb[1]) * bf_hi(sg.x)); y.y = cvt_pk_bf16((hf[2] + hb[2]) * bf_lo(sg.y), (hf[3] + hb[3]) * bf_hi(sg.y));
                *(u32x2*)(YL + off) = y;
            }
        }
        LDS_WAIT(); __builtin_amdgcn_s_barrier(); asm volatile("" ::: "memory");
    }
};

__device__ __forceinline__ void final_norm(Frame& F, float* out, const float* ss, const float* g) {
    const int gw = F.vcu * 8 + F.wave, NGW = F.G * 8;
    f32x4 gv[4];
#pragma unroll
    for (int j = 0; j < 4; ++j) gv[j] = ((const f32x4*)g)[F.lane + 64 * j];
    for (int m = gw; m < M; m += NGW) {
        const float rstd = 1.0f / sqrtf(ss[m] * (1.0f / DM) + NORM_EPS);
        f32x4* xr = (f32x4*)(out + (size_t)m * DM) + F.lane;
#pragma unroll
        for (int j = 0; j < 4; ++j) { const f32x4 v = xr[64 * j]; xr[64 * j] = v * rstd * gv[j]; }
    }
}

constexpr int N_PHASES = 16;
__global__ void __launch_bounds__(512, 2) hybrid_fwd(Args args) {
    extern __shared__ __attribute__((aligned(16))) unsigned char lds_raw[];
    Frame F;
    F.lds = (LAS unsigned char*)lds_raw;
    F.tid = threadIdx.x; F.lane = F.tid & 63; F.wave = __builtin_amdgcn_readfirstlane(F.tid >> 6);
    F.G = gridDim.x; { const int bx = blockIdx.x; F.vcu = (F.G % 8 == 0) ? (bx % 8) * (F.G / 8) + bx / 8 : bx; }
    F.ws = args.ws; F.ctl = (unsigned*)(args.ws + WS_CTL);
    volatile LAS unsigned* MISC = (volatile LAS unsigned*)(F.lds + LDSCTL_OFF);
    if (F.tid < 64) MISC[F.tid] = 0u;
    __syncthreads();
    XcdBarrier bar; bar.bar = F.ctl + CW_BAR; bar.x = 0; bar.st = nullptr;
    if (MK_N_LAUNCHES == 1) bar = xcd_barrier_post(F.ctl + CW_BAR, MISC + 8);
    bf16_t* Wb = (bf16_t*)(F.ws + WS_W);
    float* ss = (float*)(F.ctl + CW_SS);

#ifndef PHMASK
#define PHMASK 0x3ff
#endif
    for (int ph = args.ph_lo; ph < args.ph_hi; ++ph) {
        { int tv = threadIdx.x; asm volatile("" : "+v"(tv)); F.tid = tv; F.lane = tv & 63; F.wave = __builtin_amdgcn_readfirstlane(tv >> 6); }
        if (ph == 0) { if (PHMASK & 1) p0_prologue(F, args); }
        else if (ph == 15) { if (PHMASK & 2) final_norm(F, args.out, ss + 2 * M, args.in[14]); }
        else {
            const int l = (ph - 1) / 7, sub = (ph - 1) % 7;
            const bf16_t* XB = (const bf16_t*)(F.ws + WS_XB);
            if (sub == 0 && (PHMASK & 4)) {
                pg8::Gemm g{XB, Wb + W_IN_T / 2 + (size_t)l * NIN * DM, DM, DM, DM};
                pg8::StaticOrder S; S.init(M, NCOL_A, F.G, (int)blockIdx.x, DM, DM);
                EpiProjA E{F.ws, ss + l * M};
                pg8::gemm_phase(fresh(threadIdx.x), F.lds, g, S, E);
            } else if (sub == 1 && (PHMASK & 8)) {
#ifdef NAIVE_ATTN
                attn_naive(F);
#else
                attn_phase(F);
#endif
            } else if (sub == 2 && (PHMASK & 16)) {
                pg8::Gemm g{XB, Wb + W_IN_T / 2 + ((size_t)l * NIN + NCOL_A) * DM, DM, DM, DM};
                pg8::StaticOrder S; S.init(M, NCOL_B, F.G, (int)blockIdx.x, DM, DM);
                EpiProjB E{F.ws, ss + l * M, args.in[3] + l * 2048};
                pg8::gemm_phase(fresh(threadIdx.x), F.lds, g, S, E);
            } else if ((sub == 3 && (PHMASK & 32)) || (sub == 4 && (PHMASK & 64))) {
                for (int task = F.vcu; task < 256; task += F.G) {
                    const int pm = task >> 2, n = task & 3;
                    if (sub == 3) { lru_conv(F, pm, n, args.in[4] + l * 4 * DM, args.in[5] + l * DM); VM_WAIT(); __syncthreads(); }
                    for (int qq = 0; qq < 4; ++qq) {
                        pg8::Gemm g{XB, Wb + W_RG_T / 2, DM, 256, 256};
                        pg8::SingleUnit S; S.u0.pm = pm; S.u0.pn = qq; S.u0.abyte = (pm * 256 * DM + n * 256) * 2; S.u0.bbyte = ((l * 4 + n) * 4 + qq) * 65536 * 2;
                        if (sub == 3) { EpiLru<1> E{XB, args.in[7] + l * 2048, args.in[9] + l * 2048, args.in[10] + l * 2048, (float*)(F.ws + WS_TIL), nullptr, nullptr, n, qq}; pg8::gemm_phase(fresh(threadIdx.x), F.lds, g, S, E); }
                        else { EpiLru<2> E{XB, args.in[7] + l * 2048, args.in[9] + l * 2048, args.in[10] + l * 2048, (float*)(F.ws + WS_TIL), (const bf16_t*)(F.ws + WS_SGL), (bf16_t*)(F.ws + WS_XLRU), n, qq}; pg8::gemm_phase(fresh(threadIdx.x), F.lds, g, S, E); }
                    }
                    if (sub == 4) attn_mix(F, pm, n);
                }
            } else if (sub == 5 && (PHMASK & 128)) {
                { pg8::Gemm g{(const bf16_t*)(F.ws + WS_SGA), Wb + W_OATT_T / 2 + (size_t)l * DM * 512, 512, 512, 512};
                  pg8::StaticOrder S; S.init(M, DM, F.G, (int)blockIdx.x, 512, 512);
                  EpiMerge<true> E{(bf16_t*)(F.ws + WS_Q), (const bf16_t*)(F.ws + WS_GATE)};
                  pg8::gemm_phase(fresh(threadIdx.x), F.lds, g, S, E); }
                VM_WAIT(); __syncthreads();
                { pg8::Gemm g{(const bf16_t*)(F.ws + WS_XLRU), Wb + W_OLRU_T / 2 + (size_t)l * DM * DM, DM, DM, DM};
                  pg8::StaticOrder S; S.init(M, DM, F.G, (int)blockIdx.x, DM, DM);
                  EpiMerge<false> E{(bf16_t*)(F.ws + WS_Q), (const bf16_t*)(F.ws + WS_GATE) + 1024};
                  pg8::gemm_phase(fresh(threadIdx.x), F.lds, g, S, E); }
            } else if (sub == 6 && (PHMASK & 256)) {
                pg8::Gemm g{(const bf16_t*)(F.ws + WS_Q), Wb + W_OUT_T / 2 + (size_t)l * DM * DM, DM, DM, DM};
                pg8::StaticOrder S; S.init(M, DM, F.G, (int)blockIdx.x, DM, DM);
                EpiResid E{l == 0 ? args.in[0] : args.out, args.out, (bf16_t*)(F.ws + WS_XB), ss + (l + 1) * M};
                pg8::gemm_phase(fresh(threadIdx.x), F.lds, g, S, E);
            }
        }
        if (ph + 1 < args.ph_hi) xcd_barrier(bar);
    }
}

extern "C" void kernel_launch(void* const* d_in, const int* in_sizes, int n_in, void* d_out, int out_size, void* d_ws, size_t ws_size, hipStream_t stream) {
    static int grid = 0;
    if (grid == 0) {
        if (n_in != 15 || in_sizes[0] != M * DM || out_size != M * DM || ws_size < WS_END) { fprintf(stderr, "kernel_launch: unexpected shapes / workspace (%d inputs, ws %zu < %zu)\n", n_in, ws_size, (size_t)WS_END); grid = -1; return; }
        int dev = 0, cus = 0, per_cu = 0;
        if (hipGetDevice(&dev) != hipSuccess || hipDeviceGetAttribute(&cus, hipDeviceAttributeMultiprocessorCount, dev) != hipSuccess) { grid = -1; return; }
        if (hipFuncSetAttribute((const void*)hybrid_fwd, hipFuncAttributeMaxDynamicSharedMemorySize, LDS_BYTES) != hipSuccess) { fprintf(stderr, "kernel_launch: hipFuncSetAttribute failed\n"); grid = -1; return; }
        if (hipOccupancyMaxActiveBlocksPerMultiprocessor(&per_cu, (const void*)hybrid_fwd, 512, LDS_BYTES) != hipSuccess || per_cu < 1) { fprintf(stderr, "kernel_launch: occupancy query says %d\n", per_cu); grid = -1; return; }
        (void)hipGetLastError();
        grid = cus;
    }
    if (grid < 0) return;
    (void)hipMemsetAsync((char*)d_ws + WS_CTL, 0, CTL_ZERO_BYTES, stream);
    Args a{};
    for (int i = 0; i < 15; ++i) a.in[i] = (const float*)d_in[i];
    a.out = (float*)d_out; a.ws = (unsigned char*)d_ws;
    if (MK_N_LAUNCHES == 1) { a.ph_lo = 0; a.ph_hi = N_PHASES; a.li = 0; hipLaunchKernelGGL(hybrid_fwd, dim3(grid), dim3(512), LDS_BYTES, stream, a); }
    else for (int ph = 0; ph < N_PHASES; ++ph) { a.ph_lo = ph; a.ph_hi = ph + 1; a.li = ph; hipLaunchKernelGGL(hybrid_fwd, dim3(grid), dim3(512), LDS_BYTES, stream, a); }
}
```

```cpp
#include <hip/hip_runtime.h>
#include <cstdio>
#include <cstdint>

#ifndef MK_N_LAUNCHES
#define MK_N_LAUNCHES 1
#endif

#define LAS __attribute__((address_space(3)))
#define GAS __attribute__((address_space(1)))
typedef unsigned short bf16_t;
typedef short bf16x8 __attribute__((ext_vector_type(8)));
typedef float f32x4 __attribute__((ext_vector_type(4)));
typedef float f32x2 __attribute__((ext_vector_type(2)));
typedef unsigned u32x4 __attribute__((ext_vector_type(4)));
typedef unsigned u32x2 __attribute__((ext_vector_type(2)));

constexpr int BATCH = 2, SEQ = 8192, DM = 1024, M = BATCH * SEQ, DEPTH = 2;
constexpr int NIN = 9216, NH = 12, HD = 128;
constexpr int NCOL_A = 5120, NCOL_B = 4096;
constexpr float LOG2E = 1.4426950408889634f;
constexpr float QSCALE = 0.08838834764831845f * LOG2E;
constexpr float NORM_EPS = 1e-6f;

constexpr size_t MiB = 1u << 20;
constexpr size_t WS_CTL = 0, CTL_ZERO_BYTES = 1 * MiB;
constexpr size_t WS_LSE = 1 * MiB;
constexpr size_t WS_TIL = 2 * MiB;
constexpr size_t WS_W   = 8 * MiB;
constexpr size_t W_IN_T = 0;
constexpr size_t W_OATT_T = W_IN_T + (size_t)2 * NIN * DM * 2;
constexpr size_t W_OLRU_T = W_OATT_T + (size_t)2 * DM * 512 * 2;
constexpr size_t W_OUT_T  = W_OLRU_T + (size_t)2 * DM * DM * 2;
constexpr size_t W_RG_T   = W_OUT_T + (size_t)2 * DM * DM * 2;
constexpr size_t W_END    = W_RG_T + (size_t)2 * 16 * 65536 * 2;
static_assert(W_END == 50 * MiB, "weight map");
constexpr size_t WS_XB  = 58 * MiB;
constexpr size_t WS_Q   = 90 * MiB;
constexpr size_t WS_K   = 138 * MiB;
constexpr size_t WS_V   = 186 * MiB;
constexpr size_t WS_XLRU = WS_K;
constexpr size_t WS_SGL  = WS_K + 32 * MiB;
constexpr size_t WS_GATE = WS_K + 64 * MiB;
constexpr size_t WS_SGA  = 266 * MiB;
constexpr size_t WS_END  = 282 * MiB;
static_assert(WS_V - WS_K == WS_K - WS_Q, "q/k/v spacing");
constexpr int CW_BAR = 4096;
constexpr int CW_TMO = 0;
constexpr int CW_CNT = 16384;
constexpr int CW_SS = 65536;
static_assert((CW_SS + 3 * M) * 4 <= (int)CTL_ZERO_BYTES, "ctl");

constexpr int RING_BYTES = 131072;
constexpr int LRU_PITCH = 528;
constexpr int LRU_IMG = 256 * LRU_PITCH;
constexpr int LRU_XCH = LRU_IMG;
constexpr int LDSCTL_OFF = 147456;
constexpr int LDS_BYTES = 148480;
static_assert(LRU_XCH + 4096 <= LDSCTL_OFF, "lds");

#define RLX_AGENT __ATOMIC_RELAXED, __HIP_MEMORY_SCOPE_AGENT
#define LDS_WAIT() asm volatile("s_waitcnt lgkmcnt(0)" ::: "memory")
#define VM_WAIT() asm volatile("s_waitcnt vmcnt(0)" ::: "memory")

__device__ __forceinline__ unsigned cvt_pk_bf16(float lo, float hi) { unsigned r; asm volatile("v_cvt_pk_bf16_f32 %0, %1, %2" : "=v"(r) : "v"(lo), "v"(hi)); return r; }
__device__ __forceinline__ float bf_lo(unsigned w) { return __uint_as_float(w << 16); }
__device__ __forceinline__ float bf_hi(unsigned w) { return __uint_as_float(w & 0xffff0000u); }
__device__ __forceinline__ float fast_sigmoid(float v) { return __builtin_amdgcn_rcpf(1.0f + __builtin_amdgcn_exp2f(-LOG2E * v)); }
__device__ __forceinline__ float fast_silu(float v) { return v * fast_sigmoid(v); }

namespace pg8 {
constexpr int BM = 256, BK = 64, HALF = 128, HTB = HALF * BK * 2, STAGE_BYTES = 8 * HTB, NXCD = 8, WGM = 8;
__host__ __device__ __forceinline__ int lds_byte(int r, int c) { const int st = (r >> 4) * 2 + (c >> 5), rr = r & 15, cc = c & 31, ob = rr * 64 + cc * 2; return st * 1024 + (ob ^ (((ob >> 9) & 1) << 5)); }
__host__ __device__ __forceinline__ void stage_rc(int b, int& R, int& C) { const int st = b / 1024, sb = b % 1024, swz = sb ^ (((sb >> 9) & 1) << 5); R = (st >> 1) * 16 + swz / 64; C = (st & 1) * 32 + (swz % 64) / 2; }
__host__ __device__ __forceinline__ int perm32(int rho) { const int n = rho >> 4, i = rho & 15; return 8 * (i >> 2) + 4 * n + (i & 3); }

struct Unit { int pm, pn; int abyte, bbyte; };
struct Gemm { const bf16_t* A; const bf16_t* Bt; int lda, ldb, K; };

struct StaticOrder {
    int nM, nN, nwg, G, c, ta, tb;
    __device__ void init(int Mr, int N, int G_, int c_, int lda, int ldb) { nM = Mr / BM; nN = N / BM; nwg = nM * nN; G = G_; c = c_; ta = BM * lda * 2; tb = BM * ldb * 2; }
    __device__ bool next(int i, Unit& u) const {
        const long L = (long)i * G + c; if (L >= nwg) return false;
        int wgid = (int)L; { const int q = nwg / NXCD, r = nwg % NXCD, xcd = wgid % NXCD, off = wgid / NXCD; wgid = (xcd < r ? xcd * (q + 1) : r * (q + 1) + (xcd - r) * q) + off; }
        const int nig = WGM * nN, gid = wgid / nig, fm = gid * WGM, gsz = (nM - fm) < WGM ? (nM - fm) : WGM;
        u.pm = fm + ((wgid % nig) % gsz); u.pn = (wgid % nig) / gsz; u.abyte = u.pm * ta; u.bbyte = u.pn * tb; return true;
    }
};
struct SingleUnit {
    Unit u0;
    __device__ bool next(int i, Unit& u) const { if (i != 0) return false; u = u0; return true; }
};

template <class Epi, class Sched>
__device__ __forceinline__ void gemm_phase(int tid_in, LAS unsigned char* lds, const Gemm g, const Sched& S, const Epi& E) {
    int tid = tid_in; asm volatile("" : "+v"(tid));
    const int wid = __builtin_amdgcn_readfirstlane(tid >> 6), lane = tid & 63, wr = wid >> 2, wc = wid & 3, fr = lane & 15, fq = lane >> 4;
    const int K = g.K, nt = K / BK;
    unsigned voffA[2], voffB[2];
#pragma unroll
    for (int i = 0; i < 2; ++i) { int R, C; stage_rc(tid * 16 + i * 8192, R, C); const int Rb = Epi::PERM ? ((R & ~31) + perm32(R & 31)) : R;
        voffA[i] = (unsigned)(R * g.lda + C) * 2u; voffB[i] = (unsigned)(Rb * g.ldb + C) * 2u; }
    const int kstep = BK * 2;
    const int hstepA = HALF * g.lda * 2, hstepB = HALF * g.ldb * 2;
    const __amdgpu_buffer_rsrc_t rsA = __builtin_amdgcn_make_buffer_rsrc((void*)g.A, 0, 0x7ffffff0, 0x00020000);
    const __amdgpu_buffer_rsrc_t rsB = __builtin_amdgcn_make_buffer_rsrc((void*)g.Bt, 0, 0x7ffffff0, 0x00020000);
    const unsigned ldsw = (unsigned)wid * 1024u;
    const int aoff = lds_byte(wr * 64 + fr, fq * 8), boff = lds_byte(wc * 32 + fr, fq * 8);
#define PG8_SA(b, h) (((b) * 2 + (h)) * HTB)
#define PG8_SB(b, h) ((4 + (b) * 2 + (h)) * HTB)
#define PG8_STAGEA(bufoff, soff) do { _Pragma("unroll") for (int _i = 0; _i < 2; ++_i) \
        __builtin_amdgcn_raw_ptr_buffer_load_lds(rsA, (LAS void*)(lds + (bufoff) + ldsw + _i * 8192), 16, (int)voffA[_i], (soff), 0, 0); } while (0)
#define PG8_STAGEB(bufoff, soff) do { _Pragma("unroll") for (int _i = 0; _i < 2; ++_i) \
        __builtin_amdgcn_raw_ptr_buffer_load_lds(rsB, (LAS void*)(lds + (bufoff) + ldsw + _i * 8192), 16, (int)voffB[_i], (soff), 0, 0); } while (0)
#define PG8_LDA(dst, b, h) do { _Pragma("unroll") for (int m = 0; m < 4; ++m) _Pragma("unroll") for (int k = 0; k < 2; ++k) dst[m][k] = *(const LAS bf16x8*)(lds + PG8_SA(b, h) + aoff + m * 2048 + k * 1024); } while (0)
#define PG8_LDB(dst, b, h) do { _Pragma("unroll") for (int n = 0; n < 2; ++n) _Pragma("unroll") for (int k = 0; k < 2; ++k) dst[n][k] = *(const LAS bf16x8*)(lds + PG8_SB(b, h) + boff + n * 2048 + k * 1024); } while (0)
#define PG8_MMA(ai, bj, At, Bt) do { __builtin_amdgcn_s_setprio(1); _Pragma("unroll") for (int m = 0; m < 4; ++m) _Pragma("unroll") for (int n = 0; n < 2; ++n) _Pragma("unroll") for (int k = 0; k < 2; ++k) \
        acc[ai][bj][m][n] = __builtin_amdgcn_mfma_f32_16x16x32_bf16(Bt[n][k], At[m][k], acc[ai][bj][m][n], 0, 0, 0); __builtin_amdgcn_s_setprio(0); } while (0)
#define PG8_WAIT_V(n) asm volatile("s_waitcnt vmcnt(" #n ")" ::: "memory")
#define PG8_WAIT_L(n) asm volatile("s_waitcnt lgkmcnt(" #n ")" ::: "memory")
#define PG8_BAR __builtin_amdgcn_s_barrier()
#define PG8_SCHED __builtin_amdgcn_sched_barrier(0)
    Unit cur, nxt; int ui = 0;
    if (!S.next(0, cur)) return;
    f32x4 acc[2][2][4][2];
#pragma unroll
    for (int a = 0; a < 2; ++a)
#pragma unroll
        for (int b = 0; b < 2; ++b)
#pragma unroll
            for (int m = 0; m < 4; ++m)
#pragma unroll
                for (int n = 0; n < 2; ++n) acc[a][b][m][n] = (f32x4){0.f, 0.f, 0.f, 0.f};
    bf16x8 At[4][2], B0[2][2], B1[2][2];
    int cA = cur.abyte, cB = cur.bbyte;
    PG8_STAGEB(PG8_SB(0, 0), cB); PG8_STAGEB(PG8_SB(0, 1), cB + hstepB); PG8_STAGEA(PG8_SA(0, 0), cA); PG8_STAGEA(PG8_SA(0, 1), cA + hstepA);
    if (wr == 1) PG8_BAR;
    PG8_WAIT_V(2); PG8_BAR;
    PG8_STAGEB(PG8_SB(1, 0), cB + kstep); PG8_STAGEA(PG8_SA(1, 0), cA + kstep); PG8_STAGEB(PG8_SB(1, 1), cB + hstepB + kstep);
    PG8_WAIT_V(6); PG8_BAR;
    for (;;) {
        const bool has_next = S.next(ui + 1, nxt);
        const int nA = has_next ? nxt.abyte : cA, nB = has_next ? nxt.bbyte : cB;
#pragma unroll 1
        for (int t = 0; t < nt; t += 2) {
            const bool last = (t == nt - 2);
            const int a1 = cA + (t + 1) * kstep;
            const int a2 = last ? nA : cA + (t + 2) * kstep, b2 = last ? nB : cB + (t + 2) * kstep;
            const int a3 = a2 + kstep, b3 = b2 + kstep;
            PG8_LDB(B0, 0, 0); PG8_LDB(B1, 0, 1); PG8_SCHED; PG8_LDA(At, 0, 0); PG8_STAGEA(PG8_SA(1, 1), a1 + hstepA);
            PG8_WAIT_V(8); PG8_WAIT_L(0); PG8_BAR; PG8_MMA(0, 0, At, B0); PG8_MMA(0, 1, At, B1); PG8_BAR; PG8_SCHED;
            PG8_LDA(At, 0, 1); PG8_STAGEB(PG8_SB(0, 0), b2); PG8_STAGEB(PG8_SB(0, 1), b2 + hstepB); PG8_STAGEA(PG8_SA(0, 0), a2);
            PG8_WAIT_V(8); PG8_WAIT_L(0); PG8_BAR; PG8_MMA(1, 0, At, B0); PG8_MMA(1, 1, At, B1); PG8_BAR; PG8_SCHED;
            PG8_LDB(B0, 1, 0); PG8_LDB(B1, 1, 1); PG8_SCHED; PG8_LDA(At, 1, 0); PG8_STAGEA(PG8_SA(0, 1), a2 + hstepA);
            PG8_WAIT_V(8); PG8_WAIT_L(0); PG8_BAR; PG8_MMA(0, 0, At, B0); PG8_MMA(0, 1, At, B1); PG8_BAR; PG8_SCHED;
            PG8_LDA(At, 1, 1); PG8_STAGEB(PG8_SB(1, 0), b3); PG8_STAGEB(PG8_SB(1, 1), b3 + hstepB); PG8_STAGEA(PG8_SA(1, 0), a3);
            PG8_WAIT_V(8); PG8_WAIT_L(0); PG8_BAR; PG8_MMA(1, 0, At, B0); PG8_MMA(1, 1, At, B1); PG8_BAR; PG8_SCHED;
        }
        if constexpr (!Epi::AFTER_DRAIN) { if (wr == 0) PG8_BAR; int l2 = lane; asm volatile("" : "+v"(l2)); int w2 = wid; asm volatile("" : "+s"(w2)); E(acc, cur, w2 >> 2, w2 & 3, l2 & 15, l2 >> 4); }
        if (!has_next) break;
#pragma unroll
        for (int a = 0; a < 2; ++a)
#pragma unroll
            for (int b = 0; b < 2; ++b)
#pragma unroll
                for (int m = 0; m < 4; ++m)
#pragma unroll
                    for (int n = 0; n < 2; ++n) acc[a][b][m][n] = (f32x4){0.f, 0.f, 0.f, 0.f};
        cur = nxt; cA = nA; cB = nB; ++ui;
        if constexpr (!Epi::AFTER_DRAIN) { if (wr == 1) PG8_BAR; }
    }
    PG8_WAIT_V(0);
    if constexpr (Epi::AFTER_DRAIN) { if (wr == 0) PG8_BAR; }
    PG8_BAR;
    if constexpr (Epi::AFTER_DRAIN) { int l2 = lane; asm volatile("" : "+v"(l2)); int w2 = wid; asm volatile("" : "+s"(w2)); E.fused(acc, cur, w2 >> 2, w2 & 3, l2 & 15, l2 >> 4, lds, w2, l2); }
#undef PG8_SA
#undef PG8_SB
#undef PG8_STAGEA
#undef PG8_STAGEB
#undef PG8_LDA
#undef PG8_LDB
#undef PG8_MMA
#undef PG8_WAIT_V
#undef PG8_WAIT_L
#undef PG8_BAR
#undef PG8_SCHED
}
}

#define XB_TMO      128
#define XB_XCNT(j)  (256  + 64 * (j))
#define XB_XSUB(j)  (1280 + 64 * (j))
#define XB_XGEN(j)  (2304 + 64 * (j))
#define XB_TOP      3328
#define XB_TOPGEN   3392
#define XCD_BAR_WORDS 3456
#define XB_SPIN_CAP (1u << 18)
__device__ __forceinline__ unsigned xb_ld(unsigned* p)              { return __hip_atomic_load(p, __ATOMIC_RELAXED, __HIP_MEMORY_SCOPE_AGENT); }
__device__ __forceinline__ unsigned xb_add(unsigned* p, unsigned v) { return __hip_atomic_fetch_add(p, v, __ATOMIC_RELAXED, __HIP_MEMORY_SCOPE_AGENT); }
__device__ __forceinline__ unsigned xb_xcc_id() { return (unsigned)__builtin_amdgcn_s_getreg((3 << 11) | 20) & 0xFu; }
#define XB_SPIN(cond, bar) do { unsigned _sp = 0; while (cond) { __builtin_amdgcn_s_sleep(1); \
    if ((++_sp & 255u) == 0u) { if (xb_ld(&(bar)[XB_TMO])) break; if (_sp > XB_SPIN_CAP) { atomicAdd(&(bar)[XB_TMO], 1u); break; } } } } while (0)
struct XcdBarrier { unsigned* bar; unsigned x; volatile LAS unsigned* st; };
__device__ __forceinline__ XcdBarrier xcd_barrier_post(unsigned* bar, volatile LAS unsigned* st) {
    XcdBarrier b; b.bar = bar; b.x = xb_xcc_id(); b.st = st;
    if (threadIdx.x == 0) (void)xb_add(&bar[XB_XCNT(b.x)], 1u);
    return b;
}
__device__ __forceinline__ void xcd_barrier_complete(unsigned* bar, unsigned x, unsigned& nloc, unsigned& nx) {
    const unsigned G = gridDim.x * gridDim.y * gridDim.z;
    unsigned sum, cnt, mine, sp = 0u;
    for (;;) {
        sum = 0u; cnt = 0u; mine = 0u;
#pragma unroll
        for (unsigned j = 0; j < 16; ++j) { const unsigned c = xb_ld(&bar[XB_XCNT(j)]); sum += c; cnt += (c > 0u) ? 1u : 0u; mine = (j == x) ? c : mine; }
        if (sum == G) break;
        __builtin_amdgcn_s_sleep(1);
        if ((++sp & 255u) == 0u) { if (xb_ld(&bar[XB_TMO])) break; if (sp > XB_SPIN_CAP) { atomicAdd(&bar[XB_TMO], 1u); break; } }
    }
    nloc = mine > 0u ? mine : 1u; nx = cnt > 0u ? cnt : 1u;
}
__device__ __forceinline__ void xcd_barrier(const XcdBarrier& b) {
    asm volatile("s_waitcnt vmcnt(0)" ::: "memory");
    __syncthreads();
    if (threadIdx.x == 0) {
        unsigned* bar = b.bar;
        __builtin_amdgcn_s_waitcnt(0);
        unsigned nloc = b.st[0], nx = b.st[1];
        if (nloc == 0u) { xcd_barrier_complete(bar, b.x, nloc, nx); b.st[0] = nloc; b.st[1] = nx; }
        const unsigned old = xb_add(&bar[XB_XSUB(b.x)], 1u);
        const unsigned gen = old / nloc;
        if (old + 1u == (gen + 1u) * nloc) {
            __builtin_amdgcn_fence(__ATOMIC_RELEASE, "agent");
            asm volatile("s_waitcnt vmcnt(0)" ::: "memory");
            const unsigned og = xb_add(&bar[XB_TOP], 1u);
            const unsigned tg = og / nx;
            if (og + 1u == (tg + 1u) * nx) xb_add(&bar[XB_TOPGEN], 1u);
            else XB_SPIN(xb_ld(&bar[XB_TOPGEN]) == tg, bar);
            __builtin_amdgcn_fence(__ATOMIC_ACQUIRE, "agent");
            xb_add(&bar[XB_XGEN(b.x)], 1u);
            asm volatile("s_waitcnt vmcnt(0)" ::: "memory");
        } else {
            XB_SPIN(xb_ld(&bar[XB_XGEN(b.x)]) == gen, bar);
            __builtin_amdgcn_fence(__ATOMIC_ACQUIRE, "agent");
            asm volatile("s_waitcnt vmcnt(0)" ::: "memory");
        }
    }
    __syncthreads();
}

struct Frame {
    LAS unsigned char* lds;
    unsigned* ctl;
    int tid, lane, wave, vcu, G;
    unsigned char* ws;
};
struct Args { const float* in[15]; float* out; unsigned char* ws; int ph_lo, ph_hi, li, pad; };

__device__ __forceinline__ int fresh(int v) { asm volatile("" : "+v"(v)); return v; }
__device__ __forceinline__ float wave_sum(float v) {
#pragma unroll
    for (int o = 1; o < 64; o <<= 1) v += __shfl_xor(v, o);
    return v;
}
__device__ __forceinline__ float wave_max(float v) {
#pragma unroll
    for (int o = 1; o < 64; o <<= 1) v = fmaxf(v, __shfl_xor(v, o));
    return v;
}

template <class RowFn>
__device__ __forceinline__ void p0_transpose_item(const float* W, int K, int N, const float* kscale, const RowFn& rowptr, LAS float* scr, int item, int lane) {
    const int nblk = N / 32, kb = item / nblk, nb = item % nblk, k0 = 64 * kb, n0 = 32 * nb;
#pragma unroll 8
    for (int i = 0; i < 32; ++i) { const int kk = 2 * i + (lane >> 5); const float sc = kscale ? kscale[k0 + kk] : 1.0f; scr[kk * 33 + (lane & 31)] = W[(size_t)(k0 + kk) * N + n0 + (lane & 31)] * sc; }
    LDS_WAIT(); asm volatile("" ::: "memory");
    const int c = lane & 7;
#pragma unroll
    for (int j = 0; j < 4; ++j) { const int n = (lane >> 3) + 8 * j; const LAS float* s = scr + (8 * c) * 33 + n;
        u32x4 o; o.x = cvt_pk_bf16(s[0 * 33], s[1 * 33]); o.y = cvt_pk_bf16(s[2 * 33], s[3 * 33]); o.z = cvt_pk_bf16(s[4 * 33], s[5 * 33]); o.w = cvt_pk_bf16(s[6 * 33], s[7 * 33]);
        *(u32x4*)(rowptr(n0 + n) + k0 + 8 * c) = o; }
    LDS_WAIT(); asm volatile("" ::: "memory");
}

__device__ __forceinline__ void p0_prologue(Frame& F, const Args& a) {
    LAS float* scr = (LAS float*)(F.lds + F.wave * 16384);
    const int gw = F.vcu * 8 + F.wave, NGW = F.G * 8;
    bf16_t* Wb = (bf16_t*)(F.ws + WS_W);
    constexpr int I_IN = (DM / 64) * (NIN / 32), I_OA = (512 / 64) * (DM / 32), I_OL = (DM / 64) * (DM / 32), I_RG = (256 / 64) * (256 / 32);
    constexpr int PER_LAYER = I_IN + I_OA + 2 * I_OL + 16 * I_RG;
    for (int it = gw; it < DEPTH * PER_LAYER; it += NGW) {
        const int l = it / PER_LAYER; int r = it % PER_LAYER;
        if (r < I_IN) { bf16_t* dst = Wb + W_IN_T / 2 + (size_t)l * NIN * DM;
            p0_transpose_item(a.in[2] + (size_t)l * DM * NIN, DM, NIN, a.in[1] + l * DM, [=](int n) { return dst + (size_t)n * DM; }, scr, r, F.lane); continue; } r -= I_IN;
        if (r < I_OA) { bf16_t* dst = Wb + W_OATT_T / 2 + (size_t)l * DM * 512;
            p0_transpose_item(a.in[11] + (size_t)l * 512 * DM, 512, DM, nullptr, [=](int n) { return dst + (size_t)n * 512; }, scr, r, F.lane); continue; } r -= I_OA;
        if (r < I_OL) { bf16_t* dst = Wb + W_OLRU_T / 2 + (size_t)l * DM * DM;
            p0_transpose_item(a.in[12] + (size_t)l * DM * DM, DM, DM, nullptr, [=](int n) { return dst + (size_t)n * DM; }, scr, r, F.lane); continue; } r -= I_OL;
        if (r < I_OL) { bf16_t* dst = Wb + W_OUT_T / 2 + (size_t)l * DM * DM;
            p0_transpose_item(a.in[13] + (size_t)l * DM * DM, DM, DM, nullptr, [=](int n) { return dst + (size_t)n * DM; }, scr, r, F.lane); continue; } r -= I_OL;
        {
            const int s = r / I_RG, item = r % I_RG, dir = s >> 3, kind = (s >> 2) & 1, n = s & 3;
            const float* src = (kind ? a.in[8] : a.in[6]) + ((size_t)((l * 2 + dir) * 4 + n)) * 65536;
            bf16_t* dst = Wb + W_RG_T / 2 + (size_t)(l * 4 + n) * 4 * 65536;
            p0_transpose_item(src, 256, 256, nullptr, [=](int j) { return dst + (size_t)(j >> 6) * 65536 + (size_t)(128 * dir + 32 * ((j >> 4) & 3) + 16 * kind + (j & 15)) * 256; }, scr, item, F.lane);
        }
    }
    const float* x = a.in[0]; bf16_t* XB = (bf16_t*)(F.ws + WS_XB); float* ss = (float*)(F.ctl + CW_SS);
    for (int m = gw; m < M; m += NGW) {
        const f32x4* xr = (const f32x4*)(x + (size_t)m * DM) + F.lane; float s = 0.f;
        unsigned long long* o8 = (unsigned long long*)(XB + (size_t)m * DM) + F.lane;
#pragma unroll
        for (int j = 0; j < 4; ++j) { const f32x4 v = xr[64 * j]; s += (v.x * v.x + v.y * v.y) + (v.z * v.z + v.w * v.w);
            o8[64 * j] = (unsigned long long)cvt_pk_bf16(v.x, v.y) | ((unsigned long long)cvt_pk_bf16(v.z, v.w) << 32); }
        s = wave_sum(s);
        if (F.lane == 0) ss[m] = s;
    }
}

struct EpiProjA {
    static constexpr bool PERM = true, AFTER_DRAIN = false;
    unsigned char* ws; const float* ss;
    __device__ __forceinline__ void operator()(const f32x4 (&acc)[2][2][4][2], const pg8::Unit& u, int wr, int wc, int fr, int fq) const {
        const int kind = u.pn / 6;
        float rs[2][4];
#pragma unroll
        for (int ai = 0; ai < 2; ++ai)
#pragma unroll
            for (int m = 0; m < 4; ++m) rs[ai][m] = ss[u.pm * 256 + ai * 128 + wr * 64 + m * 16 + fr];
#pragma unroll
        for (int ai = 0; ai < 2; ++ai)
#pragma unroll
            for (int m = 0; m < 4; ++m) {
                const int row = u.pm * 256 + ai * 128 + wr * 64 + m * 16 + fr;
                const float rstd = __builtin_amdgcn_rsqf(rs[ai][m] * (1.0f / DM) + NORM_EPS);
                if (kind < 3) {
                    const int b = row >> 13, p = row & 8191; const float sc = (kind == 0) ? rstd * QSCALE : rstd;
                    bf16_t* base = (bf16_t*)(ws + WS_Q + (size_t)kind * (WS_K - WS_Q));
#pragma unroll
                    for (int bj = 0; bj < 2; ++bj) {
                        const int hh = 2 * (u.pn - 6 * kind) + bj, sh = 2 * (hh >> 2);
                        const int rho = ((p & ((1 << sh) - 1)) << (13 - sh)) + (p >> sh);
                        bf16_t* dst = base + ((size_t)(b * NH + hh) * SEQ + rho) * HD + wc * 32 + 8 * fq;
                        const f32x4 v0 = acc[ai][bj][m][0] * sc, v1 = acc[ai][bj][m][1] * sc;
                        u32x4 w; w.x = cvt_pk_bf16(v0[0], v0[1]); w.y = cvt_pk_bf16(v0[2], v0[3]); w.z = cvt_pk_bf16(v1[0], v1[1]); w.w = cvt_pk_bf16(v1[2], v1[3]);
                        *(u32x4*)dst = w;
                    }
                } else {
#pragma unroll
                    for (int bj = 0; bj < 2; ++bj) {
                        bf16_t* dst = (bf16_t*)(ws + WS_SGA) + (size_t)row * 512 + (u.pn - 18) * 256 + bj * 128 + wc * 32 + 8 * fq;
                        const f32x4 v0 = acc[ai][bj][m][0] * rstd, v1 = acc[ai][bj][m][1] * rstd;
                        u32x4 w; w.x = cvt_pk_bf16(fast_silu(v0[0]), fast_silu(v0[1])); w.y = cvt_pk_bf16(fast_silu(v0[2]), fast_silu(v0[3]));
                        w.z = cvt_pk_bf16(fast_silu(v1[0]), fast_silu(v1[1])); w.w = cvt_pk_bf16(fast_silu(v1[2]), fast_silu(v1[3]));
                        *(u32x4*)dst = w;
                    }
                }
            }
    }
};
struct EpiProjB {
    static constexpr bool PERM = true, AFTER_DRAIN = false;
    unsigned char* ws; const float* ss; const float* bgate;
    __device__ __forceinline__ void operator()(const f32x4 (&acc)[2][2][4][2], const pg8::Unit& u, int wr, int wc, int fr, int fq) const {
        const int kind = u.pn < 4 ? 0 : (u.pn < 8 ? 1 : 2);
        f32x4 bv[2][2];
#pragma unroll
        for (int bj = 0; bj < 2; ++bj)
#pragma unroll
            for (int n = 0; n < 2; ++n) bv[bj][n] = (kind == 2) ? *(const f32x4*)(bgate + (u.pn - 8) * 256 + bj * 128 + wc * 32 + 8 * fq + 4 * n) : (f32x4){0.f, 0.f, 0.f, 0.f};
        float rs[2][4];
#pragma unroll
        for (int ai = 0; ai < 2; ++ai)
#pragma unroll
            for (int m = 0; m < 4; ++m) rs[ai][m] = ss[u.pm * 256 + ai * 128 + wr * 64 + m * 16 + fr];
#pragma unroll
        for (int ai = 0; ai < 2; ++ai)
#pragma unroll
            for (int m = 0; m < 4; ++m) {
                const int row = u.pm * 256 + ai * 128 + wr * 64 + m * 16 + fr;
                const float rstd = __builtin_amdgcn_rsqf(rs[ai][m] * (1.0f / DM) + NORM_EPS);
#pragma unroll
                for (int bj = 0; bj < 2; ++bj) {
                    const int cin = bj * 128 + wc * 32 + 8 * fq;
                    f32x4 v0 = acc[ai][bj][m][0] * rstd, v1 = acc[ai][bj][m][1] * rstd;
                    bf16_t* dst;
                    if (kind == 0) dst = (bf16_t*)(ws + WS_XLRU) + (size_t)row * DM + u.pn * 256 + cin;
                    else if (kind == 1) { dst = (bf16_t*)(ws + WS_SGL) + (size_t)row * DM + (u.pn - 4) * 256 + cin;
#pragma unroll
                        for (int e = 0; e < 4; ++e) { v0[e] = fast_silu(v0[e]); v1[e] = fast_silu(v1[e]); } }
                    else { dst = (bf16_t*)(ws + WS_GATE) + (size_t)row * 2048 + (u.pn - 8) * 256 + cin; v0 += bv[bj][0]; v1 += bv[bj][1];
#pragma unroll
                        for (int e = 0; e < 4; ++e) { v0[e] = fast_sigmoid(v0[e]); v1[e] = fast_sigmoid(v1[e]); } }
                    u32x4 w; w.x = cvt_pk_bf16(v0[0], v0[1]); w.y = cvt_pk_bf16(v0[2], v0[3]); w.z = cvt_pk_bf16(v1[0], v1[1]); w.w = cvt_pk_bf16(v1[2], v1[3]);
                    *(u32x4*)dst = w;
                }
            }
    }
};
template <bool FIRST> struct EpiMerge {
    static constexpr bool PERM = true, AFTER_DRAIN = false;
    bf16_t* MG; const bf16_t* GATE;
    __device__ __forceinline__ void operator()(const f32x4 (&acc)[2][2][4][2], const pg8::Unit& u, int wr, int wc, int fr, int fq) const {
#pragma unroll
        for (int ai = 0; ai < 2; ++ai) {
            u32x4 gw[4][2], pw[4][2];
#pragma unroll
            for (int m = 0; m < 4; ++m)
#pragma unroll
                for (int bj = 0; bj < 2; ++bj) {
                    const int row = u.pm * 256 + ai * 128 + wr * 64 + m * 16 + fr, col = u.pn * 256 + bj * 128 + wc * 32 + 8 * fq;
                    gw[m][bj] = *(const u32x4*)(GATE + (size_t)row * 2048 + col);
                    if (!FIRST) pw[m][bj] = *(const u32x4*)(MG + (size_t)row * DM + col);
                }
#pragma unroll
            for (int m = 0; m < 4; ++m)
#pragma unroll
                for (int bj = 0; bj < 2; ++bj) {
                    const int row = u.pm * 256 + ai * 128 + wr * 64 + m * 16 + fr, col = u.pn * 256 + bj * 128 + wc * 32 + 8 * fq;
                    const u32x4 g4 = gw[m][bj];
                    f32x4 v0 = acc[ai][bj][m][0], v1 = acc[ai][bj][m][1];
                    v0[0] *= bf_lo(g4.x); v0[1] *= bf_hi(g4.x); v0[2] *= bf_lo(g4.y); v0[3] *= bf_hi(g4.y);
                    v1[0] *= bf_lo(g4.z); v1[1] *= bf_hi(g4.z); v1[2] *= bf_lo(g4.w); v1[3] *= bf_hi(g4.w);
                    if (!FIRST) { const u32x4 p4 = pw[m][bj];
                        v0[0] += bf_lo(p4.x); v0[1] += bf_hi(p4.x); v0[2] += bf_lo(p4.y); v0[3] += bf_hi(p4.y);
                        v1[0] += bf_lo(p4.z); v1[1] += bf_hi(p4.z); v1[2] += bf_lo(p4.w); v1[3] += bf_hi(p4.w); }
                    u32x4 w; w.x = cvt_pk_bf16(v0[0], v0[1]); w.y = cvt_pk_bf16(v0[2], v0[3]); w.z = cvt_pk_bf16(v1[0], v1[1]); w.w = cvt_pk_bf16(v1[2], v1[3]);
                    *(u32x4*)(MG + (size_t)row * DM + col) = w;
                }
        }
    }
};
struct EpiResid {
    static constexpr bool PERM = false, AFTER_DRAIN = false;
    const float* xin; float* xout; bf16_t* XB; float* ssn; bool dry;
    __device__ __forceinline__ void operator()(const f32x4 (&acc)[2][2][4][2], const pg8::Unit& u, int wr, int wc, int fr, int fq) const {
#pragma unroll
        for (int ai = 0; ai < 2; ++ai)
#pragma unroll
            for (int mp = 0; mp < 2; ++mp) {
                f32x4 xi[2][2][2];
#pragma unroll
                for (int mm = 0; mm < 2; ++mm)
#pragma unroll
                    for (int bj = 0; bj < 2; ++bj)
#pragma unroll
                        for (int n = 0; n < 2; ++n) {
                            const int row = u.pm * 256 + ai * 128 + wr * 64 + (mp * 2 + mm) * 16 + fr;
                            xi[mm][bj][n] = *(const f32x4*)(xin + (size_t)row * DM + u.pn * 256 + bj * 128 + wc * 32 + n * 16 + 4 * fq);
                        }
#pragma unroll
                for (int mm = 0; mm < 2; ++mm) {
                    const int m = mp * 2 + mm, row = u.pm * 256 + ai * 128 + wr * 64 + m * 16 + fr; float s = 0.f;
#pragma unroll
                    for (int bj = 0; bj < 2; ++bj)
#pragma unroll
                        for (int n = 0; n < 2; ++n) {
                            const size_t off = (size_t)row * DM + u.pn * 256 + bj * 128 + wc * 32 + n * 16 + 4 * fq;
                            const f32x4 v = xi[mm][bj][n] + acc[ai][bj][m][n];
                            u32x2 w; w.x = cvt_pk_bf16(v[0], v[1]); w.y = cvt_pk_bf16(v[2], v[3]);
                            if (!dry) { *(f32x4*)(xout + off) = v; *(u32x2*)(XB + off) = w; }
                            s += (v[0] * v[0] + v[1] * v[1]) + (v[2] * v[2] + v[3] * v[3]);
                        }
                    s += __shfl_xor(s, 16); s += __shfl_xor(s, 32);
                    if (fq == 0 && !dry) atomicAdd(ssn + row, s);
                }
            }
    }
};

__device__ __forceinline__ void attn_naive(Frame& F) {
    bf16_t* Q = (bf16_t*)(F.ws + WS_Q); const bf16_t* Kb = (const bf16_t*)(F.ws + WS_K); const bf16_t* Vb = (const bf16_t*)(F.ws + WS_V);
    float* LSE = (float*)(F.ws + WS_LSE);
    const int gw = F.vcu * 8 + F.wave, NGW = F.G * 8, lane = F.lane;
    for (int item = gw; item < BATCH * NH * SEQ; item += NGW) {
        const int bh = item >> 13, rho = item & 8191, hh = bh % NH, sh = 2 * (hh >> 2), ng = SEQ >> sh;
        const int idx = rho & (ng - 1);
        const size_t rowq = (size_t)bh * SEQ + rho;
        const float slope2 = exp2f(-8.0f * (float)(hh + 1) / 12.0f) * (float)(1 << sh) * LOG2E;
        float s[3]; bool ok[3];
#pragma unroll
        for (int t = 0; t < 3; ++t) {
            const int j = lane - 64 + 64 * t; ok[t] = (j <= 64) && (idx + j >= 0) && (idx + j < ng); s[t] = -1e30f;
            if (ok[t]) {
                const u32x4* kp = (const u32x4*)(Kb + (rowq + j) * HD); const u32x4* qp = (const u32x4*)(Q + rowq * HD); float d = 0.f;
#pragma unroll 4
                for (int c = 0; c < 16; ++c) { const u32x4 kv = kp[c], qv = qp[c];
                    d += bf_lo(kv.x) * bf_lo(qv.x) + bf_hi(kv.x) * bf_hi(qv.x) + bf_lo(kv.y) * bf_lo(qv.y) + bf_hi(kv.y) * bf_hi(qv.y)
                       + bf_lo(kv.z) * bf_lo(qv.z) + bf_hi(kv.z) * bf_hi(qv.z) + bf_lo(kv.w) * bf_lo(qv.w) + bf_hi(kv.w) * bf_hi(qv.w); }
                s[t] = d - slope2 * fabsf((float)j);
            }
        }
        const float mx = wave_max(fmaxf(fmaxf(s[0], s[1]), s[2]));
        float p[3];
#pragma unroll
        for (int t = 0; t < 3; ++t) p[t] = ok[t] ? exp2f(s[t] - mx) : 0.f;
        const float den = wave_sum(p[0] + p[1] + p[2]);
        float o0 = 0.f, o1 = 0.f;
#pragma unroll
        for (int t = 0; t < 3; ++t)
            for (int src = 0; src < 64; ++src) {
                const int j = src - 64 + 64 * t; if (j > 64) break;
                if (idx + j < 0 || idx + j >= ng) continue;
                const float pj = __shfl(p[t], src);
                const unsigned vv = *(const unsigned*)(Vb + (rowq + j) * HD + 2 * lane);
                o0 += pj * bf_lo(vv); o1 += pj * bf_hi(vv);
            }
        const float inv = 1.0f / den;
        *(unsigned*)(Q + rowq * HD + 2 * lane) = cvt_pk_bf16(o0 * inv, o1 * inv);
        if (lane == 0) LSE[rowq] = mx + log2f(den);
    }
}

typedef float f32x16 __attribute__((ext_vector_type(16)));
typedef short s16x4 __attribute__((ext_vector_type(4)));
typedef __bf16 bf16x2_t __attribute__((ext_vector_type(2)));
__device__ __forceinline__ unsigned cvtpk_c(float lo, float hi) { f32x2 v = {lo, hi}; bf16x2_t b = __builtin_convertvector(v, bf16x2_t); return __builtin_bit_cast(unsigned, b); }
__device__ __forceinline__ int crow(int r, int hi) { return (r & 3) + 8 * (r >> 2) + 4 * hi; }
__device__ __forceinline__ void attn_dma(LAS unsigned char* img, const bf16_t* base, int U, int seq_lo, int seq_hi, int w, int lane) {
    const __amdgpu_buffer_rsrc_t rs = __builtin_amdgcn_make_buffer_rsrc((void*)base, 0, SEQ * 256, 0x00020000);
    const int rl0 = lane >> 4, cp = lane & 15;
#pragma unroll
    for (int i = 0; i < 12; ++i) {
        const int pc = w * 12 + i, row_local = 4 * pc + rl0;
        int grow = U - 64 + row_local; grow = grow < seq_lo ? seq_lo : grow; grow = grow > seq_hi - 1 ? seq_hi - 1 : grow;
        const int voff = grow * 256 + ((cp ^ ((rl0 << 2) | (i & 3))) << 4);
        __builtin_amdgcn_raw_ptr_buffer_load_lds(rs, (LAS void*)(img + pc * 1024), 16, voff, 0, 0, 0);
    }
}
__device__ __forceinline__ void attn_unit(Frame& F, int unit, bool dry) {
    LAS unsigned char* img = F.lds;
    const int lane = F.lane, w = F.wave, c = lane & 31, hi = lane >> 5;
    const int bh = unit >> 5, qb = unit & 31, hh = bh % NH, sh = 2 * (hh >> 2), ng = SEQ >> sh;
    const int U = qb * 256, seq_lo = U & ~(ng - 1), seq_hi = seq_lo + ng;
    bf16_t* Qh = (bf16_t*)(F.ws + WS_Q) + (size_t)bh * SEQ * HD;
    const bf16_t* Kh = (const bf16_t*)(F.ws + WS_K) + (size_t)bh * SEQ * HD;
    const bf16_t* Vh = (const bf16_t*)(F.ws + WS_V) + (size_t)bh * SEQ * HD;
    attn_dma(img, Kh, U, seq_lo, seq_hi, w, lane);
    bf16x8 qf[8];
    { const bf16_t* qrow = Qh + (size_t)(U + 32 * w + c) * HD + 8 * hi;
#pragma unroll
      for (int s = 0; s < 8; ++s) qf[s] = *(const bf16x8*)(qrow + 16 * s); }
    const float slope2 = exp2f(-8.0f * (float)(hh + 1) / 12.0f) * (float)(1 << sh) * LOG2E;
    asm volatile("s_waitcnt vmcnt(0)" ::: "memory"); __builtin_amdgcn_s_barrier(); asm volatile("" ::: "memory");
    f32x16 p[5];
    {   const int lk = fresh(lane), ck = lk & 31, hk = lk >> 5;
        const unsigned swz = ((unsigned)(ck & 3) << 2) | ((unsigned)(ck >> 2) & 3u);
        unsigned kx[8];
#pragma unroll
        for (int s = 0; s < 8; ++s) kx[s] = 256u * (unsigned)(32 * w + ck) + 16u * (((unsigned)(2 * s + hk)) ^ swz);
#pragma unroll
        for (int i = 0; i < 5; ++i) {
            f32x16 a = {0.f, 0.f, 0.f, 0.f, 0.f, 0.f, 0.f, 0.f, 0.f, 0.f, 0.f, 0.f, 0.f, 0.f, 0.f, 0.f};
#pragma unroll
            for (int s = 0; s < 8; ++s) { const bf16x8 kf = *(const LAS bf16x8*)(img + kx[s] + 8192 * i); a = __builtin_amdgcn_mfma_f32_32x32x16_bf16(kf, qf[s], a, 0, 0, 0); }
            p[i] = a;
        }
    }
    const bool lo_edge = (U == seq_lo), hi_edge = (U + 256 == seq_hi);
    const int lm = fresh(lane);
    const float dbase = (float)(4 * (lm >> 5) - (lm & 31));
    float mx = -1e30f;
#pragma unroll
    for (int i = 0; i < 5; ++i) {
        const bool tile_dead = (lo_edge && (w + i < 2)) || (hi_edge && (w + i >= 10));
        const float pen = tile_dead ? -1e30f : 0.0f;
#pragma unroll
        for (int r = 0; r < 16; ++r) {
            const float ad = fabsf((float)(32 * i + (r & 3) + 8 * (r >> 2) - 64) + dbase);
            float s = p[i][r] - slope2 * ad + pen;
            if (i == 0 || i == 4) s = (ad <= 64.0f) ? s : -1e30f;
            p[i][r] = s; mx = fmaxf(mx, s);
        }
    }
    mx = fmaxf(mx, __shfl_xor(mx, 32));
    float l = 0.f;
#pragma unroll
    for (int i = 0; i < 5; ++i)
#pragma unroll
        for (int r = 0; r < 16; ++r) { const float e = __builtin_amdgcn_exp2f(p[i][r] - mx); p[i][r] = e; l += e; }
    l += __shfl_xor(l, 32);
    const float inv = 1.0f / l;
    if (hi == 0 && !dry) ((float*)(F.ws + WS_LSE))[(size_t)bh * SEQ + U + 32 * w + c] = mx + log2f(l);
    u32x4 pa[5][2];
#pragma unroll
    for (int i = 0; i < 5; ++i)
#pragma unroll
        for (int s = 0; s < 2; ++s) {
            pa[i][s].x = cvtpk_c(p[i][8 * s + 0] * inv, p[i][8 * s + 1] * inv); pa[i][s].y = cvtpk_c(p[i][8 * s + 2] * inv, p[i][8 * s + 3] * inv);
            pa[i][s].z = cvtpk_c(p[i][8 * s + 4] * inv, p[i][8 * s + 5] * inv); pa[i][s].w = cvtpk_c(p[i][8 * s + 6] * inv, p[i][8 * s + 7] * inv);
        }
    asm volatile("s_waitcnt lgkmcnt(0)" ::: "memory"); __builtin_amdgcn_s_barrier(); asm volatile("" ::: "memory");
    attn_dma(img, Vh, U, seq_lo, seq_hi, w, lane);
    asm volatile("s_waitcnt vmcnt(0)" ::: "memory"); __builtin_amdgcn_s_barrier(); asm volatile("" ::: "memory");
    f32x16 o[4];
#pragma unroll
    for (int c4 = 0; c4 < 4; ++c4) o[c4] = (f32x16){0.f, 0.f, 0.f, 0.f, 0.f, 0.f, 0.f, 0.f, 0.f, 0.f, 0.f, 0.f, 0.f, 0.f, 0.f, 0.f};
    {   const int lv = fresh(lane), blk = (lv >> 4) & 1, q = (lv & 15) >> 2, pp = lv & 3, hv = lv >> 5;
        unsigned vx[4][2];
#pragma unroll
        for (int c4 = 0; c4 < 4; ++c4)
#pragma unroll
            for (int t = 0; t < 2; ++t)
                vx[c4][t] = 256u * (unsigned)(32 * w + 8 * t + 4 * hv + q) + 16u * ((((unsigned)(c4 ^ q)) << 2) | (((unsigned)(2 * blk + (pp >> 1))) ^ ((unsigned)(2 * t + hv)))) + 8u * (unsigned)(pp & 1);
#pragma unroll
        for (int i = 0; i < 5; ++i)
#pragma unroll
            for (int s = 0; s < 2; ++s) {
                const bf16x8 af = __builtin_bit_cast(bf16x8, pa[i][s]);
#pragma unroll
                for (int c4 = 0; c4 < 4; ++c4) {
                    const s16x4 v0 = __builtin_bit_cast(s16x4, __builtin_amdgcn_ds_read_tr16_b64_v4i16((LAS s16x4*)(img + vx[c4][0] + 8192 * i + 4096 * s)));
                    const s16x4 v1 = __builtin_bit_cast(s16x4, __builtin_amdgcn_ds_read_tr16_b64_v4i16((LAS s16x4*)(img + vx[c4][1] + 8192 * i + 4096 * s)));
                    const bf16x8 bfv = (bf16x8){v0[0], v0[1], v0[2], v0[3], v1[0], v1[1], v1[2], v1[3]};
                    o[c4] = __builtin_amdgcn_mfma_f32_32x32x16_bf16(af, bfv, o[c4], 0, 0, 0);
                }
            }
    }
    asm volatile("s_waitcnt lgkmcnt(0)" ::: "memory"); __builtin_amdgcn_s_barrier(); asm volatile("" ::: "memory");
    {   LAS bf16_t* stg = (LAS bf16_t*)(img + w * 8192);
#pragma unroll
        for (int c4 = 0; c4 < 4; ++c4)
#pragma unroll
            for (int r = 0; r < 16; ++r) stg[crow(r, hi) * 128 + 32 * c4 + c] = (bf16_t)(cvtpk_c(o[c4][r], 0.f) & 0xffffu);
        asm volatile("s_waitcnt lgkmcnt(0)" ::: "memory");
        bf16_t* orow = Qh + (size_t)(U + 32 * w) * HD;
#pragma unroll
        for (int it = 0; it < 8; ++it) { const int row = it * 4 + (lane >> 4), ch = lane & 15;
            const u32x4 v = *(const LAS u32x4*)((LAS unsigned char*)stg + row * 256 + ch * 16);
            if (!dry) *(u32x4*)(orow + (size_t)row * HD + ch * 8) = v; }
    }
    asm volatile("s_waitcnt lgkmcnt(0)" ::: "memory"); __builtin_amdgcn_s_barrier(); asm volatile("" ::: "memory");
}
__device__ __forceinline__ void attn_phase(Frame& F, bool dry) {
    for (int unit = F.vcu; unit < BATCH * NH * 32; unit += F.G) attn_unit(F, unit, dry);
}

__device__ __forceinline__ void attn_mix(unsigned char* ws, int pm, int slot, int part, bool dry) {
    const bf16_t* O = (const bf16_t*)(ws + WS_Q); const float* LSE = (const float*)(ws + WS_LSE); bf16_t* SGA = (bf16_t*)(ws + WS_SGA);
    for (int it = part * 1024 + fresh(threadIdx.x); it < (part + 1) * 1024; it += 512) {
        const int row = pm * 256 + (it >> 4), ch = it & 15, b = row >> 13, p = row & 8191;
        float l[3]; u32x4 o[3];
#pragma unroll
        for (int g = 0; g < 3; ++g) { const int sh = 2 * g, hh = 4 * g + slot; const int rho = ((p & ((1 << sh) - 1)) << (13 - sh)) + (p >> sh);
            const size_t r = (size_t)(b * NH + hh) * SEQ + rho; l[g] = LSE[r]; o[g] = *(const u32x4*)(O + r * HD + 8 * ch); }
        const float mx = fmaxf(fmaxf(l[0], l[1]), l[2]);
        float w0 = exp2f(l[0] - mx), w1 = exp2f(l[1] - mx), w2 = exp2f(l[2] - mx); const float inv = 1.0f / (w0 + w1 + w2); w0 *= inv; w1 *= inv; w2 *= inv;
        bf16_t* dst = SGA + (size_t)row * 512 + slot * 128 + 8 * ch; const u32x4 sg = *(const u32x4*)dst;
        u32x4 y;
#define MIXW(f) { const float lo = (w0 * bf_lo(o[0].f) + w1 * bf_lo(o[1].f) + w2 * bf_lo(o[2].f)) * bf_lo(sg.f); const float hi = (w0 * bf_hi(o[0].f) + w1 * bf_hi(o[1].f) + w2 * bf_hi(o[2].f)) * bf_hi(sg.f); y.f = cvt_pk_bf16(lo, hi); }
        MIXW(x) MIXW(y) MIXW(z) MIXW(w)
#undef MIXW
        if (!dry) *(u32x4*)dst = y;
    }
}

__device__ __forceinline__ void lru_conv(Frame& F, int pm, int n, const float* conv_w, const float* conv_b) {
    const bf16_t* XL = (const bf16_t*)(F.ws + WS_XLRU); bf16_t* XC = (bf16_t*)(F.ws + WS_XB);
    for (int it = fresh(threadIdx.x); it < 256 * 32; it += 512) {
        const int row = pm * 256 + (it >> 5), c0 = n * 256 + (it & 31) * 8, t = row & 8191;
        float acc[8];
        { const f32x4 b0 = *(const f32x4*)(conv_b + c0), b1 = *(const f32x4*)(conv_b + c0 + 4); acc[0] = b0[0]; acc[1] = b0[1]; acc[2] = b0[2]; acc[3] = b0[3]; acc[4] = b1[0]; acc[5] = b1[1]; acc[6] = b1[2]; acc[7] = b1[3]; }
#pragma unroll
        for (int j = 0; j < 4; ++j) { const int tt = t + j - 2; if (tt < 0 || tt >= SEQ) continue;
            const u32x4 xv = *(const u32x4*)(XL + (size_t)(row + j - 2) * DM + c0);
            const f32x4 w0 = *(const f32x4*)(conv_w + j * DM + c0), w1 = *(const f32x4*)(conv_w + j * DM + c0 + 4);
            acc[0] += w0[0] * bf_lo(xv.x); acc[1] += w0[1] * bf_hi(xv.x); acc[2] += w0[2] * bf_lo(xv.y); acc[3] += w0[3] * bf_hi(xv.y);
            acc[4] += w1[0] * bf_lo(xv.z); acc[5] += w1[1] * bf_hi(xv.z); acc[6] += w1[2] * bf_lo(xv.w); acc[7] += w1[3] * bf_hi(xv.w); }
        u32x4 o; o.x = cvt_pk_bf16(acc[0], acc[1]); o.y = cvt_pk_bf16(acc[2], acc[3]); o.z = cvt_pk_bf16(acc[4], acc[5]); o.w = cvt_pk_bf16(acc[6], acc[7]);
        *(u32x4*)(XC + (size_t)row * DM + c0) = o;
    }
}
struct EpiLru {
    static constexpr bool PERM = false, AFTER_DRAIN = true;
    const bf16_t* XC; const float *ba, *bx, *lam;
    unsigned long long* TIL; unsigned* cnt; unsigned* tmo; const bf16_t* SGL; bf16_t* YL; unsigned char* ws; int n, qq; bool dry;
    __device__ __forceinline__ void fused(f32x4 (&acc)[2][2][4][2], const pg8::Unit& u, int wr, int wc, int fr, int fq, LAS unsigned char* lds, int wid, int lane) const {
        const int cu0 = 16 * wc + 4 * fq, ch0 = 256 * n + 64 * qq + cu0;
#pragma unroll
        for (int d = 0; d < 2; ++d) {
            float cba[4], cbx[4], c2[4];
            { const f32x4 a4 = *(const f32x4*)(ba + d * DM + ch0), x4 = *(const f32x4*)(bx + d * DM + ch0), l4 = *(const f32x4*)(lam + d * DM + ch0);
#pragma unroll
              for (int e = 0; e < 4; ++e) { cba[e] = a4[e]; cbx[e] = x4[e]; c2[e] = -8.0f * LOG2E * log1pf(expf(-l4[e])); } }
#pragma unroll
            for (int ai = 0; ai < 2; ++ai)
#pragma unroll
                for (int m = 0; m < 4; ++m) {
                    const int rl = ai * 128 + wr * 64 + m * 16 + fr, row = u.pm * 256 + rl, t = row & 8191;
                    const u32x2 xw = *(const u32x2*)(XC + (size_t)row * DM + ch0);
                    const float xc[4] = {bf_lo(xw.x), bf_hi(xw.x), bf_lo(xw.y), bf_hi(xw.y)};
                    const bool first = (d == 0) ? (t == 0) : (t == SEQ - 1);
                    u32x4 w;
#pragma unroll
                    for (int e = 0; e < 4; ++e) {
                        const float r = fast_sigmoid(acc[ai][d][m][0][e] + cba[e]), ig = fast_sigmoid(acc[ai][d][m][1][e] + cbx[e]);
                        const float l2a = r * c2[e];
                        const float a2 = __builtin_amdgcn_exp2f(2.0f * l2a);
                        const float mult = first ? 1.0f : __builtin_amdgcn_sqrtf(fmaxf(1.0f - a2, 0.0f));
                        w[e] = cvt_pk_bf16(l2a, mult * ig * xc[e]);
                    }
                    *(LAS u32x4*)(lds + rl * LRU_PITCH + d * 256 + cu0 * 4) = w;
                }
        }
        LDS_WAIT(); __builtin_amdgcn_s_barrier(); asm volatile("" ::: "memory");
        const int tid = wid * 64 + lane, seg = tid >> 7, dir = (tid >> 6) & 1, cu = tid & 63;
        LAS unsigned char* col = lds + dir * 256 + cu * 4;
        const int r0 = dir ? (seg * 64 + 63) : seg * 64, rstep = dir ? -LRU_PITCH : LRU_PITCH;
        float P = 1.0f, H = 0.0f;
        { LAS unsigned char* pp = col + r0 * LRU_PITCH;
#pragma unroll 8
          for (int i = 0; i < 64; ++i) { const unsigned w = *(LAS unsigned*)pp; pp += rstep; const float a = __builtin_amdgcn_exp2f(bf_lo(w)); H = a * H + bf_hi(w); P *= a; } }
        LAS f32x2* xch = (LAS f32x2*)(lds + LRU_XCH);
        xch[(dir * 4 + seg) * 64 + cu] = (f32x2){P, H};
        LDS_WAIT(); __builtin_amdgcn_s_barrier(); asm volatile("" ::: "memory");
        const size_t tslot = (size_t)(n * 4 + qq) * 128 + dir * 64 + cu;
        if (seg == 0) {
            float Pt = 1.0f, Ht = 0.0f;
#pragma unroll
            for (int s = 0; s < 4; ++s) { const f32x2 v = xch[(dir * 4 + (dir ? 3 - s : s)) * 64 + cu]; Ht = v.x * Ht + v.y; Pt *= v.x; }
            __hip_atomic_store(TIL + (size_t)u.pm * 2048 + tslot, ((unsigned long long)__float_as_uint(Ht) << 32) | __float_as_uint(Pt), __ATOMIC_RELAXED, __HIP_MEMORY_SCOPE_AGENT);
        }
        asm volatile("s_waitcnt vmcnt(0)" ::: "memory"); __builtin_amdgcn_s_barrier(); asm volatile("" ::: "memory");
        if (tid == 0) __hip_atomic_fetch_add(cnt, 1u, __ATOMIC_RELAXED, __HIP_MEMORY_SCOPE_AGENT);
        attn_mix(ws, u.pm, n, qq, dry);
        if (wid == 0) {
            unsigned sp = 0;
            while ((unsigned)__builtin_amdgcn_readfirstlane(__hip_atomic_load(cnt, __ATOMIC_RELAXED, __HIP_MEMORY_SCOPE_AGENT)) < 32u) {
                __builtin_amdgcn_s_sleep(1);
                if ((++sp & 1023u) == 0u) { if (__hip_atomic_load(tmo, __ATOMIC_RELAXED, __HIP_MEMORY_SCOPE_AGENT) != 0u) break; if (sp > (1u << 22)) { if (lane == 0) __hip_atomic_store(tmo, 1u, __ATOMIC_RELAXED, __HIP_MEMORY_SCOPE_AGENT); break; } }
            }
            __builtin_amdgcn_fence(__ATOMIC_ACQUIRE, "agent");
            asm volatile("s_waitcnt vmcnt(0)" ::: "memory");
        }
        asm volatile("s_waitcnt vmcnt(0)" ::: "memory"); __builtin_amdgcn_s_barrier(); asm volatile("" ::: "memory");
        float h = 0.0f;
        {   const int pb = u.pm & ~31, k0 = u.pm - pb;
            unsigned long long tv[31];
#pragma unroll
            for (int k = 0; k < 31; ++k) {
                const int q = dir ? (pb + 31 - k) : (pb + k); const bool use = dir ? (q > u.pm) : (q < u.pm);
                tv[k] = use ? __hip_atomic_load(TIL + (size_t)q * 2048 + tslot, __ATOMIC_RELAXED, __HIP_MEMORY_SCOPE_AGENT) : 0x000000003f800000ull;
            }
            (void)k0;
#pragma unroll
            for (int k = 0; k < 31; ++k) h = __uint_as_float((unsigned)tv[k]) * h + __uint_as_float((unsigned)(tv[k] >> 32));
        }
        if (dir == 0) { for (int s = 0; s < seg; ++s) { const f32x2 v = xch[(0 * 4 + s) * 64 + cu]; h = v.x * h + v.y; } }
        else { for (int s = 3; s > seg; --s) { const f32x2 v = xch[(1 * 4 + s) * 64 + cu]; h = v.x * h + v.y; } }
        { LAS unsigned char* pp = col + r0 * LRU_PITCH;
#pragma unroll 8
          for (int i = 0; i < 64; ++i) { const unsigned w = *(LAS unsigned*)pp; const float a = __builtin_amdgcn_exp2f(bf_lo(w)); h = a * h + bf_hi(w); *(LAS float*)pp = h; pp += rstep; } }
        LDS_WAIT(); __builtin_amdgcn_s_barrier(); asm volatile("" ::: "memory");
        const int qd = tid & 15, rg = tid >> 4;
#pragma unroll 4
        for (int i = 0; i < 8; ++i) {
            const int rl = i * 32 + rg, row = u.pm * 256 + rl;
            const f32x4 hf = *(const LAS f32x4*)(lds + rl * LRU_PITCH + qd * 16), hb = *(const LAS f32x4*)(lds + rl * LRU_PITCH + 256 + qd * 16);
            const size_t off = (size_t)row * DM + 256 * n + 64 * qq + 4 * qd;
            const u32x2 sg = *(const u32x2*)(SGL + off);
            u32x2 y; y.x = cvt_pk_bf16((hf[0] + hb[0]) * bf_lo(sg.x), (hf[1] + hb[1]) * bf_hi(sg.x)); y.y = cvt_pk_bf16((hf[2] + hb[2]) * bf_lo(sg.y), (hf[3] + hb[3]) * bf_hi(sg.y));
            *(u32x2*)(YL + off) = y;
        }
        LDS_WAIT(); __builtin_amdgcn_s_barrier(); asm volatile("" ::: "memory");
    }
};

__device__ __forceinline__ void final_norm(Frame& F, float* out, const float* ss, const float* g, bool dry) {
    const int gw = F.vcu * 8 + F.wave, NGW = F.G * 8;
    f32x4 gv[4];
#pragma unroll
    for (int j = 0; j < 4; ++j) gv[j] = ((const f32x4*)g)[F.lane + 64 * j];
    for (int m = gw; m < M; m += NGW) {
        const float rstd = 1.0f / sqrtf(ss[m] * (1.0f / DM) + NORM_EPS);
        f32x4* xr = (f32x4*)(out + (size_t)m * DM) + F.lane;
#pragma unroll
        for (int j = 0; j < 4; ++j) { const f32x4 v = xr[64 * j]; if (!dry) xr[64 * j] = v * rstd * gv[j]; }
    }
}

constexpr int N_PHASES = 14;
__global__ void __launch_bounds__(512, 2) hybrid_fwd(Args args) {
    extern __shared__ __attribute__((aligned(16))) unsigned char lds_raw[];
    Frame F;
    F.lds = (LAS unsigned char*)lds_raw;
    F.tid = threadIdx.x; F.lane = F.tid & 63; F.wave = __builtin_amdgcn_readfirstlane(F.tid >> 6);
    F.G = gridDim.x; { const int bx = blockIdx.x; F.vcu = (F.G % 8 == 0) ? (bx % 8) * (F.G / 8) + bx / 8 : bx; }
    F.ws = args.ws; F.ctl = (unsigned*)(args.ws + WS_CTL);
    volatile LAS unsigned* MISC = (volatile LAS unsigned*)(F.lds + LDSCTL_OFF);
    if (F.tid < 64) MISC[F.tid] = 0u;
    __syncthreads();
    XcdBarrier bar; bar.bar = F.ctl + CW_BAR; bar.x = 0; bar.st = nullptr;
    if (MK_N_LAUNCHES == 1) bar = xcd_barrier_post(F.ctl + CW_BAR, MISC + 8);
    bf16_t* Wb = (bf16_t*)(F.ws + WS_W);
    float* ss = (float*)(F.ctl + CW_SS);

#ifndef PHMASK
#define PHMASK 0x3ff
#endif
#ifndef REPEAT_PH
#define REPEAT_PH -1
#endif
#ifndef REPEAT_N
#define REPEAT_N 2
#endif
    for (int ph = args.ph_lo; ph < args.ph_hi; ++ph) {
      const int reps = (ph == REPEAT_PH) ? REPEAT_N : 1;
      for (int rep = 0; rep < reps; ++rep) {
        const bool dry = (rep + 1 < reps);
        if (rep > 0) xcd_barrier(bar);
        { int tv = threadIdx.x; asm volatile("" : "+v"(tv)); F.tid = tv; F.lane = tv & 63; F.wave = __builtin_amdgcn_readfirstlane(tv >> 6); }
        if (ph == 0) { if (PHMASK & 1) p0_prologue(F, args); }
        else if (ph == 13) { if (PHMASK & 2) final_norm(F, args.out, ss + 2 * M, args.in[14], dry); }
        else {
            const int l = (ph - 1) / 6; int sub = (ph - 1) % 6; if (sub >= 4) ++sub;
            const bf16_t* XB = (const bf16_t*)(F.ws + WS_XB);
            if (sub == 0 && (PHMASK & 4)) {
                pg8::Gemm g{XB, Wb + W_IN_T / 2 + (size_t)l * NIN * DM, DM, DM, DM};
                pg8::StaticOrder S; S.init(M, NCOL_A, F.G, (int)blockIdx.x, DM, DM);
                EpiProjA E{F.ws, ss + l * M};
                pg8::gemm_phase(fresh(threadIdx.x), F.lds, g, S, E);
            } else if (sub == 1 && (PHMASK & 8)) {
#ifdef NAIVE_ATTN
                attn_naive(F);
#else
                attn_phase(F, dry);
#endif
            } else if (sub == 2 && (PHMASK & 16)) {
                pg8::Gemm g{XB, Wb + W_IN_T / 2 + ((size_t)l * NIN + NCOL_A) * DM, DM, DM, DM};
                pg8::StaticOrder S; S.init(M, NCOL_B, F.G, (int)blockIdx.x, DM, DM);
                EpiProjB E{F.ws, ss + l * M, args.in[3] + l * 2048};
                pg8::gemm_phase(fresh(threadIdx.x), F.lds, g, S, E);
            } else if (sub == 3 && (PHMASK & 32)) {
                for (int task = F.vcu; task < 256; task += F.G) {
                    const int pm = task >> 2, n = task & 3;
                    lru_conv(F, pm, n, args.in[4] + l * 4 * DM, args.in[5] + l * DM); VM_WAIT(); __syncthreads();
                    for (int qq = 0; qq < 4; ++qq) {
                        pg8::Gemm g{XB, Wb + W_RG_T / 2, DM, 256, 256};
                        pg8::SingleUnit S; S.u0.pm = pm; S.u0.pn = qq; S.u0.abyte = (pm * 256 * DM + n * 256) * 2; S.u0.bbyte = ((l * 4 + n) * 4 + qq) * 65536 * 2;
                        EpiLru E{XB, args.in[7] + l * 2048, args.in[9] + l * 2048, args.in[10] + l * 2048, (unsigned long long*)(F.ws + WS_TIL + (size_t)l * MiB),
                                 F.ctl + CW_CNT + (((l * 2 + (pm >> 5)) * 4 + n) * 4 + qq) * 64, F.ctl + CW_TMO, (const bf16_t*)(F.ws + WS_SGL), (bf16_t*)(F.ws + WS_XLRU), F.ws, n, qq, dry};
                        pg8::gemm_phase(fresh(threadIdx.x), F.lds, g, S, E);
                    }
                }
            } else if (sub == 5 && (PHMASK & 128)) {
                { pg8::Gemm g{(const bf16_t*)(F.ws + WS_SGA), Wb + W_OATT_T / 2 + (size_t)l * DM * 512, 512, 512, 512};
                  pg8::StaticOrder S; S.init(M, DM, F.G, (int)blockIdx.x, 512, 512);
                  EpiMerge<true> E{(bf16_t*)(F.ws + WS_Q), (const bf16_t*)(F.ws + WS_GATE)};
                  pg8::gemm_phase(fresh(threadIdx.x), F.lds, g, S, E); }
                VM_WAIT(); __syncthreads();
                { pg8::Gemm g{(const bf16_t*)(F.ws + WS_XLRU), Wb + W_OLRU_T / 2 + (size_t)l * DM * DM, DM, DM, DM};
                  pg8::StaticOrder S; S.init(M, DM, F.G, (int)blockIdx.x, DM, DM);
                  EpiMerge<false> E{(bf16_t*)(F.ws + WS_Q), (const bf16_t*)(F.ws + WS_GATE) + 1024};
                  pg8::gemm_phase(fresh(threadIdx.x), F.lds, g, S, E); }
            } else if (sub == 6 && (PHMASK & 256)) {
                pg8::Gemm g{(const bf16_t*)(F.ws + WS_Q), Wb + W_OUT_T / 2 + (size_t)l * DM * DM, DM, DM, DM};
                pg8::StaticOrder S; S.init(M, DM, F.G, (int)blockIdx.x, DM, DM);
                EpiResid E{l == 0 ? args.in[0] : args.out, args.out, (bf16_t*)(F.ws + WS_XB), ss + (l + 1) * M, dry};
                pg8::gemm_phase(fresh(threadIdx.x), F.lds, g, S, E);
            }
        }
      }
        if (ph + 1 < args.ph_hi) xcd_barrier(bar);
        if (REPEAT_PH == 100 && ph == 1) { xcd_barrier(bar); xcd_barrier(bar); xcd_barrier(bar); xcd_barrier(bar); xcd_barrier(bar); xcd_barrier(bar); xcd_barrier(bar); xcd_barrier(bar); }
    }
}

extern "C" void kernel_launch(void* const* d_in, const int* in_sizes, int n_in, void* d_out, int out_size, void* d_ws, size_t ws_size, hipStream_t stream) {
    static int grid = 0;
    if (grid == 0) {
        if (n_in != 15 || in_sizes[0] != M * DM || out_size != M * DM || ws_size < WS_END) { fprintf(stderr, "kernel_launch: unexpected shapes / workspace (%d inputs, ws %zu < %zu)\n", n_in, ws_size, (size_t)WS_END); grid = -1; return; }
        int dev = 0, cus = 0, per_cu = 0;
        if (hipGetDevice(&dev) != hipSuccess || hipDeviceGetAttribute(&cus, hipDeviceAttributeMultiprocessorCount, dev) != hipSuccess) { grid = -1; return; }
        if (hipFuncSetAttribute((const void*)hybrid_fwd, hipFuncAttributeMaxDynamicSharedMemorySize, LDS_BYTES) != hipSuccess) { fprintf(stderr, "kernel_launch: hipFuncSetAttribute failed\n"); grid = -1; return; }
        if (hipOccupancyMaxActiveBlocksPerMultiprocessor(&per_cu, (const void*)hybrid_fwd, 512, LDS_BYTES) != hipSuccess || per_cu < 1) { fprintf(stderr, "kernel_launch: occupancy query says %d\n", per_cu); grid = -1; return; }
        (void)hipGetLastError();
        grid = cus;
    }
    if (grid < 0) return;
    (void)hipMemsetAsync((char*)d_ws + WS_CTL, 0, CTL_ZERO_BYTES, stream);
    Args a{};
    for (int i = 0; i < 15; ++i) a.in[i] = (const float*)d_in[i];
    a.out = (float*)d_out; a.ws = (unsigned char*)d_ws;
    if (MK_N_LAUNCHES == 1) { a.ph_lo = 0; a.ph_hi = N_PHASES; a.li = 0; hipLaunchKernelGGL(hybrid_fwd, dim3(grid), dim3(512), LDS_BYTES, stream, a); }
    else for (int ph = 0; ph < N_PHASES; ++ph) { a.ph_lo = ph; a.ph_hi = ph + 1; a.li = ph; hipLaunchKernelGGL(hybrid_fwd, dim3(grid), dim3(512), LDS_BYTES, stream, a); }
}
```

```cpp
#include <hip/hip_runtime.h>
#include <cstdio>
#include <cstdint>

#ifndef MK_N_LAUNCHES
#define MK_N_LAUNCHES 1
#endif

#define LAS __attribute__((address_space(3)))
#define GAS __attribute__((address_space(1)))
typedef unsigned short bf16_t;
typedef short bf16x8 __attribute__((ext_vector_type(8)));
typedef float f32x4 __attribute__((ext_vector_type(4)));
typedef float f32x2 __attribute__((ext_vector_type(2)));
typedef unsigned u32x4 __attribute__((ext_vector_type(4)));
typedef unsigned u32x2 __attribute__((ext_vector_type(2)));

constexpr int BATCH = 2, SEQ = 8192, DM = 1024, M = BATCH * SEQ, DEPTH = 2;
constexpr int NIN = 9216, NH = 12, HD = 128;
constexpr int NCOL_A = 5120, NCOL_B = 4096;
constexpr float LOG2E = 1.4426950408889634f;
constexpr float QSCALE = 0.08838834764831845f * LOG2E;
constexpr float NORM_EPS = 1e-6f;

constexpr size_t MiB = 1u << 20;
constexpr size_t WS_CTL = 0, CTL_ZERO_BYTES = 1 * MiB;
constexpr size_t WS_LSE = 1 * MiB;
constexpr size_t WS_LC  = 4 * MiB;
constexpr size_t WS_TIL = 2 * MiB;
constexpr size_t WS_W   = 8 * MiB;
constexpr size_t W_IN_T = 0;
constexpr size_t W_OATT_T = W_IN_T + (size_t)2 * NIN * DM * 2;
constexpr size_t W_OLRU_T = W_OATT_T + (size_t)2 * DM * 512 * 2;
constexpr size_t W_OUT_T  = W_OLRU_T + (size_t)2 * DM * DM * 2;
constexpr size_t W_RG_T   = W_OUT_T + (size_t)2 * DM * DM * 2;
constexpr size_t W_END    = W_RG_T + (size_t)2 * 16 * 65536 * 2;
static_assert(W_END == 50 * MiB, "weight map");
constexpr size_t WS_XB  = 58 * MiB;
constexpr size_t WS_Q   = 90 * MiB;
constexpr size_t WS_K   = 138 * MiB;
constexpr size_t WS_V   = 186 * MiB;
constexpr size_t WS_XLRU = WS_K;
constexpr size_t WS_SGL  = WS_K + 32 * MiB;
constexpr size_t WS_GATE = WS_K + 64 * MiB;
constexpr size_t WS_SGA  = 266 * MiB;
constexpr size_t WS_END  = 282 * MiB;
static_assert(WS_V - WS_K == WS_K - WS_Q, "q/k/v spacing");
constexpr int CW_BAR = 4096;
constexpr int CW_TMO = 0;
constexpr int CW_PAN = 24576;
constexpr int CW_CNT = 16384;
constexpr int CW_SS = 65536;
static_assert((CW_SS + 3 * M) * 4 <= (int)CTL_ZERO_BYTES, "ctl");

constexpr int RING_BYTES = 131072;
constexpr int LRU_PITCH = 528;
constexpr int LRU_IMG = 256 * LRU_PITCH;
constexpr int LRU_XCH = LRU_IMG;
constexpr int LDSCTL_OFF = 147456;
constexpr int LDS_BYTES = 148480;
static_assert(LRU_XCH + 4096 <= LDSCTL_OFF, "lds");

#define RLX_AGENT __ATOMIC_RELAXED, __HIP_MEMORY_SCOPE_AGENT
#define LDS_WAIT() asm volatile("s_waitcnt lgkmcnt(0)" ::: "memory")
#define VM_WAIT() asm volatile("s_waitcnt vmcnt(0)" ::: "memory")

__device__ __forceinline__ unsigned cvt_pk_bf16(float lo, float hi) { unsigned r; asm volatile("v_cvt_pk_bf16_f32 %0, %1, %2" : "=v"(r) : "v"(lo), "v"(hi)); return r; }
__device__ __forceinline__ float bf_lo(unsigned w) { return __uint_as_float(w << 16); }
__device__ __forceinline__ float bf_hi(unsigned w) { return __uint_as_float(w & 0xffff0000u); }
__device__ __forceinline__ float fast_sigmoid(float v) { return __builtin_amdgcn_rcpf(1.0f + __builtin_amdgcn_exp2f(-LOG2E * v)); }
__device__ __forceinline__ float fast_silu(float v) { return v * fast_sigmoid(v); }

namespace pg8 {
constexpr int BM = 256, BK = 64, HALF = 128, HTB = HALF * BK * 2, STAGE_BYTES = 8 * HTB, NXCD = 8, WGM = 8;
__host__ __device__ __forceinline__ int lds_byte(int r, int c) { const int st = (r >> 4) * 2 + (c >> 5), rr = r & 15, cc = c & 31, ob = rr * 64 + cc * 2; return st * 1024 + (ob ^ (((ob >> 9) & 1) << 5)); }
__host__ __device__ __forceinline__ void stage_rc(int b, int& R, int& C) { const int st = b / 1024, sb = b % 1024, swz = sb ^ (((sb >> 9) & 1) << 5); R = (st >> 1) * 16 + swz / 64; C = (st & 1) * 32 + (swz % 64) / 2; }
__host__ __device__ __forceinline__ int perm32(int rho) { const int n = rho >> 4, i = rho & 15; return 8 * (i >> 2) + 4 * n + (i & 3); }

struct Unit { int pm, pn; int abyte, bbyte; };
struct Gemm { const bf16_t* A; const bf16_t* Bt; int lda, ldb, K; };

struct StaticOrder {
    int nM, nN, nwg, G, c, ta, tb;
    __device__ void init(int Mr, int N, int G_, int c_, int lda, int ldb) { nM = Mr / BM; nN = N / BM; nwg = nM * nN; G = G_; c = c_; ta = BM * lda * 2; tb = BM * ldb * 2; }
    __device__ bool next(int i, Unit& u) const {
        const long L = (long)i * G + c; if (L >= nwg) return false;
        int wgid = (int)L; { const int q = nwg / NXCD, r = nwg % NXCD, xcd = wgid % NXCD, off = wgid / NXCD; wgid = (xcd < r ? xcd * (q + 1) : r * (q + 1) + (xcd - r) * q) + off; }
        const int nig = WGM * nN, gid = wgid / nig, fm = gid * WGM, gsz = (nM - fm) < WGM ? (nM - fm) : WGM;
        u.pm = fm + ((wgid % nig) % gsz); u.pn = (wgid % nig) / gsz; u.abyte = u.pm * ta; u.bbyte = u.pn * tb; return true;
    }
};
struct SingleUnit {
    Unit u0;
    __device__ bool next(int i, Unit& u) const { if (i != 0) return false; u = u0; return true; }
};

template <class Epi, class Sched>
__device__ __forceinline__ void gemm_phase(int tid_in, LAS unsigned char* lds, const Gemm g, const Sched& S, const Epi& E) {
    int tid = tid_in; asm volatile("" : "+v"(tid));
    const int wid = __builtin_amdgcn_readfirstlane(tid >> 6), lane = tid & 63, wr = wid >> 2, wc = wid & 3, fr = lane & 15, fq = lane >> 4;
    const int K = g.K, nt = K / BK;
    unsigned voffA[2], voffB[2];
#pragma unroll
    for (int i = 0; i < 2; ++i) { int R, C; stage_rc(tid * 16 + i * 8192, R, C); const int Rb = Epi::PERM ? ((R & ~31) + perm32(R & 31)) : R;
        voffA[i] = (unsigned)(R * g.lda + C) * 2u; voffB[i] = (unsigned)(Rb * g.ldb + C) * 2u; }
    const int kstep = BK * 2;
    const int hstepA = HALF * g.lda * 2, hstepB = HALF * g.ldb * 2;
    const __amdgpu_buffer_rsrc_t rsA = __builtin_amdgcn_make_buffer_rsrc((void*)g.A, 0, 0x7ffffff0, 0x00020000);
    const __amdgpu_buffer_rsrc_t rsB = __builtin_amdgcn_make_buffer_rsrc((void*)g.Bt, 0, 0x7ffffff0, 0x00020000);
    const unsigned ldsw = (unsigned)wid * 1024u;
    const int aoff = lds_byte(wr * 64 + fr, fq * 8), boff = lds_byte(wc * 32 + fr, fq * 8);
#define PG8_SA(b, h) (((b) * 2 + (h)) * HTB)
#define PG8_SB(b, h) ((4 + (b) * 2 + (h)) * HTB)
#define PG8_STAGEA(bufoff, soff) do { _Pragma("unroll") for (int _i = 0; _i < 2; ++_i) \
        __builtin_amdgcn_raw_ptr_buffer_load_lds(rsA, (LAS void*)(lds + (bufoff) + ldsw + _i * 8192), 16, (int)voffA[_i], (soff), 0, 0); } while (0)
#define PG8_STAGEB(bufoff, soff) do { _Pragma("unroll") for (int _i = 0; _i < 2; ++_i) \
        __builtin_amdgcn_raw_ptr_buffer_load_lds(rsB, (LAS void*)(lds + (bufoff) + ldsw + _i * 8192), 16, (int)voffB[_i], (soff), 0, 0); } while (0)
#define PG8_LDA(dst, b, h) do { _Pragma("unroll") for (int m = 0; m < 4; ++m) _Pragma("unroll") for (int k = 0; k < 2; ++k) dst[m][k] = *(const LAS bf16x8*)(lds + PG8_SA(b, h) + aoff + m * 2048 + k * 1024); } while (0)
#define PG8_LDB(dst, b, h) do { _Pragma("unroll") for (int n = 0; n < 2; ++n) _Pragma("unroll") for (int k = 0; k < 2; ++k) dst[n][k] = *(const LAS bf16x8*)(lds + PG8_SB(b, h) + boff + n * 2048 + k * 1024); } while (0)
#define PG8_MMA(ai, bj, At, Bt) do { __builtin_amdgcn_s_setprio(1); _Pragma("unroll") for (int m = 0; m < 4; ++m) _Pragma("unroll") for (int n = 0; n < 2; ++n) _Pragma("unroll") for (int k = 0; k < 2; ++k) \
        acc[ai][bj][m][n] = __builtin_amdgcn_mfma_f32_16x16x32_bf16(Bt[n][k], At[m][k], acc[ai][bj][m][n], 0, 0, 0); __builtin_amdgcn_s_setprio(0); } while (0)
#define PG8_WAIT_V(n) asm volatile("s_waitcnt vmcnt(" #n ")" ::: "memory")
#define PG8_WAIT_L(n) asm volatile("s_waitcnt lgkmcnt(" #n ")" ::: "memory")
#define PG8_BAR __builtin_amdgcn_s_barrier()
#define PG8_SCHED __builtin_amdgcn_sched_barrier(0)
    Unit cur, nxt; int ui = 0;
    if (!S.next(0, cur)) return;
    f32x4 acc[2][2][4][2];
#pragma unroll
    for (int a = 0; a < 2; ++a)
#pragma unroll
        for (int b = 0; b < 2; ++b)
#pragma unroll
            for (int m = 0; m < 4; ++m)
#pragma unroll
                for (int n = 0; n < 2; ++n) acc[a][b][m][n] = (f32x4){0.f, 0.f, 0.f, 0.f};
    bf16x8 At[4][2], B0[2][2], B1[2][2];
    int cA = cur.abyte, cB = cur.bbyte;
    PG8_STAGEB(PG8_SB(0, 0), cB); PG8_STAGEB(PG8_SB(0, 1), cB + hstepB); PG8_STAGEA(PG8_SA(0, 0), cA); PG8_STAGEA(PG8_SA(0, 1), cA + hstepA);
    if (wr == 1) PG8_BAR;
    PG8_WAIT_V(2); PG8_BAR;
    PG8_STAGEB(PG8_SB(1, 0), cB + kstep); PG8_STAGEA(PG8_SA(1, 0), cA + kstep); PG8_STAGEB(PG8_SB(1, 1), cB + hstepB + kstep);
    PG8_WAIT_V(6); PG8_BAR;
    for (;;) {
        const bool has_next = S.next(ui + 1, nxt);
        const int nA = has_next ? nxt.abyte : cA, nB = has_next ? nxt.bbyte : cB;
#pragma unroll 1
        for (int t = 0; t < nt; t += 2) {
            const bool last = (t == nt - 2);
            const int a1 = cA + (t + 1) * kstep;
            const int a2 = last ? nA : cA + (t + 2) * kstep, b2 = last ? nB : cB + (t + 2) * kstep;
            const int a3 = a2 + kstep, b3 = b2 + kstep;
            PG8_LDB(B0, 0, 0); PG8_LDB(B1, 0, 1); PG8_SCHED; PG8_LDA(At, 0, 0); PG8_STAGEA(PG8_SA(1, 1), a1 + hstepA);
            PG8_WAIT_V(8); PG8_WAIT_L(0); PG8_BAR; PG8_MMA(0, 0, At, B0); PG8_MMA(0, 1, At, B1); PG8_BAR; PG8_SCHED;
            PG8_LDA(At, 0, 1); PG8_STAGEB(PG8_SB(0, 0), b2); PG8_STAGEB(PG8_SB(0, 1), b2 + hstepB); PG8_STAGEA(PG8_SA(0, 0), a2);
            PG8_WAIT_V(8); PG8_WAIT_L(0); PG8_BAR; PG8_MMA(1, 0, At, B0); PG8_MMA(1, 1, At, B1); PG8_BAR; PG8_SCHED;
            PG8_LDB(B0, 1, 0); PG8_LDB(B1, 1, 1); PG8_SCHED; PG8_LDA(At, 1, 0); PG8_STAGEA(PG8_SA(0, 1), a2 + hstepA);
            PG8_WAIT_V(8); PG8_WAIT_L(0); PG8_BAR; PG8_MMA(0, 0, At, B0); PG8_MMA(0, 1, At, B1); PG8_BAR; PG8_SCHED;
            PG8_LDA(At, 1, 1); PG8_STAGEB(PG8_SB(1, 0), b3); PG8_STAGEB(PG8_SB(1, 1), b3 + hstepB); PG8_STAGEA(PG8_SA(1, 0), a3);
            PG8_WAIT_V(8); PG8_WAIT_L(0); PG8_BAR; PG8_MMA(1, 0, At, B0); PG8_MMA(1, 1, At, B1); PG8_BAR; PG8_SCHED;
        }
        if constexpr (!Epi::AFTER_DRAIN) { if (wr == 0) PG8_BAR; int l2 = lane; asm volatile("" : "+v"(l2)); int w2 = wid; asm volatile("" : "+s"(w2)); E(acc, cur, w2 >> 2, w2 & 3, l2 & 15, l2 >> 4); }
        if (!has_next) break;
#pragma unroll
        for (int a = 0; a < 2; ++a)
#pragma unroll
            for (int b = 0; b < 2; ++b)
#pragma unroll
                for (int m = 0; m < 4; ++m)
#pragma unroll
                    for (int n = 0; n < 2; ++n) acc[a][b][m][n] = (f32x4){0.f, 0.f, 0.f, 0.f};
        cur = nxt; cA = nA; cB = nB; ++ui;
        if constexpr (!Epi::AFTER_DRAIN) { if (wr == 1) PG8_BAR; }
    }
    PG8_WAIT_V(0);
    if constexpr (Epi::AFTER_DRAIN) { if (wr == 0) PG8_BAR; }
    PG8_BAR;
    if constexpr (Epi::AFTER_DRAIN) { int l2 = lane; asm volatile("" : "+v"(l2)); int w2 = wid; asm volatile("" : "+s"(w2)); E.fused(acc, cur, w2 >> 2, w2 & 3, l2 & 15, l2 >> 4, lds, w2, l2); }
#undef PG8_SA
#undef PG8_SB
#undef PG8_STAGEA
#undef PG8_STAGEB
#undef PG8_LDA
#undef PG8_LDB
#undef PG8_MMA
#undef PG8_WAIT_V
#undef PG8_WAIT_L
#undef PG8_BAR
#undef PG8_SCHED
}
}

#define XB_TMO      128
#define XB_XCNT(j)  (256  + 64 * (j))
#define XB_XSUB(j)  (1280 + 64 * (j))
#define XB_XGEN(j)  (2304 + 64 * (j))
#define XB_TOP      3328
#define XB_TOPGEN   3392
#define XCD_BAR_WORDS 3456
#define XB_SPIN_CAP (1u << 18)
__device__ __forceinline__ unsigned xb_ld(unsigned* p)              { return __hip_atomic_load(p, __ATOMIC_RELAXED, __HIP_MEMORY_SCOPE_AGENT); }
__device__ __forceinline__ unsigned xb_add(unsigned* p, unsigned v) { return __hip_atomic_fetch_add(p, v, __ATOMIC_RELAXED, __HIP_MEMORY_SCOPE_AGENT); }
__device__ __forceinline__ unsigned xb_xcc_id() { return (unsigned)__builtin_amdgcn_s_getreg((3 << 11) | 20) & 0xFu; }
#define XB_SPIN(cond, bar) do { unsigned _sp = 0; while (cond) { __builtin_amdgcn_s_sleep(1); \
    if ((++_sp & 255u) == 0u) { if (xb_ld(&(bar)[XB_TMO])) break; if (_sp > XB_SPIN_CAP) { atomicAdd(&(bar)[XB_TMO], 1u); break; } } } } while (0)
struct XcdBarrier { unsigned* bar; unsigned x; volatile LAS unsigned* st; };
__device__ __forceinline__ XcdBarrier xcd_barrier_post(unsigned* bar, volatile LAS unsigned* st) {
    XcdBarrier b; b.bar = bar; b.x = xb_xcc_id(); b.st = st;
    if (threadIdx.x == 0) (void)xb_add(&bar[XB_XCNT(b.x)], 1u);
    return b;
}
__device__ __forceinline__ void xcd_barrier_complete(unsigned* bar, unsigned x, unsigned& nloc, unsigned& nx) {
    const unsigned G = gridDim.x * gridDim.y * gridDim.z;
    unsigned sum, cnt, mine, sp = 0u;
    for (;;) {
        sum = 0u; cnt = 0u; mine = 0u;
#pragma unroll
        for (unsigned j = 0; j < 16; ++j) { const unsigned c = xb_ld(&bar[XB_XCNT(j)]); sum += c; cnt += (c > 0u) ? 1u : 0u; mine = (j == x) ? c : mine; }
        if (sum == G) break;
        __builtin_amdgcn_s_sleep(1);
        if ((++sp & 255u) == 0u) { if (xb_ld(&bar[XB_TMO])) break; if (sp > XB_SPIN_CAP) { atomicAdd(&bar[XB_TMO], 1u); break; } }
    }
    nloc = mine > 0u ? mine : 1u; nx = cnt > 0u ? cnt : 1u;
}
__device__ __forceinline__ void xcd_barrier(const XcdBarrier& b) {
    asm volatile("s_waitcnt vmcnt(0)" ::: "memory");
    __syncthreads();
    if (threadIdx.x == 0) {
        unsigned* bar = b.bar;
        __builtin_amdgcn_s_waitcnt(0);
        unsigned nloc = b.st[0], nx = b.st[1];
        if (nloc == 0u) { xcd_barrier_complete(bar, b.x, nloc, nx); b.st[0] = nloc; b.st[1] = nx; }
        const unsigned old = xb_add(&bar[XB_XSUB(b.x)], 1u);
        const unsigned gen = old / nloc;
        if (old + 1u == (gen + 1u) * nloc) {
            __builtin_amdgcn_fence(__ATOMIC_RELEASE, "agent");
            asm volatile("s_waitcnt vmcnt(0)" ::: "memory");
            const unsigned og = xb_add(&bar[XB_TOP], 1u);
            const unsigned tg = og / nx;
            if (og + 1u == (tg + 1u) * nx) xb_add(&bar[XB_TOPGEN], 1u);
            else XB_SPIN(xb_ld(&bar[XB_TOPGEN]) == tg, bar);
            __builtin_amdgcn_fence(__ATOMIC_ACQUIRE, "agent");
            xb_add(&bar[XB_XGEN(b.x)], 1u);
            asm volatile("s_waitcnt vmcnt(0)" ::: "memory");
        } else {
            XB_SPIN(xb_ld(&bar[XB_XGEN(b.x)]) == gen, bar);
            __builtin_amdgcn_fence(__ATOMIC_ACQUIRE, "agent");
            asm volatile("s_waitcnt vmcnt(0)" ::: "memory");
        }
    }
    __syncthreads();
}

struct Frame {
    LAS unsigned char* lds;
    unsigned* ctl;
    int tid, lane, wave, vcu, G;
    unsigned char* ws;
};
struct Args { const float* in[15]; float* out; unsigned char* ws; int ph_lo, ph_hi, li, pad; };

__device__ __forceinline__ int fresh(int v) { asm volatile("" : "+v"(v)); return v; }
__device__ __forceinline__ float wave_sum(float v) {
#pragma unroll
    for (int o = 1; o < 64; o <<= 1) v += __shfl_xor(v, o);
    return v;
}
__device__ __forceinline__ float wave_max(float v) {
#pragma unroll
    for (int o = 1; o < 64; o <<= 1) v = fmaxf(v, __shfl_xor(v, o));
    return v;
}

template <class RowFn>
__device__ __forceinline__ void p0_transpose_item(const float* W, int K, int N, const float* kscale, float gscale, const RowFn& rowptr, LAS float* scr, int item, int lane) {
    const int nblk = N / 32, kb = item / nblk, nb = item % nblk, k0 = 64 * kb, n0 = 32 * nb;
    float wv[32];
#pragma unroll
    for (int i = 0; i < 32; ++i) wv[i] = W[(size_t)(k0 + 2 * i + (lane >> 5)) * N + n0 + (lane & 31)];
#pragma unroll
    for (int i = 0; i < 32; ++i) { const int kk = 2 * i + (lane >> 5); const float sc = kscale ? kscale[k0 + kk] * gscale : gscale; scr[kk * 33 + (lane & 31)] = wv[i] * sc; }
    LDS_WAIT(); asm volatile("" ::: "memory");
    const int c = lane & 7;
#pragma unroll
    for (int j = 0; j < 4; ++j) { const int n = (lane >> 3) + 8 * j; const LAS float* s = scr + (8 * c) * 33 + n;
        u32x4 o; o.x = cvt_pk_bf16(s[0 * 33], s[1 * 33]); o.y = cvt_pk_bf16(s[2 * 33], s[3 * 33]); o.z = cvt_pk_bf16(s[4 * 33], s[5 * 33]); o.w = cvt_pk_bf16(s[6 * 33], s[7 * 33]);
        *(u32x4*)(rowptr(n0 + n) + k0 + 8 * c) = o; }
    LDS_WAIT(); asm volatile("" ::: "memory");
}

__device__ __forceinline__ void p0_prologue(Frame& F, const Args& a) {
    LAS float* scr = (LAS float*)(F.lds + F.wave * 16384);
    const int gw = F.vcu * 8 + F.wave, NGW = F.G * 8;
    bf16_t* Wb = (bf16_t*)(F.ws + WS_W);
    constexpr int I_IN = (DM / 64) * (NIN / 32), I_OA = (512 / 64) * (DM / 32), I_OL = (DM / 64) * (DM / 32), I_RG = (256 / 64) * (256 / 32);
    constexpr int PER_LAYER = I_IN + I_OA + 2 * I_OL + 16 * I_RG;
    for (int it = gw; it < DEPTH * PER_LAYER; it += NGW) {
        const int l = it / PER_LAYER; int r = it % PER_LAYER;
        if (r < I_IN) { bf16_t* dst = Wb + W_IN_T / 2 + (size_t)l * NIN * DM;
            p0_transpose_item(a.in[2] + (size_t)l * DM * NIN, DM, NIN, a.in[1] + l * DM, 1.0f, [=](int n) { return dst + (size_t)n * DM; }, scr, r, F.lane); continue; } r -= I_IN;
        if (r < I_OA) { bf16_t* dst = Wb + W_OATT_T / 2 + (size_t)l * DM * 512;
            p0_transpose_item(a.in[11] + (size_t)l * 512 * DM, 512, DM, nullptr, 1.0f, [=](int n) { return dst + (size_t)n * 512; }, scr, r, F.lane); continue; } r -= I_OA;
        if (r < I_OL) { bf16_t* dst = Wb + W_OLRU_T / 2 + (size_t)l * DM * DM;
            p0_transpose_item(a.in[12] + (size_t)l * DM * DM, DM, DM, nullptr, 1.0f, [=](int n) { return dst + (size_t)n * DM; }, scr, r, F.lane); continue; } r -= I_OL;
        if (r < I_OL) { bf16_t* dst = Wb + W_OUT_T / 2 + (size_t)l * DM * DM;
            p0_transpose_item(a.in[13] + (size_t)l * DM * DM, DM, DM, nullptr, 1.0f, [=](int n) { return dst + (size_t)n * DM; }, scr, r, F.lane); continue; } r -= I_OL;
        {
            const int s = r / I_RG, item = r % I_RG, dir = s >> 3, kind = (s >> 2) & 1, n = s & 3;
            const float* src = (kind ? a.in[8] : a.in[6]) + ((size_t)((l * 2 + dir) * 4 + n)) * 65536;
            bf16_t* dst = Wb + W_RG_T / 2 + (size_t)(l * 4 + n) * 4 * 65536;
            p0_transpose_item(src, 256, 256, nullptr, -LOG2E, [=](int j) { return dst + (size_t)(j >> 6) * 65536 + (size_t)(128 * dir + 32 * ((j >> 4) & 3) + 16 * kind + (j & 15)) * 256; }, scr, item, F.lane);
        }
    }
    for (int i = gw * 64 + F.lane; i < DEPTH * 2 * DM; i += NGW * 64) {
        const float c2 = -8.0f * LOG2E * log1pf(expf(-a.in[10][i]));
        ((f32x4*)(F.ws + WS_LC))[i] = (f32x4){-LOG2E * a.in[7][i], -LOG2E * a.in[9][i], c2, 2.0f * c2};
    }
    const float* x = a.in[0]; bf16_t* XB = (bf16_t*)(F.ws + WS_XB); float* ss = (float*)(F.ctl + CW_SS);
    for (int m0 = gw * 4; m0 < M; m0 += NGW * 4) {
        f32x4 v[4][4];
#pragma unroll
        for (int r = 0; r < 4; ++r)
#pragma unroll
            for (int j = 0; j < 4; ++j) v[r][j] = ((const f32x4*)(x + (size_t)(m0 + r) * DM))[F.lane + 64 * j];
#pragma unroll
        for (int r = 0; r < 4; ++r) { float s = 0.f;
            unsigned long long* o8 = (unsigned long long*)(XB + (size_t)(m0 + r) * DM) + F.lane;
#pragma unroll
            for (int j = 0; j < 4; ++j) { const f32x4 t = v[r][j]; s += (t.x * t.x + t.y * t.y) + (t.z * t.z + t.w * t.w);
                o8[64 * j] = (unsigned long long)cvt_pk_bf16(t.x, t.y) | ((unsigned long long)cvt_pk_bf16(t.z, t.w) << 32); }
            s = wave_sum(s);
            if (F.lane == 0) ss[m0 + r] = s; }
    }
}

struct EpiProjA {
    static constexpr bool PERM = true, AFTER_DRAIN = false;
    unsigned char* ws; const float* ss; bool dry;
    __device__ __forceinline__ void operator()(const f32x4 (&acc)[2][2][4][2], const pg8::Unit& u, int wr, int wc, int fr, int fq) const {
        const int kind = u.pn / 6;
        float rs[2][4];
#pragma unroll
        for (int ai = 0; ai < 2; ++ai)
#pragma unroll
            for (int m = 0; m < 4; ++m) rs[ai][m] = ss[u.pm * 256 + ai * 128 + wr * 64 + m * 16 + fr];
#pragma unroll
        for (int ai = 0; ai < 2; ++ai)
#pragma unroll
            for (int m = 0; m < 4; ++m) {
                const int row = u.pm * 256 + ai * 128 + wr * 64 + m * 16 + fr;
                const float rstd = __builtin_amdgcn_rsqf(rs[ai][m] * (1.0f / DM) + NORM_EPS);
                if (kind < 3) {
                    const int b = row >> 13, p = row & 8191; const float sc = (kind == 0) ? rstd * QSCALE : rstd;
                    bf16_t* base = (bf16_t*)(ws + WS_Q + (size_t)kind * (WS_K - WS_Q));
#pragma unroll
                    for (int bj = 0; bj < 2; ++bj) {
                        const int hh = 2 * (u.pn - 6 * kind) + bj, sh = 2 * (hh >> 2);
                        const int rho = ((p & ((1 << sh) - 1)) << (13 - sh)) + (p >> sh);
                        bf16_t* dst = base + ((size_t)(b * NH + hh) * SEQ + rho) * HD + wc * 32 + 8 * fq;
                        const f32x4 v0 = acc[ai][bj][m][0] * sc, v1 = acc[ai][bj][m][1] * sc;
                        u32x4 w; w.x = cvt_pk_bf16(v0[0], v0[1]); w.y = cvt_pk_bf16(v0[2], v0[3]); w.z = cvt_pk_bf16(v1[0], v1[1]); w.w = cvt_pk_bf16(v1[2], v1[3]);
                        if (!dry) *(u32x4*)dst = w; else asm volatile("" :: "v"(w));
                    }
                } else {
#pragma unroll
                    for (int bj = 0; bj < 2; ++bj) {
                        bf16_t* dst = (bf16_t*)(ws + WS_SGA) + (size_t)row * 512 + (u.pn - 18) * 256 + bj * 128 + wc * 32 + 8 * fq;
                        const f32x4 v0 = acc[ai][bj][m][0] * rstd, v1 = acc[ai][bj][m][1] * rstd;
                        u32x4 w; w.x = cvt_pk_bf16(fast_silu(v0[0]), fast_silu(v0[1])); w.y = cvt_pk_bf16(fast_silu(v0[2]), fast_silu(v0[3]));
                        w.z = cvt_pk_bf16(fast_silu(v1[0]), fast_silu(v1[1])); w.w = cvt_pk_bf16(fast_silu(v1[2]), fast_silu(v1[3]));
                        *(u32x4*)dst = w;
                    }
                }
            }
    }
};
struct EpiProjB {
    static constexpr bool PERM = true, AFTER_DRAIN = false;
    unsigned char* ws; const float* ss; const float* bgate;
    __device__ __forceinline__ void operator()(const f32x4 (&acc)[2][2][4][2], const pg8::Unit& u, int wr, int wc, int fr, int fq) const {
        const int kind = u.pn < 4 ? 0 : (u.pn < 8 ? 1 : 2);
        f32x4 bv[2][2];
#pragma unroll
        for (int bj = 0; bj < 2; ++bj)
#pragma unroll
            for (int n = 0; n < 2; ++n) bv[bj][n] = (kind == 2) ? *(const f32x4*)(bgate + (u.pn - 8) * 256 + bj * 128 + wc * 32 + 8 * fq + 4 * n) : (f32x4){0.f, 0.f, 0.f, 0.f};
        float rs[2][4];
#pragma unroll
        for (int ai = 0; ai < 2; ++ai)
#pragma unroll
            for (int m = 0; m < 4; ++m) rs[ai][m] = ss[u.pm * 256 + ai * 128 + wr * 64 + m * 16 + fr];
#pragma unroll
        for (int ai = 0; ai < 2; ++ai)
#pragma unroll
            for (int m = 0; m < 4; ++m) {
                const int row = u.pm * 256 + ai * 128 + wr * 64 + m * 16 + fr;
                const float rstd = __builtin_amdgcn_rsqf(rs[ai][m] * (1.0f / DM) + NORM_EPS);
#pragma unroll
                for (int bj = 0; bj < 2; ++bj) {
                    const int cin = bj * 128 + wc * 32 + 8 * fq;
                    f32x4 v0 = acc[ai][bj][m][0] * rstd, v1 = acc[ai][bj][m][1] * rstd;
                    bf16_t* dst;
                    if (kind == 0) dst = (bf16_t*)(ws + WS_XLRU) + (size_t)row * DM + u.pn * 256 + cin;
                    else if (kind == 1) { dst = (bf16_t*)(ws + WS_SGL) + (size_t)row * DM + (u.pn - 4) * 256 + cin;
#pragma unroll
                        for (int e = 0; e < 4; ++e) { v0[e] = fast_silu(v0[e]); v1[e] = fast_silu(v1[e]); } }
                    else { dst = (bf16_t*)(ws + WS_GATE) + (size_t)row * 2048 + (u.pn - 8) * 256 + cin; v0 += bv[bj][0]; v1 += bv[bj][1];
#pragma unroll
                        for (int e = 0; e < 4; ++e) { v0[e] = fast_sigmoid(v0[e]); v1[e] = fast_sigmoid(v1[e]); } }
                    u32x4 w; w.x = cvt_pk_bf16(v0[0], v0[1]); w.y = cvt_pk_bf16(v0[2], v0[3]); w.z = cvt_pk_bf16(v1[0], v1[1]); w.w = cvt_pk_bf16(v1[2], v1[3]);
                    *(u32x4*)dst = w;
                }
            }
    }
};
template <bool FIRST> struct EpiMerge {
    static constexpr bool PERM = true, AFTER_DRAIN = false;
    bf16_t* MG; const bf16_t* GATE;
    __device__ __forceinline__ void operator()(const f32x4 (&acc)[2][2][4][2], const pg8::Unit& u, int wr, int wc, int fr, int fq) const {
#pragma unroll
        for (int ai = 0; ai < 2; ++ai) {
            u32x4 gw[4][2], pw[4][2];
#pragma unroll
            for (int m = 0; m < 4; ++m)
#pragma unroll
                for (int bj = 0; bj < 2; ++bj) {
                    const int row = u.pm * 256 + ai * 128 + wr * 64 + m * 16 + fr, col = u.pn * 256 + bj * 128 + wc * 32 + 8 * fq;
                    gw[m][bj] = *(const u32x4*)(GATE + (size_t)row * 2048 + col);
                    if (!FIRST) pw[m][bj] = *(const u32x4*)(MG + (size_t)row * DM + col);
                }
#pragma unroll
            for (int m = 0; m < 4; ++m)
#pragma unroll
                for (int bj = 0; bj < 2; ++bj) {
                    const int row = u.pm * 256 + ai * 128 + wr * 64 + m * 16 + fr, col = u.pn * 256 + bj * 128 + wc * 32 + 8 * fq;
                    const u32x4 g4 = gw[m][bj];
                    f32x4 v0 = acc[ai][bj][m][0], v1 = acc[ai][bj][m][1];
                    v0[0] *= bf_lo(g4.x); v0[1] *= bf_hi(g4.x); v0[2] *= bf_lo(g4.y); v0[3] *= bf_hi(g4.y);
                    v1[0] *= bf_lo(g4.z); v1[1] *= bf_hi(g4.z); v1[2] *= bf_lo(g4.w); v1[3] *= bf_hi(g4.w);
                    if (!FIRST) { const u32x4 p4 = pw[m][bj];
                        v0[0] += bf_lo(p4.x); v0[1] += bf_hi(p4.x); v0[2] += bf_lo(p4.y); v0[3] += bf_hi(p4.y);
                        v1[0] += bf_lo(p4.z); v1[1] += bf_hi(p4.z); v1[2] += bf_lo(p4.w); v1[3] += bf_hi(p4.w); }
                    u32x4 w; w.x = cvt_pk_bf16(v0[0], v0[1]); w.y = cvt_pk_bf16(v0[2], v0[3]); w.z = cvt_pk_bf16(v1[0], v1[1]); w.w = cvt_pk_bf16(v1[2], v1[3]);
                    *(u32x4*)(MG + (size_t)row * DM + col) = w;
                }
        }
    }
};
struct EpiResid {
    static constexpr bool PERM = false, AFTER_DRAIN = false;
    const float* xin; float* xout; bf16_t* XB; float* ssn; bool dry;
    __device__ __forceinline__ void operator()(const f32x4 (&acc)[2][2][4][2], const pg8::Unit& u, int wr, int wc, int fr, int fq) const {
#pragma unroll
        for (int ai = 0; ai < 2; ++ai)
#pragma unroll
            for (int mp = 0; mp < 2; ++mp) {
                f32x4 xi[2][2][2];
#pragma unroll
                for (int mm = 0; mm < 2; ++mm)
#pragma unroll
                    for (int bj = 0; bj < 2; ++bj)
#pragma unroll
                        for (int n = 0; n < 2; ++n) {
                            const int row = u.pm * 256 + ai * 128 + wr * 64 + (mp * 2 + mm) * 16 + fr;
                            xi[mm][bj][n] = *(const f32x4*)(xin + (size_t)row * DM + u.pn * 256 + bj * 128 + wc * 32 + n * 16 + 4 * fq);
                        }
#pragma unroll
                for (int mm = 0; mm < 2; ++mm) {
                    const int m = mp * 2 + mm, row = u.pm * 256 + ai * 128 + wr * 64 + m * 16 + fr; float s = 0.f;
#pragma unroll
                    for (int bj = 0; bj < 2; ++bj)
#pragma unroll
                        for (int n = 0; n < 2; ++n) {
                            const size_t off = (size_t)row * DM + u.pn * 256 + bj * 128 + wc * 32 + n * 16 + 4 * fq;
                            const f32x4 v = xi[mm][bj][n] + acc[ai][bj][m][n];
                            u32x2 w; w.x = cvt_pk_bf16(v[0], v[1]); w.y = cvt_pk_bf16(v[2], v[3]);
                            if (!dry) { *(f32x4*)(xout + off) = v; *(u32x2*)(XB + off) = w; }
                            s += (v[0] * v[0] + v[1] * v[1]) + (v[2] * v[2] + v[3] * v[3]);
                        }
                    s += __shfl_xor(s, 16); s += __shfl_xor(s, 32);
                    if (fq == 0 && !dry) atomicAdd(ssn + row, s);
                }
            }
    }
};

struct EpiResidNorm {
    static constexpr bool PERM = false, AFTER_DRAIN = true;
    const float* xin; float* out; float* ssn; const float* g; unsigned* pan; unsigned* tmo;
    __device__ __forceinline__ void fused(f32x4 (&acc)[2][2][4][2], const pg8::Unit& u, int wr, int wc, int fr, int fq, LAS unsigned char* lds, int wid, int lane) const {
#pragma unroll
        for (int ai = 0; ai < 2; ++ai)
#pragma unroll
            for (int mp = 0; mp < 2; ++mp) {
                f32x4 xi[2][2][2];
#pragma unroll
                for (int mm = 0; mm < 2; ++mm)
#pragma unroll
                    for (int bj = 0; bj < 2; ++bj)
#pragma unroll
                        for (int n = 0; n < 2; ++n) {
                            const int row = u.pm * 256 + ai * 128 + wr * 64 + (mp * 2 + mm) * 16 + fr;
                            xi[mm][bj][n] = *(const f32x4*)(xin + (size_t)row * DM + u.pn * 256 + bj * 128 + wc * 32 + n * 16 + 4 * fq);
                        }
#pragma unroll
                for (int mm = 0; mm < 2; ++mm) {
                    const int m = mp * 2 + mm, row = u.pm * 256 + ai * 128 + wr * 64 + m * 16 + fr; float s = 0.f;
#pragma unroll
                    for (int bj = 0; bj < 2; ++bj)
#pragma unroll
                        for (int n = 0; n < 2; ++n) { const f32x4 v = xi[mm][bj][n] + acc[ai][bj][m][n]; acc[ai][bj][m][n] = v; s += (v[0] * v[0] + v[1] * v[1]) + (v[2] * v[2] + v[3] * v[3]); }
                    s += __shfl_xor(s, 16); s += __shfl_xor(s, 32);
                    if (fq == 0) atomicAdd(ssn + row, s);
                }
            }
        asm volatile("s_waitcnt vmcnt(0)" ::: "memory"); __builtin_amdgcn_s_barrier(); asm volatile("" ::: "memory");
        unsigned* cnt = pan + 64 * u.pm;
        if (wid == 0) {
            if (lane == 0) __hip_atomic_fetch_add(cnt, 1u, __ATOMIC_RELAXED, __HIP_MEMORY_SCOPE_AGENT);
            unsigned sp = 0;
            while ((unsigned)__builtin_amdgcn_readfirstlane(__hip_atomic_load(cnt, __ATOMIC_RELAXED, __HIP_MEMORY_SCOPE_AGENT)) < 4u) {
                __builtin_amdgcn_s_sleep(1);
                if ((++sp & 1023u) == 0u) { if (__hip_atomic_load(tmo, __ATOMIC_RELAXED, __HIP_MEMORY_SCOPE_AGENT) != 0u) break; if (sp > (1u << 22)) { if (lane == 0) __hip_atomic_store(tmo, 1u, __ATOMIC_RELAXED, __HIP_MEMORY_SCOPE_AGENT); break; } }
            }
        }
        asm volatile("s_waitcnt vmcnt(0)" ::: "memory"); __builtin_amdgcn_s_barrier(); asm volatile("" ::: "memory");
        f32x4 gv[2][2];
#pragma unroll
        for (int bj = 0; bj < 2; ++bj)
#pragma unroll
            for (int n = 0; n < 2; ++n) gv[bj][n] = *(const f32x4*)(g + u.pn * 256 + bj * 128 + wc * 32 + n * 16 + 4 * fq);
        float rs[2][4];
#pragma unroll
        for (int ai = 0; ai < 2; ++ai)
#pragma unroll
            for (int m = 0; m < 4; ++m) rs[ai][m] = __hip_atomic_load(ssn + u.pm * 256 + ai * 128 + wr * 64 + m * 16 + fr, __ATOMIC_RELAXED, __HIP_MEMORY_SCOPE_AGENT);
#pragma unroll
        for (int ai = 0; ai < 2; ++ai)
#pragma unroll
            for (int m = 0; m < 4; ++m) {
                const int row = u.pm * 256 + ai * 128 + wr * 64 + m * 16 + fr;
                const float rstd = 1.0f / sqrtf(rs[ai][m] * (1.0f / DM) + NORM_EPS);
#pragma unroll
                for (int bj = 0; bj < 2; ++bj)
#pragma unroll
                    for (int n = 0; n < 2; ++n)
                        *(f32x4*)(out + (size_t)row * DM + u.pn * 256 + bj * 128 + wc * 32 + n * 16 + 4 * fq) = acc[ai][bj][m][n] * rstd * gv[bj][n];
            }
    }
};

__device__ __forceinline__ void attn_naive(Frame& F) {
    bf16_t* Q = (bf16_t*)(F.ws + WS_Q); const bf16_t* Kb = (const bf16_t*)(F.ws + WS_K); const bf16_t* Vb = (const bf16_t*)(F.ws + WS_V);
    float* LSE = (float*)(F.ws + WS_LSE);
    const int gw = F.vcu * 8 + F.wave, NGW = F.G * 8, lane = F.lane;
    for (int item = gw; item < BATCH * NH * SEQ; item += NGW) {
        const int bh = item >> 13, rho = item & 8191, hh = bh % NH, sh = 2 * (hh >> 2), ng = SEQ >> sh;
        const int idx = rho & (ng - 1);
        const size_t rowq = (size_t)bh * SEQ + rho;
        const float slope2 = exp2f(-8.0f * (float)(hh + 1) / 12.0f) * (float)(1 << sh) * LOG2E;
        float s[3]; bool ok[3];
#pragma unroll
        for (int t = 0; t < 3; ++t) {
            const int j = lane - 64 + 64 * t; ok[t] = (j <= 64) && (idx + j >= 0) && (idx + j < ng); s[t] = -1e30f;
            if (ok[t]) {
                const u32x4* kp = (const u32x4*)(Kb + (rowq + j) * HD); const u32x4* qp = (const u32x4*)(Q + rowq * HD); float d = 0.f;
#pragma unroll 4
                for (int c = 0; c < 16; ++c) { const u32x4 kv = kp[c], qv = qp[c];
                    d += bf_lo(kv.x) * bf_lo(qv.x) + bf_hi(kv.x) * bf_hi(qv.x) + bf_lo(kv.y) * bf_lo(qv.y) + bf_hi(kv.y) * bf_hi(qv.y)
                       + bf_lo(kv.z) * bf_lo(qv.z) + bf_hi(kv.z) * bf_hi(qv.z) + bf_lo(kv.w) * bf_lo(qv.w) + bf_hi(kv.w) * bf_hi(qv.w); }
                s[t] = d - slope2 * fabsf((float)j);
            }
        }
        const float mx = wave_max(fmaxf(fmaxf(s[0], s[1]), s[2]));
        float p[3];
#pragma unroll
        for (int t = 0; t < 3; ++t) p[t] = ok[t] ? exp2f(s[t] - mx) : 0.f;
        const float den = wave_sum(p[0] + p[1] + p[2]);
        float o0 = 0.f, o1 = 0.f;
#pragma unroll
        for (int t = 0; t < 3; ++t)
            for (int src = 0; src < 64; ++src) {
                const int j = src - 64 + 64 * t; if (j > 64) break;
                if (idx + j < 0 || idx + j >= ng) continue;
                const float pj = __shfl(p[t], src);
                const unsigned vv = *(const unsigned*)(Vb + (rowq + j) * HD + 2 * lane);
                o0 += pj * bf_lo(vv); o1 += pj * bf_hi(vv);
            }
        const float inv = 1.0f / den;
        *(unsigned*)(Q + rowq * HD + 2 * lane) = cvt_pk_bf16(o0 * inv, o1 * inv);
        if (lane == 0) LSE[rowq] = mx + log2f(den);
    }
}

typedef float f32x16 __attribute__((ext_vector_type(16)));
typedef short s16x4 __attribute__((ext_vector_type(4)));
typedef __bf16 bf16x2_t __attribute__((ext_vector_type(2)));
__device__ __forceinline__ unsigned cvtpk_c(float lo, float hi) { f32x2 v = {lo, hi}; bf16x2_t b = __builtin_convertvector(v, bf16x2_t); return __builtin_bit_cast(unsigned, b); }
__device__ __forceinline__ int crow(int r, int hi) { return (r & 3) + 8 * (r >> 2) + 4 * hi; }
__device__ __forceinline__ void attn_dma(LAS unsigned char* img, const bf16_t* base, int U, int seq_lo, int seq_hi, int w, int lane) {
    const __amdgpu_buffer_rsrc_t rs = __builtin_amdgcn_make_buffer_rsrc((void*)base, 0, SEQ * 256, 0x00020000);
    const int rl0 = lane >> 4, cp = lane & 15;
#pragma unroll
    for (int i = 0; i < 12; ++i) {
        const int pc = w * 12 + i, row_local = 4 * pc + rl0;
        int grow = U - 64 + row_local; grow = grow < seq_lo ? seq_lo : grow; grow = grow > seq_hi - 1 ? seq_hi - 1 : grow;
        const int voff = grow * 256 + ((cp ^ ((rl0 << 2) | (i & 3))) << 4);
        __builtin_amdgcn_raw_ptr_buffer_load_lds(rs, (LAS void*)(img + pc * 1024), 16, voff, 0, 0, 0);
    }
}
constexpr int ATT_STG = 98304;
struct AttnUnit { int bh, U, seq_lo, seq_hi, hh, sh; };
__device__ __forceinline__ AttnUnit attn_decode(int unit) {
    AttnUnit a; a.bh = unit >> 5; const int qb = unit & 31; a.hh = a.bh % NH; a.sh = 2 * (a.hh >> 2); const int ng = SEQ >> a.sh;
    a.U = qb * 256; a.seq_lo = a.U & ~(ng - 1); a.seq_hi = a.seq_lo + ng; return a;
}
__device__ __forceinline__ void attn_unit(Frame& F, int unit, int next_unit, bool dry) {
    LAS unsigned char* img = F.lds;
    const int lane = F.lane, w = F.wave, c = lane & 31, hi = lane >> 5;
    const AttnUnit au = attn_decode(unit);
    const int bh = au.bh, U = au.U, seq_lo = au.seq_lo, seq_hi = au.seq_hi;
    bf16_t* Qh = (bf16_t*)(F.ws + WS_Q) + (size_t)bh * SEQ * HD;
    const bf16_t* Vh = (const bf16_t*)(F.ws + WS_V) + (size_t)bh * SEQ * HD;
    bf16x8 qf[8];
    { const bf16_t* qrow = Qh + (size_t)(U + 32 * w + c) * HD + 8 * hi;
#pragma unroll
      for (int s = 0; s < 8; ++s) qf[s] = *(const bf16x8*)(qrow + 16 * s); }
    const float slope2 = exp2f(-8.0f * (float)(au.hh + 1) / 12.0f) * (float)(1 << au.sh) * LOG2E;
    asm volatile("s_waitcnt vmcnt(0)" ::: "memory"); __builtin_amdgcn_s_barrier(); asm volatile("" ::: "memory");
    f32x16 p[5];
    {   const int lk = fresh(lane), ck = lk & 31, hk = lk >> 5;
        const unsigned swz = ((unsigned)(ck & 3) << 2) | ((unsigned)(ck >> 2) & 3u);
        unsigned kx[8];
#pragma unroll
        for (int s = 0; s < 8; ++s) kx[s] = 256u * (unsigned)(32 * w + ck) + 16u * (((unsigned)(2 * s + hk)) ^ swz);
#pragma unroll
        for (int i = 0; i < 5; ++i) {
            f32x16 a = {0.f, 0.f, 0.f, 0.f, 0.f, 0.f, 0.f, 0.f, 0.f, 0.f, 0.f, 0.f, 0.f, 0.f, 0.f, 0.f};
#pragma unroll
            for (int s = 0; s < 8; ++s) { const bf16x8 kf = *(const LAS bf16x8*)(img + kx[s] + 8192 * i); a = __builtin_amdgcn_mfma_f32_32x32x16_bf16(kf, qf[s], a, 0, 0, 0); }
            p[i] = a;
        }
    }
    asm volatile("s_waitcnt lgkmcnt(0)" ::: "memory"); __builtin_amdgcn_s_barrier(); asm volatile("" ::: "memory");
    attn_dma(img, Vh, U, seq_lo, seq_hi, w, lane);
    const bool lo_edge = (U == seq_lo), hi_edge = (U + 256 == seq_hi);
    const int lm = fresh(lane);
    const float dbase = (float)(4 * (lm >> 5) - (lm & 31));
    float mx = -1e30f;
#pragma unroll
    for (int i = 0; i < 5; ++i) {
        const bool tile_dead = (lo_edge && (w + i < 2)) || (hi_edge && (w + i >= 10));
#pragma unroll
        for (int r = 0; r < 16; ++r) {
            const float ad = fabsf((float)(32 * i + (r & 3) + 8 * (r >> 2) - 64) + dbase);
            float s = p[i][r] - slope2 * ad;
            if (i == 0 || i == 4) s = (ad <= 64.0f) ? s : -1e30f;
            if (tile_dead) s = -1e30f;
            p[i][r] = s; mx = fmaxf(mx, s);
        }
    }
    mx = fmaxf(mx, __shfl_xor(mx, 32));
    float l = 0.f;
    u32x4 pa[5][2];
#pragma unroll
    for (int i = 0; i < 5; ++i) {
#pragma unroll
        for (int r = 0; r < 16; ++r) { const float e = __builtin_amdgcn_exp2f(p[i][r] - mx); p[i][r] = e; l += e; }
#pragma unroll
        for (int s = 0; s < 2; ++s) {
            pa[i][s].x = cvtpk_c(p[i][8 * s + 0], p[i][8 * s + 1]); pa[i][s].y = cvtpk_c(p[i][8 * s + 2], p[i][8 * s + 3]);
            pa[i][s].z = cvtpk_c(p[i][8 * s + 4], p[i][8 * s + 5]); pa[i][s].w = cvtpk_c(p[i][8 * s + 6], p[i][8 * s + 7]);
        }
    }
    l += __shfl_xor(l, 32);
    const float inv = 1.0f / l;
    if (hi == 0 && !dry) ((float*)(F.ws + WS_LSE))[(size_t)bh * SEQ + U + 32 * w + c] = mx + log2f(l);
    asm volatile("s_waitcnt vmcnt(0)" ::: "memory"); __builtin_amdgcn_s_barrier(); asm volatile("" ::: "memory");
    f32x16 o[4];
#pragma unroll
    for (int c4 = 0; c4 < 4; ++c4) o[c4] = (f32x16){0.f, 0.f, 0.f, 0.f, 0.f, 0.f, 0.f, 0.f, 0.f, 0.f, 0.f, 0.f, 0.f, 0.f, 0.f, 0.f};
    {   const int lv = fresh(lane), blk = (lv >> 4) & 1, q = (lv & 15) >> 2, pp = lv & 3, hv = lv >> 5;
        unsigned vx[4][2];
#pragma unroll
        for (int c4 = 0; c4 < 4; ++c4)
#pragma unroll
            for (int t = 0; t < 2; ++t)
                vx[c4][t] = 256u * (unsigned)(32 * w + 8 * t + 4 * hv + q) + 16u * ((((unsigned)(c4 ^ q)) << 2) | (((unsigned)(2 * blk + (pp >> 1))) ^ ((unsigned)(2 * t + hv)))) + 8u * (unsigned)(pp & 1);
#pragma unroll
        for (int i = 0; i < 5; ++i)
#pragma unroll
            for (int s = 0; s < 2; ++s) {
                const bf16x8 pf = __builtin_bit_cast(bf16x8, pa[i][s]);
#pragma unroll
                for (int c4 = 0; c4 < 4; ++c4) {
                    const s16x4 v0 = __builtin_bit_cast(s16x4, __builtin_amdgcn_ds_read_tr16_b64_v4i16((LAS s16x4*)(img + vx[c4][0] + 8192 * i + 4096 * s)));
                    const s16x4 v1 = __builtin_bit_cast(s16x4, __builtin_amdgcn_ds_read_tr16_b64_v4i16((LAS s16x4*)(img + vx[c4][1] + 8192 * i + 4096 * s)));
                    const bf16x8 vf = (bf16x8){v0[0], v0[1], v0[2], v0[3], v1[0], v1[1], v1[2], v1[3]};
                    o[c4] = __builtin_amdgcn_mfma_f32_32x32x16_bf16(vf, pf, o[c4], 0, 0, 0);
                }
            }
    }
    asm volatile("s_waitcnt lgkmcnt(0)" ::: "memory"); __builtin_amdgcn_s_barrier(); asm volatile("" ::: "memory");
    if (next_unit < BATCH * NH * 32) { const AttnUnit nu = attn_decode(next_unit);
        attn_dma(img, (const bf16_t*)(F.ws + WS_K) + (size_t)nu.bh * SEQ * HD, nu.U, nu.seq_lo, nu.seq_hi, w, lane); }
    {   LAS unsigned char* stg = F.lds + ATT_STG + w * 4096;
        bf16_t* orow = Qh + (size_t)(U + 32 * w) * HD;
#pragma unroll
        for (int rnd = 0; rnd < 2; ++rnd) {
            if ((c >> 4) == rnd) {
                const int rr = c & 15;
#pragma unroll
                for (int c4 = 0; c4 < 4; ++c4)
#pragma unroll
                    for (int g = 0; g < 4; ++g) {
                        u32x2 v; v.x = cvtpk_c(o[c4][4 * g + 0] * inv, o[c4][4 * g + 1] * inv); v.y = cvtpk_c(o[c4][4 * g + 2] * inv, o[c4][4 * g + 3] * inv);
                        *(LAS u32x2*)(stg + rr * 256 + (((4 * c4 + g) ^ rr) << 4) + 8 * hi) = v;
                    }
            }
            asm volatile("s_waitcnt lgkmcnt(0)" ::: "memory");
#pragma unroll
            for (int it = 0; it < 4; ++it) { const int row = it * 4 + (lane >> 4), ch = lane & 15;
                const u32x4 v = *(const LAS u32x4*)(stg + row * 256 + ((ch ^ row) << 4));
                if (!dry) *(u32x4*)(orow + (size_t)(rnd * 16 + row) * HD + ch * 8) = v; }
            asm volatile("s_waitcnt lgkmcnt(0)" ::: "memory");
        }
    }
}
__device__ __forceinline__ void attn_phase(Frame& F, bool dry) {
    int unit = F.vcu;
    if (unit < BATCH * NH * 32) { const AttnUnit au = attn_decode(unit);
        attn_dma(F.lds, (const bf16_t*)(F.ws + WS_K) + (size_t)au.bh * SEQ * HD, au.U, au.seq_lo, au.seq_hi, F.wave, F.lane); }
    for (; unit < BATCH * NH * 32; unit += F.G) attn_unit(F, unit, unit + F.G, dry);
    __syncthreads();
}

__device__ __forceinline__ void attn_mix(unsigned char* ws, int pm, int slot, int part, bool dry) {
    const bf16_t* O = (const bf16_t*)(ws + WS_Q); const float* LSE = (const float*)(ws + WS_LSE); bf16_t* SGA = (bf16_t*)(ws + WS_SGA);
    for (int it = part * 1024 + fresh(threadIdx.x); it < (part + 1) * 1024; it += 512) {
        const int row = pm * 256 + (it >> 4), ch = it & 15, b = row >> 13, p = row & 8191;
        float l[3]; u32x4 o[3];
#pragma unroll
        for (int g = 0; g < 3; ++g) { const int sh = 2 * g, hh = 4 * g + slot; const int rho = ((p & ((1 << sh) - 1)) << (13 - sh)) + (p >> sh);
            const size_t r = (size_t)(b * NH + hh) * SEQ + rho; l[g] = LSE[r]; o[g] = *(const u32x4*)(O + r * HD + 8 * ch); }
        const float mx = fmaxf(fmaxf(l[0], l[1]), l[2]);
        float w0 = exp2f(l[0] - mx), w1 = exp2f(l[1] - mx), w2 = exp2f(l[2] - mx); const float inv = 1.0f / (w0 + w1 + w2); w0 *= inv; w1 *= inv; w2 *= inv;
        bf16_t* dst = SGA + (size_t)row * 512 + slot * 128 + 8 * ch; const u32x4 sg = *(const u32x4*)dst;
        u32x4 y;
#define MIXW(f) { const float lo = (w0 * bf_lo(o[0].f) + w1 * bf_lo(o[1].f) + w2 * bf_lo(o[2].f)) * bf_lo(sg.f); const float hi = (w0 * bf_hi(o[0].f) + w1 * bf_hi(o[1].f) + w2 * bf_hi(o[2].f)) * bf_hi(sg.f); y.f = cvt_pk_bf16(lo, hi); }
        MIXW(x) MIXW(y) MIXW(z) MIXW(w)
#undef MIXW
        if (!dry) *(u32x4*)dst = y;
    }
}

__device__ __forceinline__ void lru_conv(Frame& F, int pm, int n, const float* conv_w, const float* conv_b) {
    const bf16_t* XL = (const bf16_t*)(F.ws + WS_XLRU); bf16_t* XC = (bf16_t*)(F.ws + WS_XB);
    const int tid = fresh(threadIdx.x), c0 = n * 256 + (tid & 31) * 8, r0 = pm * 256 + (tid >> 5) * 16, t0 = r0 & 8191;
    float w[4][8], b[8];
#pragma unroll
    for (int j = 0; j < 4; ++j) { const f32x4 w0 = *(const f32x4*)(conv_w + j * DM + c0), w1 = *(const f32x4*)(conv_w + j * DM + c0 + 4);
        w[j][0] = w0[0]; w[j][1] = w0[1]; w[j][2] = w0[2]; w[j][3] = w0[3]; w[j][4] = w1[0]; w[j][5] = w1[1]; w[j][6] = w1[2]; w[j][7] = w1[3]; }
    { const f32x4 b0 = *(const f32x4*)(conv_b + c0), b1 = *(const f32x4*)(conv_b + c0 + 4); b[0] = b0[0]; b[1] = b0[1]; b[2] = b0[2]; b[3] = b0[3]; b[4] = b1[0]; b[5] = b1[1]; b[6] = b1[2]; b[7] = b1[3]; }
    u32x4 xr[19];
#pragma unroll
    for (int i = 0; i < 19; ++i) { const int tt = t0 + i - 2;
        xr[i] = (tt >= 0 && tt < SEQ) ? *(const u32x4*)(XL + (size_t)(r0 + i - 2) * DM + c0) : (u32x4){0u, 0u, 0u, 0u}; }
#pragma unroll
    for (int i = 0; i < 16; ++i) {
        float a[8];
#pragma unroll
        for (int e = 0; e < 8; ++e) a[e] = b[e];
#pragma unroll
        for (int j = 0; j < 4; ++j) { const u32x4 xv = xr[i + j];
            a[0] += w[j][0] * bf_lo(xv.x); a[1] += w[j][1] * bf_hi(xv.x); a[2] += w[j][2] * bf_lo(xv.y); a[3] += w[j][3] * bf_hi(xv.y);
            a[4] += w[j][4] * bf_lo(xv.z); a[5] += w[j][5] * bf_hi(xv.z); a[6] += w[j][6] * bf_lo(xv.w); a[7] += w[j][7] * bf_hi(xv.w); }
        u32x4 o; o.x = cvt_pk_bf16(a[0], a[1]); o.y = cvt_pk_bf16(a[2], a[3]); o.z = cvt_pk_bf16(a[4], a[5]); o.w = cvt_pk_bf16(a[6], a[7]);
        *(u32x4*)(XC + (size_t)(r0 + i) * DM + c0) = o;
    }
}
#ifndef LRU_REP_P1
#define LRU_REP_P1 1
#endif
#ifndef LRU_REP_SWA
#define LRU_REP_SWA 1
#endif
#ifndef LRU_REP_FOLD
#define LRU_REP_FOLD 1
#endif
#ifndef LRU_REP_OUT
#define LRU_REP_OUT 1
#endif
#ifndef LRU_REP_MIX
#define LRU_REP_MIX 1
#endif
#ifndef LRU_REP_GEMM
#define LRU_REP_GEMM 1
#endif
#ifndef LRU_REP_CONV
#define LRU_REP_CONV 1
#endif
struct EpiNone { static constexpr bool PERM = false, AFTER_DRAIN = true;
    __device__ __forceinline__ void fused(f32x4 (&acc)[2][2][4][2], const pg8::Unit& u, int wr, int wc, int fr, int fq, LAS unsigned char* lds, int wid, int lane) const { asm volatile("" :: "v"(acc[0][0][0][0]), "v"(acc[1][1][3][1])); } };
struct EpiLru {
    static constexpr bool PERM = false, AFTER_DRAIN = true;
    const bf16_t* XC; const f32x4* LC;
    unsigned long long* TIL; unsigned* cnt; unsigned* tmo; const bf16_t* SGL; bf16_t* YL; unsigned char* ws; int n, qq; bool dry;
    __device__ __forceinline__ void fused(f32x4 (&acc)[2][2][4][2], const pg8::Unit& u, int wr, int wc, int fr, int fq, LAS unsigned char* lds, int wid, int lane) const {
        const int cu0 = 16 * wc + 4 * fq, ch0 = 256 * n + 64 * qq + cu0;
#pragma unroll 1
        for (int rp1 = 0; rp1 < LRU_REP_P1; ++rp1)
#pragma unroll
        for (int d = 0; d < 2; ++d) {
            f32x4 lc[4];
#pragma unroll
            for (int e = 0; e < 4; ++e) lc[e] = LC[d * DM + ch0 + e];
#pragma unroll
            for (int ai = 0; ai < 2; ++ai)
#pragma unroll
                for (int m = 0; m < 4; ++m) {
                    const int rl = ai * 128 + wr * 64 + m * 16 + fr, row = u.pm * 256 + rl, t = row & 8191;
                    const u32x2 xw = *(const u32x2*)(XC + (size_t)row * DM + ch0);
                    const float xc[4] = {bf_lo(xw.x), bf_hi(xw.x), bf_lo(xw.y), bf_hi(xw.y)};
                    const bool first = (d == 0) ? (t == 0) : (t == SEQ - 1);
                    u32x4 w;
#pragma unroll
                    for (int e = 0; e < 4; ++e) {
                        const float r = __builtin_amdgcn_rcpf(1.0f + __builtin_amdgcn_exp2f(acc[ai][d][m][0][e] + lc[e][0]));
                        const float ig = __builtin_amdgcn_rcpf(1.0f + __builtin_amdgcn_exp2f(acc[ai][d][m][1][e] + lc[e][1]));
                        const float a2 = __builtin_amdgcn_exp2f(r * lc[e][3]);
                        const float mult = first ? 1.0f : __builtin_amdgcn_sqrtf(1.0f - a2);
                        w[e] = cvt_pk_bf16(r * lc[e][2], mult * ig * xc[e]);
                    }
                    *(LAS u32x4*)(lds + rl * LRU_PITCH + d * 256 + cu0 * 4) = w;
                }
        }
        LDS_WAIT(); __builtin_amdgcn_s_barrier(); asm volatile("" ::: "memory");
        const int tid = wid * 64 + lane, seg = tid >> 7, dir = (tid >> 6) & 1, cu = tid & 63;
        LAS unsigned char* col = lds + dir * 256 + cu * 4;
        const int r0 = dir ? (seg * 64 + 63) : seg * 64, rstep = dir ? -LRU_PITCH : LRU_PITCH;
        float P = 1.0f, H = 0.0f;
#pragma unroll 1
        for (int rsa = 0; rsa < LRU_REP_SWA; ++rsa)
        { P = 1.0f; H = 0.0f; LAS unsigned char* pp = col + r0 * LRU_PITCH;
#pragma unroll 8
          for (int i = 0; i < 64; ++i) { const unsigned w = *(LAS unsigned*)pp; pp += rstep; const float a = __builtin_amdgcn_exp2f(bf_lo(w)); H = a * H + bf_hi(w); P *= a; } }
        LAS f32x2* xch = (LAS f32x2*)(lds + LRU_XCH);
        xch[(dir * 4 + seg) * 64 + cu] = (f32x2){P, H};
        LDS_WAIT(); __builtin_amdgcn_s_barrier(); asm volatile("" ::: "memory");
        const size_t tslot = (size_t)(n * 4 + qq) * 128 + dir * 64 + cu;
        if (seg == 0) {
            float Pt = 1.0f, Ht = 0.0f;
#pragma unroll
            for (int s = 0; s < 4; ++s) { const f32x2 v = xch[(dir * 4 + (dir ? 3 - s : s)) * 64 + cu]; Ht = v.x * Ht + v.y; Pt *= v.x; }
            __hip_atomic_store(TIL + (size_t)u.pm * 2048 + tslot, ((unsigned long long)__float_as_uint(Ht) << 32) | __float_as_uint(Pt), __ATOMIC_RELAXED, __HIP_MEMORY_SCOPE_AGENT);
        }
        asm volatile("s_waitcnt vmcnt(0)" ::: "memory"); __builtin_amdgcn_s_barrier(); asm volatile("" ::: "memory");
        if (tid == 0) __hip_atomic_fetch_add(cnt, 1u, __ATOMIC_RELAXED, __HIP_MEMORY_SCOPE_AGENT);
        for (int rmx = 1; rmx < LRU_REP_MIX; ++rmx) attn_mix(ws, u.pm, n, qq, true);
        attn_mix(ws, u.pm, n, qq, dry);
        if (wid == 0) {
            unsigned sp = 0;
            while ((unsigned)__builtin_amdgcn_readfirstlane(__hip_atomic_load(cnt, __ATOMIC_RELAXED, __HIP_MEMORY_SCOPE_AGENT)) < 32u) {
                __builtin_amdgcn_s_sleep(1);
                if ((++sp & 1023u) == 0u) { if (__hip_atomic_load(tmo, __ATOMIC_RELAXED, __HIP_MEMORY_SCOPE_AGENT) != 0u) break; if (sp > (1u << 22)) { if (lane == 0) __hip_atomic_store(tmo, 1u, __ATOMIC_RELAXED, __HIP_MEMORY_SCOPE_AGENT); break; } }
            }
            __builtin_amdgcn_fence(__ATOMIC_ACQUIRE, "agent");
            asm volatile("s_waitcnt vmcnt(0)" ::: "memory");
        }
        asm volatile("s_waitcnt vmcnt(0)" ::: "memory"); __builtin_amdgcn_s_barrier(); asm volatile("" ::: "memory");
        float h = 0.0f;
#pragma unroll 1
        for (int rfo = 0; rfo < LRU_REP_FOLD; ++rfo)
        {   h = 0.0f; const int pb = u.pm & ~31, k0 = u.pm - pb;
            unsigned long long tv[31];
#pragma unroll
            for (int k = 0; k < 31; ++k) {
                const int q = dir ? (pb + 31 - k) : (pb + k); const bool use = dir ? (q > u.pm) : (q < u.pm);
                tv[k] = use ? __hip_atomic_load(TIL + (size_t)q * 2048 + tslot, __ATOMIC_RELAXED, __HIP_MEMORY_SCOPE_AGENT) : 0x000000003f800000ull;
            }
            (void)k0;
#pragma unroll
            for (int k = 0; k < 31; ++k) h = __uint_as_float((unsigned)tv[k]) * h + __uint_as_float((unsigned)(tv[k] >> 32));
        }
        if (dir == 0) { for (int s = 0; s < seg; ++s) { const f32x2 v = xch[(0 * 4 + s) * 64 + cu]; h = v.x * h + v.y; } }
        else { for (int s = 3; s > seg; --s) { const f32x2 v = xch[(1 * 4 + s) * 64 + cu]; h = v.x * h + v.y; } }
        { LAS unsigned char* pp = col + r0 * LRU_PITCH;
#pragma unroll 8
          for (int i = 0; i < 64; ++i) { const unsigned w = *(LAS unsigned*)pp; const float a = __builtin_amdgcn_exp2f(bf_lo(w)); h = a * h + bf_hi(w); *(LAS float*)pp = h; pp += rstep; } }
        LDS_WAIT(); __builtin_amdgcn_s_barrier(); asm volatile("" ::: "memory");
        const int qd = tid & 15, rg = tid >> 4;
#pragma unroll 1
        for (int rou = 0; rou < LRU_REP_OUT; ++rou)
#pragma unroll 4
        for (int i = 0; i < 8; ++i) {
            const int rl = i * 32 + rg, row = u.pm * 256 + rl;
            const f32x4 hf = *(const LAS f32x4*)(lds + rl * LRU_PITCH + qd * 16), hb = *(const LAS f32x4*)(lds + rl * LRU_PITCH + 256 + qd * 16);
            const size_t off = (size_t)row * DM + 256 * n + 64 * qq + 4 * qd;
            const u32x2 sg = *(const u32x2*)(SGL + off);
            u32x2 y; y.x = cvt_pk_bf16((hf[0] + hb[0]) * bf_lo(sg.x), (hf[1] + hb[1]) * bf_hi(sg.x)); y.y = cvt_pk_bf16((hf[2] + hb[2]) * bf_lo(sg.y), (hf[3] + hb[3]) * bf_hi(sg.y));
            *(u32x2*)(YL + off) = y;
        }
        LDS_WAIT(); __builtin_amdgcn_s_barrier(); asm volatile("" ::: "memory");
    }
};

__device__ __forceinline__ void final_norm(Frame& F, float* out, const float* ss, const float* g, bool dry) {
    const int gw = F.vcu * 8 + F.wave, NGW = F.G * 8;
    f32x4 gv[4];
#pragma unroll
    for (int j = 0; j < 4; ++j) gv[j] = ((const f32x4*)g)[F.lane + 64 * j];
    for (int m = gw; m < M; m += NGW) {
        const float rstd = 1.0f / sqrtf(ss[m] * (1.0f / DM) + NORM_EPS);
        f32x4* xr = (f32x4*)(out + (size_t)m * DM) + F.lane;
#pragma unroll
        for (int j = 0; j < 4; ++j) { const f32x4 v = xr[64 * j]; if (!dry) xr[64 * j] = v * rstd * gv[j]; }
    }
}

constexpr int N_PHASES = 13;
__global__ void __launch_bounds__(512, 2) hybrid_fwd(Args args) {
    extern __shared__ __attribute__((aligned(16))) unsigned char lds_raw[];
    Frame F;
    F.lds = (LAS unsigned char*)lds_raw;
    F.tid = threadIdx.x; F.lane = F.tid & 63; F.wave = __builtin_amdgcn_readfirstlane(F.tid >> 6);
    F.G = gridDim.x; { const int bx = blockIdx.x; F.vcu = (F.G % 8 == 0) ? (bx % 8) * (F.G / 8) + bx / 8 : bx; }
    F.ws = args.ws; F.ctl = (unsigned*)(args.ws + WS_CTL);
    volatile LAS unsigned* MISC = (volatile LAS unsigned*)(F.lds + LDSCTL_OFF);
    if (F.tid < 64) MISC[F.tid] = 0u;
    __syncthreads();
    XcdBarrier bar; bar.bar = F.ctl + CW_BAR; bar.x = 0; bar.st = nullptr;
    if (MK_N_LAUNCHES == 1) bar = xcd_barrier_post(F.ctl + CW_BAR, MISC + 8);
    bf16_t* Wb = (bf16_t*)(F.ws + WS_W);
    float* ss = (float*)(F.ctl + CW_SS);

#ifndef PHMASK
#define PHMASK 0x3ff
#endif
#ifndef REPEAT_PH
#define REPEAT_PH -1
#endif
#ifndef REPEAT_N
#define REPEAT_N 2
#endif
    for (int ph = args.ph_lo; ph < args.ph_hi; ++ph) {
      const int reps = (ph == REPEAT_PH) ? REPEAT_N : 1;
      for (int rep = 0; rep < reps; ++rep) {
        const bool dry = (rep + 1 < reps);
        if (rep > 0) xcd_barrier(bar);
        { int tv = threadIdx.x; asm volatile("" : "+v"(tv)); F.tid = tv; F.lane = tv & 63; F.wave = __builtin_amdgcn_readfirstlane(tv >> 6); }
        if (ph == 0) { if (PHMASK & 1) p0_prologue(F, args); }
        else {
            const int l = (ph - 1) / 6; int sub = (ph - 1) % 6; if (sub >= 4) ++sub;
            const bf16_t* XB = (const bf16_t*)(F.ws + WS_XB);
            if (sub == 0 && (PHMASK & 4)) {
                pg8::Gemm g{XB, Wb + W_IN_T / 2 + (size_t)l * NIN * DM, DM, DM, DM};
                pg8::StaticOrder S; S.init(M, NCOL_A, F.G, (int)blockIdx.x, DM, DM);
                EpiProjA E{F.ws, ss + l * M, dry};
                pg8::gemm_phase(fresh(threadIdx.x), F.lds, g, S, E);
            } else if (sub == 1 && (PHMASK & 8)) {
#ifdef NAIVE_ATTN
                attn_naive(F);
#else
                attn_phase(F, dry);
#endif
            } else if (sub == 2 && (PHMASK & 16)) {
                pg8::Gemm g{XB, Wb + W_IN_T / 2 + ((size_t)l * NIN + NCOL_A) * DM, DM, DM, DM};
                pg8::StaticOrder S; S.init(M, NCOL_B, F.G, (int)blockIdx.x, DM, DM);
                EpiProjB E{F.ws, ss + l * M, args.in[3] + l * 2048};
                pg8::gemm_phase(fresh(threadIdx.x), F.lds, g, S, E);
            } else if (sub == 3 && (PHMASK & 32)) {
                for (int task = F.vcu; task < 256; task += F.G) {
                    const int pm = task >> 2, n = task & 3;
                    for (int rcv = 0; rcv < LRU_REP_CONV; ++rcv) lru_conv(F, pm, n, args.in[4] + l * 4 * DM, args.in[5] + l * DM);
                    VM_WAIT(); __syncthreads();
                    for (int qq = 0; qq < 4; ++qq) {
                        pg8::Gemm g{XB, Wb + W_RG_T / 2, DM, 256, 256};
                        pg8::SingleUnit S; S.u0.pm = pm; S.u0.pn = qq; S.u0.abyte = (pm * 256 * DM + n * 256) * 2; S.u0.bbyte = ((l * 4 + n) * 4 + qq) * 65536 * 2;
                        EpiLru E{XB, (const f32x4*)(F.ws + WS_LC) + l * 2048, (unsigned long long*)(F.ws + WS_TIL + (size_t)l * MiB),
                                 F.ctl + CW_CNT + (((l * 2 + (pm >> 5)) * 4 + n) * 4 + qq) * 64, F.ctl + CW_TMO, (const bf16_t*)(F.ws + WS_SGL), (bf16_t*)(F.ws + WS_XLRU), F.ws, n, qq, dry};
                        for (int rge = 1; rge < LRU_REP_GEMM; ++rge) { EpiNone E0; pg8::gemm_phase(fresh(threadIdx.x), F.lds, g, S, E0); }
                        pg8::gemm_phase(fresh(threadIdx.x), F.lds, g, S, E);
                    }
                }
            } else if (sub == 5 && (PHMASK & 128)) {
                { pg8::Gemm g{(const bf16_t*)(F.ws + WS_SGA), Wb + W_OATT_T / 2 + (size_t)l * DM * 512, 512, 512, 512};
                  pg8::StaticOrder S; S.init(M, DM, F.G, (int)blockIdx.x, 512, 512);
                  EpiMerge<true> E{(bf16_t*)(F.ws + WS_Q), (const bf16_t*)(F.ws + WS_GATE)};
                  pg8::gemm_phase(fresh(threadIdx.x), F.lds, g, S, E); }
                VM_WAIT(); __syncthreads();
                { pg8::Gemm g{(const bf16_t*)(F.ws + WS_XLRU), Wb + W_OLRU_T / 2 + (size_t)l * DM * DM, DM, DM, DM};
                  pg8::StaticOrder S; S.init(M, DM, F.G, (int)blockIdx.x, DM, DM);
                  EpiMerge<false> E{(bf16_t*)(F.ws + WS_Q), (const bf16_t*)(F.ws + WS_GATE) + 1024};
                  pg8::gemm_phase(fresh(threadIdx.x), F.lds, g, S, E); }
            } else if (sub == 6 && (PHMASK & 256)) {
                pg8::Gemm g{(const bf16_t*)(F.ws + WS_Q), Wb + W_OUT_T / 2 + (size_t)l * DM * DM, DM, DM, DM};
                pg8::StaticOrder S; S.init(M, DM, F.G, (int)blockIdx.x, DM, DM);
                if (l + 1 < DEPTH) { EpiResid E{l == 0 ? args.in[0] : args.out, args.out, (bf16_t*)(F.ws + WS_XB), ss + (l + 1) * M, dry}; pg8::gemm_phase(fresh(threadIdx.x), F.lds, g, S, E); }
                else { EpiResidNorm E{l == 0 ? args.in[0] : args.out, args.out, ss + (l + 1) * M, args.in[14], F.ctl + CW_PAN, F.ctl + CW_TMO}; pg8::gemm_phase(fresh(threadIdx.x), F.lds, g, S, E); }
            }
        }
      }
        if (ph + 1 < args.ph_hi) xcd_barrier(bar);
        if (REPEAT_PH == 100 && ph == 1) { xcd_barrier(bar); xcd_barrier(bar); xcd_barrier(bar); xcd_barrier(bar); xcd_barrier(bar); xcd_barrier(bar); xcd_barrier(bar); xcd_barrier(bar); }
    }
}

extern "C" void kernel_launch(void* const* d_in, const int* in_sizes, int n_in, void* d_out, int out_size, void* d_ws, size_t ws_size, hipStream_t stream) {
    static int grid = 0;
    if (grid == 0) {
        if (n_in != 15 || in_sizes[0] != M * DM || out_size != M * DM || ws_size < WS_END) { fprintf(stderr, "kernel_launch: unexpected shapes / workspace (%d inputs, ws %zu < %zu)\n", n_in, ws_size, (size_t)WS_END); grid = -1; return; }
        int dev = 0, cus = 0, per_cu = 0;
        if (hipGetDevice(&dev) != hipSuccess || hipDeviceGetAttribute(&cus, hipDeviceAttributeMultiprocessorCount, dev) != hipSuccess) { grid = -1; return; }
        if (hipFuncSetAttribute((const void*)hybrid_fwd, hipFuncAttributeMaxDynamicSharedMemorySize, LDS_BYTES) != hipSuccess) { fprintf(stderr, "kernel_launch: hipFuncSetAttribute failed\n"); grid = -1; return; }
        if (hipOccupancyMaxActiveBlocksPerMultiprocessor(&per_cu, (const void*)hybrid_fwd, 512, LDS_BYTES) != hipSuccess || per_cu < 1) { fprintf(stderr, "kernel_launch: occupancy query says %d\n", per_cu); grid = -1; return; }
        (void)hipGetLastError();
        grid = cus;
    }
    if (grid < 0) return;
    (void)hipMemsetAsync((char*)d_ws + WS_CTL, 0, CTL_ZERO_BYTES, stream);
    Args a{};
    for (int i = 0; i < 15; ++i) a.in[i] = (const float*)d_in[i];
    a.out = (float*)d_out; a.ws = (unsigned char*)d_ws;
    if (MK_N_LAUNCHES == 1) { a.ph_lo = 0; a.ph_hi = N_PHASES; a.li = 0; hipLaunchKernelGGL(hybrid_fwd, dim3(grid), dim3(512), LDS_BYTES, stream, a); }
    else for (int ph = 0; ph < N_PHASES; ++ph) { a.ph_lo = ph; a.ph_hi = ph + 1; a.li = ph; hipLaunchKernelGGL(hybrid_fwd, dim3(grid), dim3(512), LDS_BYTES, stream, a); }
}
```

```cpp
#include <hip/hip_runtime.h>
#include <cstdio>
#include <cstdint>

#ifndef MK_N_LAUNCHES
#define MK_N_LAUNCHES 1
#endif

#define LAS __attribute__((address_space(3)))
#define GAS __attribute__((address_space(1)))
typedef unsigned short bf16_t;
typedef short bf16x8 __attribute__((ext_vector_type(8)));
typedef float f32x4 __attribute__((ext_vector_type(4)));
typedef float f32x2 __attribute__((ext_vector_type(2)));
typedef unsigned u32x4 __attribute__((ext_vector_type(4)));
typedef unsigned u32x2 __attribute__((ext_vector_type(2)));

constexpr int BATCH = 2, SEQ = 8192, DM = 1024, M = BATCH * SEQ, DEPTH = 2;
constexpr int NIN = 9216, NH = 12, HD = 128;
constexpr int NCOL_A = 5120, NCOL_B = 4096;
constexpr float LOG2E = 1.4426950408889634f;
constexpr float QSCALE = 0.08838834764831845f * LOG2E;
constexpr float NORM_EPS = 1e-6f;

constexpr size_t MiB = 1u << 20;
constexpr size_t WS_CTL = 0, CTL_ZERO_BYTES = 1 * MiB;
constexpr size_t WS_LSE = 1 * MiB;
constexpr size_t WS_LC  = 4 * MiB;
constexpr size_t WS_TIL = 2 * MiB;
constexpr size_t WS_W   = 8 * MiB;
constexpr size_t W_IN_T = 0;
constexpr size_t W_OATT_T = W_IN_T + (size_t)2 * NIN * DM * 2;
constexpr size_t W_OLRU_T = W_OATT_T + (size_t)2 * DM * 512 * 2;
constexpr size_t W_OUT_T  = W_OLRU_T + (size_t)2 * DM * DM * 2;
constexpr size_t W_RG_T   = W_OUT_T + (size_t)2 * DM * DM * 2;
constexpr size_t W_END    = W_RG_T + (size_t)2 * 16 * 65536 * 2;
static_assert(W_END == 50 * MiB, "weight map");
constexpr size_t WS_XB  = 58 * MiB;
constexpr size_t WS_Q   = 90 * MiB;
constexpr size_t WS_K   = 138 * MiB;
constexpr size_t WS_V   = 186 * MiB;
constexpr size_t WS_XLRU = WS_K;
constexpr size_t WS_SGL  = WS_K + 32 * MiB;
constexpr size_t WS_GATE = WS_K + 64 * MiB;
constexpr size_t WS_SGA  = 266 * MiB;
constexpr size_t WS_END  = 282 * MiB;
static_assert(WS_V - WS_K == WS_K - WS_Q, "q/k/v spacing");
constexpr int CW_BAR = 4096;
constexpr int CW_TMO = 0;
constexpr int CW_PAN = 24576;
constexpr int CW_CNT = 16384;
constexpr int CW_XTAB = 32768;
constexpr int CW_GBAR = 33024;
constexpr int CW_SS = 65536;
static_assert((CW_SS + 3 * M) * 4 <= (int)CTL_ZERO_BYTES, "ctl");

constexpr int RING_BYTES = 131072;
constexpr int LRU_PITCH = 528;
constexpr int LRU_IMG = 256 * LRU_PITCH;
constexpr int LRU_XCH = LRU_IMG;
constexpr int LDSCTL_OFF = 147456;
constexpr int LDS_BYTES = 148480;
static_assert(LRU_XCH + 4096 + 2048 + 4096 <= LDSCTL_OFF, "lds");

#define RLX_AGENT __ATOMIC_RELAXED, __HIP_MEMORY_SCOPE_AGENT
#define LDS_WAIT() asm volatile("s_waitcnt lgkmcnt(0)" ::: "memory")
#define VM_WAIT() asm volatile("s_waitcnt vmcnt(0)" ::: "memory")

__device__ __forceinline__ unsigned cvt_pk_bf16(float lo, float hi) { unsigned r; asm volatile("v_cvt_pk_bf16_f32 %0, %1, %2" : "=v"(r) : "v"(lo), "v"(hi)); return r; }
__device__ __forceinline__ float bf_lo(unsigned w) { return __uint_as_float(w << 16); }
__device__ __forceinline__ float bf_hi(unsigned w) { return __uint_as_float(w & 0xffff0000u); }
__device__ __forceinline__ float fast_sigmoid(float v) { return __builtin_amdgcn_rcpf(1.0f + __builtin_amdgcn_exp2f(-LOG2E * v)); }
__device__ __forceinline__ float fast_silu(float v) { return v * fast_sigmoid(v); }

namespace pg8 {
constexpr int BM = 256, BK = 64, HALF = 128, HTB = HALF * BK * 2, STAGE_BYTES = 8 * HTB, NXCD = 8, WGM = 8;
__host__ __device__ __forceinline__ int lds_byte(int r, int c) { const int st = (r >> 4) * 2 + (c >> 5), rr = r & 15, cc = c & 31, ob = rr * 64 + cc * 2; return st * 1024 + (ob ^ (((ob >> 9) & 1) << 5)); }
__host__ __device__ __forceinline__ void stage_rc(int b, int& R, int& C) { const int st = b / 1024, sb = b % 1024, swz = sb ^ (((sb >> 9) & 1) << 5); R = (st >> 1) * 16 + swz / 64; C = (st & 1) * 32 + (swz % 64) / 2; }
__host__ __device__ __forceinline__ int perm32(int rho) { const int n = rho >> 4, i = rho & 15; return 8 * (i >> 2) + 4 * n + (i & 3); }

struct Unit { int pm, pn; int abyte, bbyte; };
struct Gemm { const bf16_t* A; const bf16_t* Bt; int lda, ldb, K; };

struct StaticOrder {
    int nM, nN, nwg, G, c, ta, tb;
    __device__ void init(int Mr, int N, int G_, int c_, int lda, int ldb) { nM = Mr / BM; nN = N / BM; nwg = nM * nN; G = G_; c = c_; ta = BM * lda * 2; tb = BM * ldb * 2; }
    __device__ bool next(int i, Unit& u) const {
        const int L = i * G + c; if (L >= nwg) return false;
        int wgid = L; { const int q = nwg / NXCD, r = nwg % NXCD, xcd = wgid % NXCD, off = wgid / NXCD; wgid = (xcd < r ? xcd * (q + 1) : r * (q + 1) + (xcd - r) * q) + off; }
        const int nig = WGM * nN, gid = wgid / nig, fm = gid * WGM, gsz = (nM - fm) < WGM ? (nM - fm) : WGM;
        u.pm = fm + ((wgid % nig) % gsz); u.pn = (wgid % nig) / gsz; u.abyte = u.pm * ta; u.bbyte = u.pn * tb; return true;
    }
};
struct SingleUnit {
    Unit u0;
    __device__ bool next(int i, Unit& u) const { if (i != 0) return false; u = u0; return true; }
};
struct QuadUnit {
    Unit u0; int bstep;
    __device__ bool next(int i, Unit& u) const { if (i >= 4) return false; u = u0; u.pn = i; u.bbyte = u0.bbyte + i * bstep; return true; }
};
template <class E, class = void> struct aperm_of { static constexpr bool value = false; };
template <class E> struct aperm_of<E, decltype((void)E::APERM)> { static constexpr bool value = E::APERM; };

template <class Epi, class Sched>
__device__ __forceinline__ void gemm_phase(int tid_in, LAS unsigned char* lds, const Gemm g, const Sched& S, const Epi& E) {
    int tid = tid_in; asm volatile("" : "+v"(tid));
    const int wid = __builtin_amdgcn_readfirstlane(tid >> 6), lane = tid & 63, wr = wid >> 2, wc = wid & 3, fr = lane & 15, fq = lane >> 4;
    const int K = g.K, nt = K / BK;
    unsigned voffA[2], voffB[2];
#pragma unroll
    for (int i = 0; i < 2; ++i) { int R, C; stage_rc(tid * 16 + i * 8192, R, C); const int Rb = Epi::PERM ? ((R & ~31) + perm32(R & 31)) : R;
        const int Ra = aperm_of<Epi>::value ? ((R & ~63) + 4 * (R & 15) + ((R >> 4) & 3)) : R;
        voffA[i] = (unsigned)(Ra * g.lda + C) * 2u; voffB[i] = (unsigned)(Rb * g.ldb + C) * 2u; }
    const int kstep = BK * 2;
    const int hstepA = HALF * g.lda * 2, hstepB = HALF * g.ldb * 2;
    const __amdgpu_buffer_rsrc_t rsA = __builtin_amdgcn_make_buffer_rsrc((void*)g.A, 0, 0x7ffffff0, 0x00020000);
    const __amdgpu_buffer_rsrc_t rsB = __builtin_amdgcn_make_buffer_rsrc((void*)g.Bt, 0, 0x7ffffff0, 0x00020000);
    const unsigned ldsw = (unsigned)wid * 1024u;
    const int aoff = lds_byte(wr * 64 + fr, fq * 8), boff = lds_byte(wc * 32 + fr, fq * 8);
#define PG8_SA(b, h) (((b) * 2 + (h)) * HTB)
#define PG8_SB(b, h) ((4 + (b) * 2 + (h)) * HTB)
#define PG8_STAGEA(bufoff, soff) do { _Pragma("unroll") for (int _i = 0; _i < 2; ++_i) \
        __builtin_amdgcn_raw_ptr_buffer_load_lds(rsA, (LAS void*)(lds + (bufoff) + ldsw + _i * 8192), 16, (int)voffA[_i], (soff), 0, 0); } while (0)
#define PG8_STAGEB(bufoff, soff) do { _Pragma("unroll") for (int _i = 0; _i < 2; ++_i) \
        __builtin_amdgcn_raw_ptr_buffer_load_lds(rsB, (LAS void*)(lds + (bufoff) + ldsw + _i * 8192), 16, (int)voffB[_i], (soff), 0, 0); } while (0)
#define PG8_LDA(dst, b, h) do { _Pragma("unroll") for (int m = 0; m < 4; ++m) _Pragma("unroll") for (int k = 0; k < 2; ++k) dst[m][k] = *(const LAS bf16x8*)(lds + PG8_SA(b, h) + aoff + m * 2048 + k * 1024); } while (0)
#define PG8_LDB(dst, b, h) do { _Pragma("unroll") for (int n = 0; n < 2; ++n) _Pragma("unroll") for (int k = 0; k < 2; ++k) dst[n][k] = *(const LAS bf16x8*)(lds + PG8_SB(b, h) + boff + n * 2048 + k * 1024); } while (0)
#define PG8_MMA(ai, bj, At, Bt) do { __builtin_amdgcn_s_setprio(1); _Pragma("unroll") for (int m = 0; m < 4; ++m) _Pragma("unroll") for (int n = 0; n < 2; ++n) _Pragma("unroll") for (int k = 0; k < 2; ++k) \
        acc[ai][bj][m][n] = __builtin_amdgcn_mfma_f32_16x16x32_bf16(Bt[n][k], At[m][k], acc[ai][bj][m][n], 0, 0, 0); __builtin_amdgcn_s_setprio(0); } while (0)
#define PG8_WAIT_V(n) asm volatile("s_waitcnt vmcnt(" #n ")" ::: "memory")
#define PG8_WAIT_L(n) asm volatile("s_waitcnt lgkmcnt(" #n ")" ::: "memory")
#define PG8_BAR __builtin_amdgcn_s_barrier()
#define PG8_SCHED __builtin_amdgcn_sched_barrier(0)
    Unit cur, nxt; int ui = 0;
    if (!S.next(0, cur)) return;
    f32x4 acc[2][2][4][2];
#pragma unroll
    for (int a = 0; a < 2; ++a)
#pragma unroll
        for (int b = 0; b < 2; ++b)
#pragma unroll
            for (int m = 0; m < 4; ++m)
#pragma unroll
                for (int n = 0; n < 2; ++n) acc[a][b][m][n] = (f32x4){0.f, 0.f, 0.f, 0.f};
    bf16x8 At[4][2], B0[2][2], B1[2][2];
    int cA = cur.abyte, cB = cur.bbyte;
    PG8_STAGEB(PG8_SB(0, 0), cB); PG8_STAGEB(PG8_SB(0, 1), cB + hstepB); PG8_STAGEA(PG8_SA(0, 0), cA); PG8_STAGEA(PG8_SA(0, 1), cA + hstepA);
    if (wr == 1) PG8_BAR;
    PG8_WAIT_V(2); PG8_BAR;
    PG8_STAGEB(PG8_SB(1, 0), cB + kstep); PG8_STAGEA(PG8_SA(1, 0), cA + kstep); PG8_STAGEB(PG8_SB(1, 1), cB + hstepB + kstep);
    PG8_WAIT_V(6); PG8_BAR;
    for (;;) {
        const bool has_next = S.next(ui + 1, nxt);
        const int nA = has_next ? nxt.abyte : cA, nB = has_next ? nxt.bbyte : cB;
#pragma unroll 1
        for (int t = 0; t < nt; t += 2) {
            const bool last = (t == nt - 2);
            const int a1 = cA + (t + 1) * kstep;
            const int a2 = last ? nA : cA + (t + 2) * kstep, b2 = last ? nB : cB + (t + 2) * kstep;
            const int a3 = a2 + kstep, b3 = b2 + kstep;
            PG8_LDB(B0, 0, 0); PG8_LDB(B1, 0, 1); PG8_SCHED; PG8_LDA(At, 0, 0); PG8_STAGEA(PG8_SA(1, 1), a1 + hstepA);
            PG8_WAIT_V(8); PG8_WAIT_L(0); PG8_BAR; PG8_MMA(0, 0, At, B0); PG8_MMA(0, 1, At, B1); PG8_BAR; PG8_SCHED;
            PG8_LDA(At, 0, 1); PG8_STAGEB(PG8_SB(0, 0), b2); PG8_STAGEB(PG8_SB(0, 1), b2 + hstepB); PG8_STAGEA(PG8_SA(0, 0), a2);
            PG8_WAIT_V(8); PG8_WAIT_L(0); PG8_BAR; PG8_MMA(1, 0, At, B0); PG8_MMA(1, 1, At, B1); PG8_BAR; PG8_SCHED;
            PG8_LDB(B0, 1, 0); PG8_LDB(B1, 1, 1); PG8_SCHED; PG8_LDA(At, 1, 0); PG8_STAGEA(PG8_SA(0, 1), a2 + hstepA);
            PG8_WAIT_V(8); PG8_WAIT_L(0); PG8_BAR; PG8_MMA(0, 0, At, B0); PG8_MMA(0, 1, At, B1); PG8_BAR; PG8_SCHED;
            PG8_LDA(At, 1, 1); PG8_STAGEB(PG8_SB(1, 0), b3); PG8_STAGEB(PG8_SB(1, 1), b3 + hstepB); PG8_STAGEA(PG8_SA(1, 0), a3);
            PG8_WAIT_V(8); PG8_WAIT_L(0); PG8_BAR; PG8_MMA(1, 0, At, B0); PG8_MMA(1, 1, At, B1); PG8_BAR; PG8_SCHED;
        }
        if constexpr (!Epi::AFTER_DRAIN) { if (wr == 0) PG8_BAR; int l2 = lane; asm volatile("" : "+v"(l2)); int w2 = wid; asm volatile("" : "+s"(w2)); E(acc, cur, w2 >> 2, w2 & 3, l2 & 15, l2 >> 4); }
        if (!has_next) break;
#pragma unroll
        for (int a = 0; a < 2; ++a)
#pragma unroll
            for (int b = 0; b < 2; ++b)
#pragma unroll
                for (int m = 0; m < 4; ++m)
#pragma unroll
                    for (int n = 0; n < 2; ++n) acc[a][b][m][n] = (f32x4){0.f, 0.f, 0.f, 0.f};
        cur = nxt; cA = nA; cB = nB; ++ui;
        if constexpr (!Epi::AFTER_DRAIN) { if (wr == 1) PG8_BAR; }
    }
    PG8_WAIT_V(0);
    if constexpr (Epi::AFTER_DRAIN) { if (wr == 0) PG8_BAR; }
    PG8_BAR;
    if constexpr (Epi::AFTER_DRAIN) { int l2 = lane; asm volatile("" : "+v"(l2)); int w2 = wid; asm volatile("" : "+s"(w2)); E.fused(acc, cur, w2 >> 2, w2 & 3, l2 & 15, l2 >> 4, lds, w2, l2); }
#undef PG8_SA
#undef PG8_SB
#undef PG8_STAGEA
#undef PG8_STAGEB
#undef PG8_LDA
#undef PG8_LDB
#undef PG8_MMA
#undef PG8_WAIT_V
#undef PG8_WAIT_L
#undef PG8_BAR
#undef PG8_SCHED
}

struct Gemm2 { const bf16_t* A0; const bf16_t* B0; int lda0, ldb0, K0; const bf16_t* A1; const bf16_t* B1; int lda1, ldb1, K1; };
template <class Epi, class Sched>
__device__ __forceinline__ void gemm_phase2(int tid_in, LAS unsigned char* lds, const Gemm2 g, const Sched& S, const Epi& E) {
    int tid = tid_in; asm volatile("" : "+v"(tid));
    const int wid = __builtin_amdgcn_readfirstlane(tid >> 6), lane = tid & 63, wr = wid >> 2, wc = wid & 3, fr = lane & 15, fq = lane >> 4;
    const int nt0 = g.K0 / BK, nt = (g.K0 + g.K1) / BK;
    unsigned voffA[2][2], voffB[2][2];
#pragma unroll
    for (int i = 0; i < 2; ++i) { int R, C; stage_rc(tid * 16 + i * 8192, R, C); const int Rb = Epi::PERM ? ((R & ~31) + perm32(R & 31)) : R;
        voffA[0][i] = (unsigned)(R * g.lda0 + C) * 2u; voffB[0][i] = (unsigned)(Rb * g.ldb0 + C) * 2u;
        voffA[1][i] = (unsigned)(R * g.lda1 + C) * 2u; voffB[1][i] = (unsigned)(Rb * g.ldb1 + C) * 2u; }
    const int kstep = BK * 2;
    const __amdgpu_buffer_rsrc_t rsA0 = __builtin_amdgcn_make_buffer_rsrc((void*)g.A0, 0, 0x7ffffff0, 0x00020000), rsA1 = __builtin_amdgcn_make_buffer_rsrc((void*)g.A1, 0, 0x7ffffff0, 0x00020000);
    const __amdgpu_buffer_rsrc_t rsB0 = __builtin_amdgcn_make_buffer_rsrc((void*)g.B0, 0, 0x7ffffff0, 0x00020000), rsB1 = __builtin_amdgcn_make_buffer_rsrc((void*)g.B1, 0, 0x7ffffff0, 0x00020000);
    const unsigned ldsw = (unsigned)wid * 1024u;
    const int aoff = lds_byte(wr * 64 + fr, fq * 8), boff = lds_byte(wc * 32 + fr, fq * 8);
#define PG8_SA(b, h) (((b) * 2 + (h)) * HTB)
#define PG8_SB(b, h) ((4 + (b) * 2 + (h)) * HTB)
#define PG8_STAGEA2(bufoff, T, h) do { int _T = (T); if (_T >= nt) _T -= nt; const bool _s = _T >= nt0; \
        const int _so = _s ? (pm * 256 * g.lda1 * 2 + (_T - nt0) * kstep + (h) * HALF * g.lda1 * 2) : (pm * 256 * g.lda0 * 2 + _T * kstep + (h) * HALF * g.lda0 * 2); \
        _Pragma("unroll") for (int _i = 0; _i < 2; ++_i) { if (_s) __builtin_amdgcn_raw_ptr_buffer_load_lds(rsA1, (LAS void*)(lds + (bufoff) + ldsw + _i * 8192), 16, (int)voffA[1][_i], _so, 0, 0); \
            else __builtin_amdgcn_raw_ptr_buffer_load_lds(rsA0, (LAS void*)(lds + (bufoff) + ldsw + _i * 8192), 16, (int)voffA[0][_i], _so, 0, 0); } } while (0)
#define PG8_STAGEB2(bufoff, T, h) do { int _T = (T); if (_T >= nt) _T -= nt; const bool _s = _T >= nt0; \
        const int _so = _s ? (pn * 256 * g.ldb1 * 2 + (_T - nt0) * kstep + (h) * HALF * g.ldb1 * 2) : (pn * 256 * g.ldb0 * 2 + _T * kstep + (h) * HALF * g.ldb0 * 2); \
        _Pragma("unroll") for (int _i = 0; _i < 2; ++_i) { if (_s) __builtin_amdgcn_raw_ptr_buffer_load_lds(rsB1, (LAS void*)(lds + (bufoff) + ldsw + _i * 8192), 16, (int)voffB[1][_i], _so, 0, 0); \
            else __builtin_amdgcn_raw_ptr_buffer_load_lds(rsB0, (LAS void*)(lds + (bufoff) + ldsw + _i * 8192), 16, (int)voffB[0][_i], _so, 0, 0); } } while (0)
#define PG8_LDA(dst, b, h) do { _Pragma("unroll") for (int m = 0; m < 4; ++m) _Pragma("unroll") for (int k = 0; k < 2; ++k) dst[m][k] = *(const LAS bf16x8*)(lds + PG8_SA(b, h) + aoff + m * 2048 + k * 1024); } while (0)
#define PG8_LDB(dst, b, h) do { _Pragma("unroll") for (int n = 0; n < 2; ++n) _Pragma("unroll") for (int k = 0; k < 2; ++k) dst[n][k] = *(const LAS bf16x8*)(lds + PG8_SB(b, h) + boff + n * 2048 + k * 1024); } while (0)
#define PG8_MMA(ai, bj, At, Bt) do { __builtin_amdgcn_s_setprio(1); _Pragma("unroll") for (int m = 0; m < 4; ++m) _Pragma("unroll") for (int n = 0; n < 2; ++n) _Pragma("unroll") for (int k = 0; k < 2; ++k) \
        acc[ai][bj][m][n] = __builtin_amdgcn_mfma_f32_16x16x32_bf16(Bt[n][k], At[m][k], acc[ai][bj][m][n], 0, 0, 0); __builtin_amdgcn_s_setprio(0); } while (0)
#define PG8_WAIT_V(n) asm volatile("s_waitcnt vmcnt(" #n ")" ::: "memory")
#define PG8_WAIT_L(n) asm volatile("s_waitcnt lgkmcnt(" #n ")" ::: "memory")
#define PG8_BAR __builtin_amdgcn_s_barrier()
#define PG8_SCHED __builtin_amdgcn_sched_barrier(0)
    Unit cur;
    for (int ui = 0; S.next(ui, cur); ++ui) {
        const int pm = cur.pm, pn = cur.pn;
        f32x4 acc[2][2][4][2];
#pragma unroll
        for (int a = 0; a < 2; ++a)
#pragma unroll
            for (int b = 0; b < 2; ++b)
#pragma unroll
                for (int m = 0; m < 4; ++m)
#pragma unroll
                    for (int n = 0; n < 2; ++n) acc[a][b][m][n] = (f32x4){0.f, 0.f, 0.f, 0.f};
        bf16x8 At[4][2], B0[2][2], B1[2][2];
        PG8_STAGEB2(PG8_SB(0, 0), 0, 0); PG8_STAGEB2(PG8_SB(0, 1), 0, 1); PG8_STAGEA2(PG8_SA(0, 0), 0, 0); PG8_STAGEA2(PG8_SA(0, 1), 0, 1);
        if (wr == 1) PG8_BAR;
        PG8_WAIT_V(2); PG8_BAR;
        PG8_STAGEB2(PG8_SB(1, 0), 1, 0); PG8_STAGEA2(PG8_SA(1, 0), 1, 0); PG8_STAGEB2(PG8_SB(1, 1), 1, 1);
        PG8_WAIT_V(6); PG8_BAR;
#pragma unroll 1
        for (int t = 0; t < nt; t += 2) {
            if (t == nt0) { int l2 = lane; asm volatile("" : "+v"(l2)); int w2 = wid; asm volatile("" : "+s"(w2)); E.mid(acc, cur, w2 >> 2, w2 & 3, l2 & 15, l2 >> 4); }
            PG8_LDB(B0, 0, 0); PG8_LDB(B1, 0, 1); PG8_SCHED; PG8_LDA(At, 0, 0); PG8_STAGEA2(PG8_SA(1, 1), t + 1, 1);
            PG8_WAIT_V(8); PG8_WAIT_L(0); PG8_BAR; PG8_MMA(0, 0, At, B0); PG8_MMA(0, 1, At, B1); PG8_BAR; PG8_SCHED;
            PG8_LDA(At, 0, 1); PG8_STAGEB2(PG8_SB(0, 0), t + 2, 0); PG8_STAGEB2(PG8_SB(0, 1), t + 2, 1); PG8_STAGEA2(PG8_SA(0, 0), t + 2, 0);
            PG8_WAIT_V(8); PG8_WAIT_L(0); PG8_BAR; PG8_MMA(1, 0, At, B0); PG8_MMA(1, 1, At, B1); PG8_BAR; PG8_SCHED;
            PG8_LDB(B0, 1, 0); PG8_LDB(B1, 1, 1); PG8_SCHED; PG8_LDA(At, 1, 0); PG8_STAGEA2(PG8_SA(0, 1), t + 2, 1);
            PG8_WAIT_V(8); PG8_WAIT_L(0); PG8_BAR; PG8_MMA(0, 0, At, B0); PG8_MMA(0, 1, At, B1); PG8_BAR; PG8_SCHED;
            PG8_LDA(At, 1, 1); PG8_STAGEB2(PG8_SB(1, 0), t + 3, 0); PG8_STAGEB2(PG8_SB(1, 1), t + 3, 1); PG8_STAGEA2(PG8_SA(1, 0), t + 3, 0);
            PG8_WAIT_V(8); PG8_WAIT_L(0); PG8_BAR; PG8_MMA(1, 0, At, B0); PG8_MMA(1, 1, At, B1); PG8_BAR; PG8_SCHED;
        }
        PG8_WAIT_V(0);
        if (wr == 0) PG8_BAR;
        PG8_BAR;
        { int l2 = lane; asm volatile("" : "+v"(l2)); int w2 = wid; asm volatile("" : "+s"(w2)); E(acc, cur, w2 >> 2, w2 & 3, l2 & 15, l2 >> 4); }
        PG8_WAIT_V(0); PG8_BAR;
    }
#undef PG8_SA
#undef PG8_SB
#undef PG8_STAGEA2
#undef PG8_STAGEB2
#undef PG8_LDA
#undef PG8_LDB
#undef PG8_MMA
#undef PG8_WAIT_V
#undef PG8_WAIT_L
#undef PG8_BAR
#undef PG8_SCHED
}
}

#define XB_TMO      128
#define XB_XCNT(j)  (256  + 64 * (j))
#define XB_XSUB(j)  (1280 + 64 * (j))
#define XB_XGEN(j)  (2304 + 64 * (j))
#define XB_TOP      3328
#define XB_TOPGEN   3392
#define XCD_BAR_WORDS 3456
#define XB_SPIN_CAP (1u << 18)
__device__ __forceinline__ unsigned xb_ld(unsigned* p)              { return __hip_atomic_load(p, __ATOMIC_RELAXED, __HIP_MEMORY_SCOPE_AGENT); }
__device__ __forceinline__ unsigned xb_add(unsigned* p, unsigned v) { return __hip_atomic_fetch_add(p, v, __ATOMIC_RELAXED, __HIP_MEMORY_SCOPE_AGENT); }
__device__ __forceinline__ unsigned xb_xcc_id() { return (unsigned)__builtin_amdgcn_s_getreg((3 << 11) | 20) & 0xFu; }
#define XB_SPIN(cond, bar) do { unsigned _sp = 0; while (cond) { __builtin_amdgcn_s_sleep(1); \
    if ((++_sp & 255u) == 0u) { if (xb_ld(&(bar)[XB_TMO])) break; if (_sp > XB_SPIN_CAP) { atomicAdd(&(bar)[XB_TMO], 1u); break; } } } } while (0)
struct XcdBarrier { unsigned* bar; unsigned x; volatile LAS unsigned* st; };
__device__ __forceinline__ XcdBarrier xcd_barrier_post(unsigned* bar, volatile LAS unsigned* st) {
    XcdBarrier b; b.bar = bar; b.x = xb_xcc_id(); b.st = st;
    if (threadIdx.x == 0) (void)xb_add(&bar[XB_XCNT(b.x)], 1u);
    return b;
}
__device__ __forceinline__ void xcd_barrier_complete(unsigned* bar, unsigned x, unsigned& nloc, unsigned& nx) {
    const unsigned G = gridDim.x * gridDim.y * gridDim.z;
    unsigned sum, cnt, mine, sp = 0u;
    for (;;) {
        sum = 0u; cnt = 0u; mine = 0u;
#pragma unroll
        for (unsigned j = 0; j < 16; ++j) { const unsigned c = xb_ld(&bar[XB_XCNT(j)]); sum += c; cnt += (c > 0u) ? 1u : 0u; mine = (j == x) ? c : mine; }
        if (sum == G) break;
        __builtin_amdgcn_s_sleep(1);
        if ((++sp & 255u) == 0u) { if (xb_ld(&bar[XB_TMO])) break; if (sp > XB_SPIN_CAP) { atomicAdd(&bar[XB_TMO], 1u); break; } }
    }
    nloc = mine > 0u ? mine : 1u; nx = cnt > 0u ? cnt : 1u;
}
__device__ __forceinline__ void xcd_barrier(const XcdBarrier& b) {
    asm volatile("s_waitcnt vmcnt(0)" ::: "memory");
    __syncthreads();
    if (threadIdx.x == 0) {
        unsigned* bar = b.bar;
        __builtin_amdgcn_s_waitcnt(0);
        unsigned nloc = b.st[0], nx = b.st[1];
        if (nloc == 0u) { xcd_barrier_complete(bar, b.x, nloc, nx); b.st[0] = nloc; b.st[1] = nx; }
        const unsigned old = xb_add(&bar[XB_XSUB(b.x)], 1u);
        const unsigned gen = old / nloc;
        if (old + 1u == (gen + 1u) * nloc) {
            __builtin_amdgcn_fence(__ATOMIC_RELEASE, "agent");
            asm volatile("s_waitcnt vmcnt(0)" ::: "memory");
            const unsigned og = xb_add(&bar[XB_TOP], 1u);
            const unsigned tg = og / nx;
            if (og + 1u == (tg + 1u) * nx) xb_add(&bar[XB_TOPGEN], 1u);
            else XB_SPIN(xb_ld(&bar[XB_TOPGEN]) == tg, bar);
            __builtin_amdgcn_fence(__ATOMIC_ACQUIRE, "agent");
            xb_add(&bar[XB_XGEN(b.x)], 1u);
            asm volatile("s_waitcnt vmcnt(0)" ::: "memory");
        } else {
            XB_SPIN(xb_ld(&bar[XB_XGEN(b.x)]) == gen, bar);
            __builtin_amdgcn_fence(__ATOMIC_ACQUIRE, "agent");
            asm volatile("s_waitcnt vmcnt(0)" ::: "memory");
        }
    }
    __syncthreads();
}


__device__ __forceinline__ void group_barrier(unsigned* gcnt, unsigned target, unsigned* tmo) {
    asm volatile("s_waitcnt vmcnt(0)" ::: "memory");
    __syncthreads();
    if (threadIdx.x == 0) {
        __hip_atomic_fetch_add(gcnt, 1u, __ATOMIC_RELAXED, __HIP_MEMORY_SCOPE_AGENT);
        unsigned sp = 0;
        while (__hip_atomic_load(gcnt, __ATOMIC_RELAXED, __HIP_MEMORY_SCOPE_AGENT) < target) {
            __builtin_amdgcn_s_sleep(1);
            if ((++sp & 1023u) == 0u) { if (__hip_atomic_load(tmo, __ATOMIC_RELAXED, __HIP_MEMORY_SCOPE_AGENT) != 0u) break; if (sp > (1u << 22)) { __hip_atomic_store(tmo, 1u, __ATOMIC_RELAXED, __HIP_MEMORY_SCOPE_AGENT); break; } }
        }
        __builtin_amdgcn_fence(__ATOMIC_ACQUIRE, "agent");
        asm volatile("s_waitcnt vmcnt(0)" ::: "memory");
    }
    __syncthreads();
}
struct Frame {
    LAS unsigned char* lds;
    unsigned* ctl;
    int tid, lane, wave, vcu, G;
    unsigned char* ws;
};
struct Args { const float* in[15]; float* out; unsigned char* ws; int ph_lo, ph_hi, li, pad; };

__device__ __forceinline__ int fresh(int v) { asm volatile("" : "+v"(v)); return v; }
__device__ __forceinline__ float wave_sum(float v) {
#pragma unroll
    for (int o = 1; o < 64; o <<= 1) v += __shfl_xor(v, o);
    return v;
}
__device__ __forceinline__ float wave_max(float v) {
#pragma unroll
    for (int o = 1; o < 64; o <<= 1) v = fmaxf(v, __shfl_xor(v, o));
    return v;
}

__host__ __device__ __forceinline__ int win_row(int n) { if (n < 7168) return n; const int g = (n - 7168) >> 10, c = (n - 7168) & 1023; return 7168 + 256 * (c >> 7) + 128 * g + (c & 127); }
template <class RowFn>
__device__ __forceinline__ void p0_transpose_item(const float* W, int K, int N, const float* kscale, float gscale, const RowFn& rowptr, LAS float* scr, int item, int lane) {
    const int nblk = N / 32, kb = item / nblk, nb = item % nblk, k0 = 64 * kb, n0 = 32 * nb;
    float wv[32];
#pragma unroll
    for (int i = 0; i < 32; ++i) wv[i] = __builtin_nontemporal_load(W + (size_t)(k0 + 2 * i + (lane >> 5)) * N + n0 + (lane & 31));
#pragma unroll
    for (int i = 0; i < 32; ++i) { const int kk = 2 * i + (lane >> 5); const float sc = kscale ? kscale[k0 + kk] * gscale : gscale; scr[kk * 33 + (lane & 31)] = wv[i] * sc; }
    LDS_WAIT(); asm volatile("" ::: "memory");
    const int c = lane & 7;
#pragma unroll
    for (int j = 0; j < 4; ++j) { const int n = (lane >> 3) + 8 * j; const LAS float* s = scr + (8 * c) * 33 + n;
        u32x4 o; o.x = cvt_pk_bf16(s[0 * 33], s[1 * 33]); o.y = cvt_pk_bf16(s[2 * 33], s[3 * 33]); o.z = cvt_pk_bf16(s[4 * 33], s[5 * 33]); o.w = cvt_pk_bf16(s[6 * 33], s[7 * 33]);
        *(u32x4*)(rowptr(n0 + n) + k0 + 8 * c) = o; }
    LDS_WAIT(); asm volatile("" ::: "memory");
}

template <class RowFn>
__device__ __forceinline__ void p0_mini_item(const float* W, int N, const float* kscale, float gscale, const RowFn& rowptr, int kb, int nb, int lane) {
    const int k0 = 32 * kb, n = 64 * nb + lane;
    float v[32];
#pragma unroll
    for (int j = 0; j < 32; ++j) v[j] = __builtin_nontemporal_load(W + (size_t)(k0 + j) * N + n);
#pragma unroll
    for (int j = 0; j < 32; ++j) v[j] *= kscale ? kscale[k0 + j] * gscale : gscale;
    bf16_t* dst = rowptr(n) + k0;
#pragma unroll
    for (int q = 0; q < 4; ++q) { u32x4 o; o.x = cvt_pk_bf16(v[8 * q], v[8 * q + 1]); o.y = cvt_pk_bf16(v[8 * q + 2], v[8 * q + 3]); o.z = cvt_pk_bf16(v[8 * q + 4], v[8 * q + 5]); o.w = cvt_pk_bf16(v[8 * q + 6], v[8 * q + 7]);
        *(u32x4*)(dst + 8 * q) = o; }
}
constexpr int P1_MINI = 32 * 144 + 16 * 16 + 2 * 32 * 16 + 16 * 32;
__device__ __forceinline__ void p0_layer1_mini(const float* const* in, unsigned char* ws, int idx, int lane) {
    bf16_t* Wb = (bf16_t*)(ws + WS_W);
    if (idx < 32 * 144) { bf16_t* dst = Wb + W_IN_T / 2 + (size_t)NIN * DM;
        p0_mini_item(in[2] + (size_t)DM * NIN, NIN, in[1] + DM, 1.0f, [=](int n) { return dst + (size_t)win_row(n) * DM; }, idx / 144, idx % 144, lane); return; } idx -= 32 * 144;
    if (idx < 256) { bf16_t* dst = Wb + W_OATT_T / 2 + (size_t)DM * 512;
        p0_mini_item(in[11] + (size_t)512 * DM, DM, nullptr, 1.0f, [=](int n) { return dst + (size_t)n * 512; }, idx / 16, idx % 16, lane); return; } idx -= 256;
    if (idx < 512) { bf16_t* dst = Wb + W_OLRU_T / 2 + (size_t)DM * DM;
        p0_mini_item(in[12] + (size_t)DM * DM, DM, nullptr, 1.0f, [=](int n) { return dst + (size_t)n * DM; }, idx / 16, idx % 16, lane); return; } idx -= 512;
    if (idx < 512) { bf16_t* dst = Wb + W_OUT_T / 2 + (size_t)DM * DM;
        p0_mini_item(in[13] + (size_t)DM * DM, DM, nullptr, 1.0f, [=](int n) { return dst + (size_t)n * DM; }, idx / 16, idx % 16, lane); return; } idx -= 512;
    {   const int s = idx / 32, item = idx % 32, dir = s >> 3, kind = (s >> 2) & 1, n = s & 3;
        const float* src = (kind ? in[8] : in[6]) + ((size_t)((1 * 2 + dir) * 4 + n)) * 65536;
        bf16_t* dst = Wb + W_RG_T / 2 + (size_t)(1 * 4 + n) * 4 * 65536;
        p0_mini_item(src, 256, nullptr, -LOG2E, [=](int j) { return dst + (size_t)(j >> 6) * 65536 + (size_t)(128 * dir + 32 * ((j >> 4) & 3) + 16 * kind + (j & 15)) * 256; }, item / 4, item % 4, lane);
    }
}
__device__ __forceinline__ void p0_prologue(Frame& F, const Args& a) {
    LAS float* scr = (LAS float*)(F.lds + F.wave * 16384);
    const int gw = F.vcu * 8 + F.wave, NGW = F.G * 8;
    bf16_t* Wb = (bf16_t*)(F.ws + WS_W);
    constexpr int I_IN = (DM / 64) * (NIN / 32), I_OA = (512 / 64) * (DM / 32), I_OL = (DM / 64) * (DM / 32), I_RG = (256 / 64) * (256 / 32);
    constexpr int PER_LAYER = I_IN + I_OA + 2 * I_OL + 16 * I_RG;
    const int n_items = (F.G == 256) ? PER_LAYER : DEPTH * PER_LAYER;
    for (int it = gw; it < n_items; it += NGW) {
        const int l = it / PER_LAYER; int r = it % PER_LAYER;
        if (r < I_IN) { bf16_t* dst = Wb + W_IN_T / 2 + (size_t)l * NIN * DM;
            p0_transpose_item(a.in[2] + (size_t)l * DM * NIN, DM, NIN, a.in[1] + l * DM, 1.0f, [=](int n) { return dst + (size_t)win_row(n) * DM; }, scr, r, F.lane); continue; } r -= I_IN;
        if (r < I_OA) { bf16_t* dst = Wb + W_OATT_T / 2 + (size_t)l * DM * 512;
            p0_transpose_item(a.in[11] + (size_t)l * 512 * DM, 512, DM, nullptr, 1.0f, [=](int n) { return dst + (size_t)n * 512; }, scr, r, F.lane); continue; } r -= I_OA;
        if (r < I_OL) { bf16_t* dst = Wb + W_OLRU_T / 2 + (size_t)l * DM * DM;
            p0_transpose_item(a.in[12] + (size_t)l * DM * DM, DM, DM, nullptr, 1.0f, [=](int n) { return dst + (size_t)n * DM; }, scr, r, F.lane); continue; } r -= I_OL;
        if (r < I_OL) { bf16_t* dst = Wb + W_OUT_T / 2 + (size_t)l * DM * DM;
            p0_transpose_item(a.in[13] + (size_t)l * DM * DM, DM, DM, nullptr, 1.0f, [=](int n) { return dst + (size_t)n * DM; }, scr, r, F.lane); continue; } r -= I_OL;
        {
            const int s = r / I_RG, item = r % I_RG, dir = s >> 3, kind = (s >> 2) & 1, n = s & 3;
            const float* src = (kind ? a.in[8] : a.in[6]) + ((size_t)((l * 2 + dir) * 4 + n)) * 65536;
            bf16_t* dst = Wb + W_RG_T / 2 + (size_t)(l * 4 + n) * 4 * 65536;
            p0_transpose_item(src, 256, 256, nullptr, -LOG2E, [=](int j) { return dst + (size_t)(j >> 6) * 65536 + (size_t)(128 * dir + 32 * ((j >> 4) & 3) + 16 * kind + (j & 15)) * 256; }, scr, item, F.lane);
        }
    }
    for (int i = gw * 64 + F.lane; i < DEPTH * 2 * DM; i += NGW * 64) {
        const float c2 = -8.0f * LOG2E * log1pf(expf(-a.in[10][i]));
        ((f32x4*)(F.ws + WS_LC))[i] = (f32x4){-LOG2E * a.in[7][i], -LOG2E * a.in[9][i], c2, 2.0f * c2};
    }
    const float* x = a.in[0]; bf16_t* XB = (bf16_t*)(F.ws + WS_XB);
    for (int m0 = gw * 4; m0 < M; m0 += NGW * 4) {
        f32x4 v[4][4];
#pragma unroll
        for (int r = 0; r < 4; ++r)
#pragma unroll
            for (int j = 0; j < 4; ++j) v[r][j] = __builtin_nontemporal_load((const f32x4*)(x + (size_t)(m0 + r) * DM) + F.lane + 64 * j);
#pragma unroll
        for (int r = 0; r < 4; ++r) { float s = 0.f;
#pragma unroll
            for (int j = 0; j < 4; ++j) { const f32x4 t = v[r][j]; s += (t.x * t.x + t.y * t.y) + (t.z * t.z + t.w * t.w); }
            const float rstd = __builtin_amdgcn_rsqf(wave_sum(s) * (1.0f / DM) + NORM_EPS);
            unsigned long long* o8 = (unsigned long long*)(XB + (size_t)(m0 + r) * DM) + F.lane;
#pragma unroll
            for (int j = 0; j < 4; ++j) { const f32x4 t = v[r][j] * rstd;
                o8[64 * j] = (unsigned long long)cvt_pk_bf16(t.x, t.y) | ((unsigned long long)cvt_pk_bf16(t.z, t.w) << 32); } }
    }
}

struct EpiProjA {
    static constexpr bool PERM = true, AFTER_DRAIN = false;
    unsigned char* ws; bool dry;
    __device__ __forceinline__ void operator()(const f32x4 (&acc)[2][2][4][2], const pg8::Unit& u, int wr, int wc, int fr, int fq) const {
        const int kind = u.pn / 6;
#pragma unroll
        for (int ai = 0; ai < 2; ++ai)
#pragma unroll
            for (int m = 0; m < 4; ++m) {
                const int row = u.pm * 256 + ai * 128 + wr * 64 + m * 16 + fr;
                if (kind < 3) {
                    const int b = row >> 13, p = row & 8191; const float sc = (kind == 0) ? QSCALE : 1.0f;
                    bf16_t* base = (bf16_t*)(ws + WS_Q + (size_t)kind * (WS_K - WS_Q));
#pragma unroll
                    for (int bj = 0; bj < 2; ++bj) {
                        const int hh = 2 * (u.pn - 6 * kind) + bj;
                        bf16_t* dst = base + ((size_t)(b * NH + hh) * SEQ + p) * HD + wc * 32 + 8 * fq;
                        const f32x4 v0 = acc[ai][bj][m][0] * sc, v1 = acc[ai][bj][m][1] * sc;
                        u32x4 w; w.x = cvt_pk_bf16(v0[0], v0[1]); w.y = cvt_pk_bf16(v0[2], v0[3]); w.z = cvt_pk_bf16(v1[0], v1[1]); w.w = cvt_pk_bf16(v1[2], v1[3]);
                        if (!dry) *(u32x4*)dst = w;
#if defined(DRY_SCRATCH)
                        else *(u32x4*)(ws + 234 * MiB + (size_t)blockIdx.x * 131072 + ((ai * 4 + m) * 2 + bj) * 8192 + (wr * 4 + wc) * 1024 + (fq * 16 + fr) * 16) = w;
#elif defined(DRY_FRESH)
                        else *(u32x4*)(ws + WS_Q + (size_t)(u.pm * 20 + u.pn) * 131072 + ((ai * 4 + m) * 2 + bj) * 8192 + (wr * 4 + wc) * 1024 + (fq * 16 + fr) * 16) = w;
#elif defined(DRY_REAL)
                        else *(u32x4*)dst = w;
#else
                        else asm volatile("" :: "v"(w));
#endif
                    }
                } else {
#pragma unroll
                    for (int bj = 0; bj < 2; ++bj) {
                        bf16_t* dst = (bf16_t*)(ws + WS_SGA) + (size_t)row * 512 + (u.pn - 18) * 256 + bj * 128 + wc * 32 + 8 * fq;
                        const f32x4 v0 = acc[ai][bj][m][0], v1 = acc[ai][bj][m][1];
                        u32x4 w; w.x = cvt_pk_bf16(fast_silu(v0[0]), fast_silu(v0[1])); w.y = cvt_pk_bf16(fast_silu(v0[2]), fast_silu(v0[3]));
                        w.z = cvt_pk_bf16(fast_silu(v1[0]), fast_silu(v1[1])); w.w = cvt_pk_bf16(fast_silu(v1[2]), fast_silu(v1[3]));
                        *(u32x4*)dst = w;
                    }
                }
            }
    }
};
struct EpiProjB {
    static constexpr bool PERM = true, AFTER_DRAIN = false;
    unsigned char* ws; const float* bgate;
    __device__ __forceinline__ void operator()(const f32x4 (&acc)[2][2][4][2], const pg8::Unit& u, int wr, int wc, int fr, int fq) const {
        const int kind = u.pn < 4 ? 0 : (u.pn < 8 ? 1 : 2);
        if (kind == 2) {
            const int c0 = (u.pn - 8) * 128 + wc * 32 + 8 * fq;
            f32x4 ba[2], bl[2];
#pragma unroll
            for (int n = 0; n < 2; ++n) { ba[n] = *(const f32x4*)(bgate + c0 + 4 * n); bl[n] = *(const f32x4*)(bgate + 1024 + c0 + 4 * n); }
#pragma unroll
            for (int ai = 0; ai < 2; ++ai)
#pragma unroll
                for (int m = 0; m < 4; ++m) {
                    const int row = u.pm * 256 + ai * 128 + wr * 64 + m * 16 + fr;
                    float ra[8], gl[8];
#pragma unroll
                    for (int n = 0; n < 2; ++n)
#pragma unroll
                        for (int e = 0; e < 4; ++e) { const float ga = fast_sigmoid(acc[ai][0][m][n][e] + ba[n][e]); const float g2 = fast_sigmoid(acc[ai][1][m][n][e] + bl[n][e]);
                            gl[4 * n + e] = g2; ra[4 * n + e] = ga * __builtin_amdgcn_rcpf(fmaxf(g2, 1e-30f)); }
                    bf16_t* dst = (bf16_t*)(ws + WS_GATE) + (size_t)row * 2048 + c0;
                    u32x4 w; w.x = cvt_pk_bf16(ra[0], ra[1]); w.y = cvt_pk_bf16(ra[2], ra[3]); w.z = cvt_pk_bf16(ra[4], ra[5]); w.w = cvt_pk_bf16(ra[6], ra[7]);
                    *(u32x4*)dst = w;
                    w.x = cvt_pk_bf16(gl[0], gl[1]); w.y = cvt_pk_bf16(gl[2], gl[3]); w.z = cvt_pk_bf16(gl[4], gl[5]); w.w = cvt_pk_bf16(gl[6], gl[7]);
                    *(u32x4*)(dst + 1024) = w;
                }
            return;
        }
#pragma unroll
        for (int ai = 0; ai < 2; ++ai)
#pragma unroll
            for (int m = 0; m < 4; ++m) {
                const int row = u.pm * 256 + ai * 128 + wr * 64 + m * 16 + fr;
#pragma unroll
                for (int bj = 0; bj < 2; ++bj) {
                    const int cin = bj * 128 + wc * 32 + 8 * fq;
                    f32x4 v0 = acc[ai][bj][m][0], v1 = acc[ai][bj][m][1];
                    bf16_t* dst;
                    if (kind == 0) dst = (bf16_t*)(ws + WS_XLRU) + (size_t)row * DM + u.pn * 256 + cin;
                    else { dst = (bf16_t*)(ws + WS_SGL) + (size_t)row * DM + (u.pn - 4) * 256 + cin;
#pragma unroll
                        for (int e = 0; e < 4; ++e) { v0[e] = fast_silu(v0[e]); v1[e] = fast_silu(v1[e]); } }
                    u32x4 w; w.x = cvt_pk_bf16(v0[0], v0[1]); w.y = cvt_pk_bf16(v0[2], v0[3]); w.z = cvt_pk_bf16(v1[0], v1[1]); w.w = cvt_pk_bf16(v1[2], v1[3]);
                    *(u32x4*)dst = w;
                }
            }
    }
};
struct EpiMerge2 {
    static constexpr bool PERM = true;
    bf16_t* MG; const bf16_t* GATE;
    __device__ __forceinline__ void mid(f32x4 (&acc)[2][2][4][2], const pg8::Unit& u, int wr, int wc, int fr, int fq) const {
#pragma unroll
        for (int ai = 0; ai < 2; ++ai) {
            u32x4 ra[4][2];
#pragma unroll
            for (int m = 0; m < 4; ++m)
#pragma unroll
                for (int bj = 0; bj < 2; ++bj) {
                    const int row = u.pm * 256 + ai * 128 + wr * 64 + m * 16 + fr, col = u.pn * 256 + bj * 128 + wc * 32 + 8 * fq;
                    ra[m][bj] = *(const u32x4*)(GATE + (size_t)row * 2048 + col);
                }
#pragma unroll
            for (int m = 0; m < 4; ++m)
#pragma unroll
                for (int bj = 0; bj < 2; ++bj) {
                    const u32x4 r4 = ra[m][bj];
                    f32x4& v0 = acc[ai][bj][m][0]; f32x4& v1 = acc[ai][bj][m][1];
                    v0[0] *= bf_lo(r4.x); v0[1] *= bf_hi(r4.x); v0[2] *= bf_lo(r4.y); v0[3] *= bf_hi(r4.y);
                    v1[0] *= bf_lo(r4.z); v1[1] *= bf_hi(r4.z); v1[2] *= bf_lo(r4.w); v1[3] *= bf_hi(r4.w);
                }
        }
    }
    __device__ __forceinline__ void operator()(const f32x4 (&acc)[2][2][4][2], const pg8::Unit& u, int wr, int wc, int fr, int fq) const {
#pragma unroll
        for (int ai = 0; ai < 2; ++ai) {
            u32x4 gl[4][2];
#pragma unroll
            for (int m = 0; m < 4; ++m)
#pragma unroll
                for (int bj = 0; bj < 2; ++bj) {
                    const int row = u.pm * 256 + ai * 128 + wr * 64 + m * 16 + fr, col = u.pn * 256 + bj * 128 + wc * 32 + 8 * fq;
                    gl[m][bj] = *(const u32x4*)(GATE + (size_t)row * 2048 + 1024 + col);
                }
#pragma unroll
            for (int m = 0; m < 4; ++m)
#pragma unroll
                for (int bj = 0; bj < 2; ++bj) {
                    const int row = u.pm * 256 + ai * 128 + wr * 64 + m * 16 + fr, col = u.pn * 256 + bj * 128 + wc * 32 + 8 * fq;
                    const u32x4 g4 = gl[m][bj];
                    f32x4 v0 = acc[ai][bj][m][0], v1 = acc[ai][bj][m][1];
                    v0[0] *= fmaxf(bf_lo(g4.x), 1e-30f); v0[1] *= fmaxf(bf_hi(g4.x), 1e-30f); v0[2] *= fmaxf(bf_lo(g4.y), 1e-30f); v0[3] *= fmaxf(bf_hi(g4.y), 1e-30f);
                    v1[0] *= fmaxf(bf_lo(g4.z), 1e-30f); v1[1] *= fmaxf(bf_hi(g4.z), 1e-30f); v1[2] *= fmaxf(bf_lo(g4.w), 1e-30f); v1[3] *= fmaxf(bf_hi(g4.w), 1e-30f);
                    u32x4 w; w.x = cvt_pk_bf16(v0[0], v0[1]); w.y = cvt_pk_bf16(v0[2], v0[3]); w.z = cvt_pk_bf16(v1[0], v1[1]); w.w = cvt_pk_bf16(v1[2], v1[3]);
                    *(u32x4*)(MG + (size_t)row * DM + col) = w;
                }
        }
    }
};
template <bool LAST, bool XBF> struct EpiResidNorm {
    static constexpr bool PERM = false, AFTER_DRAIN = true;
    const float* xin; float* out; bf16_t* XB; float* ssn; const float* g; unsigned* pan; unsigned* tmo;
    __device__ __forceinline__ void fused(f32x4 (&acc)[2][2][4][2], const pg8::Unit& u, int wr, int wc, int fr, int fq, LAS unsigned char* lds, int wid, int lane) const {
#pragma unroll
        for (int ai = 0; ai < 2; ++ai)
#pragma unroll
            for (int mp = 0; mp < 2; ++mp) {
                f32x4 xi[2][2][2];
#pragma unroll
                for (int mm = 0; mm < 2; ++mm)
#pragma unroll
                    for (int bj = 0; bj < 2; ++bj)
#pragma unroll
                        for (int n = 0; n < 2; ++n) {
                            const int row = u.pm * 256 + ai * 128 + wr * 64 + (mp * 2 + mm) * 16 + fr;
                            if (XBF) { const u32x2 w = *(const u32x2*)((const unsigned char*)xin + (size_t)row * (DM * 4) + u.pn * 1024 + (bj * 128 + wc * 32 + n * 16 + 4 * fq) * 2);
                                xi[mm][bj][n] = (f32x4){bf_lo(w.x), bf_hi(w.x), bf_lo(w.y), bf_hi(w.y)}; }
                            else xi[mm][bj][n] = *(const f32x4*)(xin + (size_t)row * DM + u.pn * 256 + bj * 128 + wc * 32 + n * 16 + 4 * fq);
                        }
#pragma unroll
                for (int mm = 0; mm < 2; ++mm) {
                    const int m = mp * 2 + mm, row = u.pm * 256 + ai * 128 + wr * 64 + m * 16 + fr; float s = 0.f;
#pragma unroll
                    for (int bj = 0; bj < 2; ++bj)
#pragma unroll
                        for (int n = 0; n < 2; ++n) { const f32x4 v = xi[mm][bj][n] + acc[ai][bj][m][n]; acc[ai][bj][m][n] = v; s += (v[0] * v[0] + v[1] * v[1]) + (v[2] * v[2] + v[3] * v[3]); }
                    s += __shfl_xor(s, 16); s += __shfl_xor(s, 32);
                    if (fq == 0) atomicAdd(ssn + row, s);
                }
            }
        asm volatile("s_waitcnt vmcnt(0)" ::: "memory"); __builtin_amdgcn_s_barrier(); asm volatile("" ::: "memory");
        unsigned* cnt = pan + 64 * u.pm;
        if (wid == 0 && lane == 0) __hip_atomic_fetch_add(cnt, 1u, __ATOMIC_RELAXED, __HIP_MEMORY_SCOPE_AGENT);
        if (!LAST) {
#pragma unroll
            for (int ai = 0; ai < 2; ++ai)
#pragma unroll
                for (int m = 0; m < 4; ++m) { const int row = u.pm * 256 + ai * 128 + wr * 64 + m * 16 + fr;
#pragma unroll
                    for (int bj = 0; bj < 2; ++bj)
#pragma unroll
                        for (int n = 0; n < 2; ++n) { const f32x4 v = acc[ai][bj][m][n]; u32x2 w; w.x = cvt_pk_bf16(v[0], v[1]); w.y = cvt_pk_bf16(v[2], v[3]);
                            *(u32x2*)((unsigned char*)out + (size_t)row * (DM * 4) + u.pn * 1024 + (bj * 128 + wc * 32 + n * 16 + 4 * fq) * 2) = w; } }
        }
        if (wid == 0) {
            unsigned sp = 0;
            while ((unsigned)__builtin_amdgcn_readfirstlane(__hip_atomic_load(cnt, __ATOMIC_RELAXED, __HIP_MEMORY_SCOPE_AGENT)) < 4u) {
                __builtin_amdgcn_s_sleep(1);
                if ((++sp & 1023u) == 0u) { if (__hip_atomic_load(tmo, __ATOMIC_RELAXED, __HIP_MEMORY_SCOPE_AGENT) != 0u) break; if (sp > (1u << 22)) { if (lane == 0) __hip_atomic_store(tmo, 1u, __ATOMIC_RELAXED, __HIP_MEMORY_SCOPE_AGENT); break; } }
            }
        }
        __builtin_amdgcn_s_barrier(); asm volatile("" ::: "memory");
        float rs[2][4];
#pragma unroll
        for (int ai = 0; ai < 2; ++ai)
#pragma unroll
            for (int m = 0; m < 4; ++m) rs[ai][m] = __hip_atomic_load(ssn + u.pm * 256 + ai * 128 + wr * 64 + m * 16 + fr, __ATOMIC_RELAXED, __HIP_MEMORY_SCOPE_AGENT);
        f32x4 gv[2][2];
#pragma unroll
        for (int bj = 0; bj < 2; ++bj)
#pragma unroll
            for (int n = 0; n < 2; ++n) gv[bj][n] = LAST ? *(const f32x4*)(g + u.pn * 256 + bj * 128 + wc * 32 + n * 16 + 4 * fq) : (f32x4){1.f, 1.f, 1.f, 1.f};
#pragma unroll
        for (int ai = 0; ai < 2; ++ai)
#pragma unroll
            for (int m = 0; m < 4; ++m) {
                const int row = u.pm * 256 + ai * 128 + wr * 64 + m * 16 + fr;
                const float rstd = __builtin_amdgcn_rsqf(rs[ai][m] * (1.0f / DM) + NORM_EPS);
#pragma unroll
                for (int bj = 0; bj < 2; ++bj)
#pragma unroll
                    for (int n = 0; n < 2; ++n) {
                        const size_t off = (size_t)row * DM + u.pn * 256 + bj * 128 + wc * 32 + n * 16 + 4 * fq;
                        if (LAST) *(f32x4*)(out + off) = acc[ai][bj][m][n] * rstd * gv[bj][n];
                        else { const f32x4 v = acc[ai][bj][m][n] * rstd; u32x2 w; w.x = cvt_pk_bf16(v[0], v[1]); w.y = cvt_pk_bf16(v[2], v[3]); *(u32x2*)(XB + off) = w; }
                    }
            }
    }
};

typedef float f32x16 __attribute__((ext_vector_type(16)));
typedef short s16x4 __attribute__((ext_vector_type(4)));
typedef __bf16 bf16x2_t __attribute__((ext_vector_type(2)));
__device__ __forceinline__ unsigned cvtpk_c(float lo, float hi) { f32x2 v = {lo, hi}; bf16x2_t b = __builtin_convertvector(v, bf16x2_t); return __builtin_bit_cast(unsigned, b); }
__device__ __forceinline__ int crow(int r, int hi) { return (r & 3) + 8 * (r >> 2) + 4 * hi; }
__device__ __forceinline__ void attn_dma(LAS unsigned char* img, const bf16_t* base, int U, int seq_lo, int seq_hi, int sh, int w, int lane) {
    const int rseq = seq_lo >> (13 - sh);
    const __amdgpu_buffer_rsrc_t rs = __builtin_amdgcn_make_buffer_rsrc((void*)base, 0, SEQ * 256, 0x00020000);
    const int rl0 = lane >> 4, cp = lane & 15;
#pragma unroll
    for (int i = 0; i < 12; ++i) {
        const int pc = w * 12 + i, row_local = 4 * pc + rl0;
        int grow = U - 64 + row_local; grow = grow < seq_lo ? seq_lo : grow; grow = grow > seq_hi - 1 ? seq_hi - 1 : grow;
        const int tok = ((grow - seq_lo) << sh) + rseq;
        const int voff = tok * 256 + ((cp ^ ((rl0 << 2) | (i & 3))) << 4);
        __builtin_amdgcn_raw_ptr_buffer_load_lds(rs, (LAS void*)(img + pc * 1024), 16, voff, 0, 0, 0);
    }
}
constexpr int ATT_STG = 98304;
struct AttnUnit { int bh, U, seq_lo, seq_hi, hh, sh; };
__device__ __forceinline__ AttnUnit attn_decode(int unit) {
    AttnUnit a; a.bh = unit >> 5; const int qb = unit & 31; a.hh = a.bh % NH; a.sh = 2 * (a.hh >> 2); const int ng = SEQ >> a.sh;
    a.U = qb * 256; a.seq_lo = a.U & ~(ng - 1); a.seq_hi = a.seq_lo + ng; return a;
}
__device__ __forceinline__ void attn_unit(Frame& F, int unit, int next_unit, bool dry) {
    LAS unsigned char* img = F.lds;
    const int lane = F.lane, w = F.wave, c = lane & 31, hi = lane >> 5;
    const AttnUnit au = attn_decode(unit);
    const int bh = au.bh, U = au.U, seq_lo = au.seq_lo, seq_hi = au.seq_hi;
    bf16_t* Qh = (bf16_t*)(F.ws + WS_Q) + (size_t)bh * SEQ * HD;
    const bf16_t* Vh = (const bf16_t*)(F.ws + WS_V) + (size_t)bh * SEQ * HD;
    bf16x8 qf[8];
    const int rseq = seq_lo >> (13 - au.sh);
    const int qtok = ((U + 32 * w + c - seq_lo) << au.sh) + rseq;
    { const bf16_t* qrow = Qh + (size_t)qtok * HD + 8 * hi;
#pragma unroll
      for (int s = 0; s < 8; ++s) qf[s] = *(const bf16x8*)(qrow + 16 * s); }
    const float slope2 = __builtin_amdgcn_exp2f(-8.0f * (float)(au.hh + 1) / 12.0f) * (float)(1 << au.sh) * LOG2E;
    asm volatile("s_waitcnt vmcnt(0)" ::: "memory"); __builtin_amdgcn_s_barrier(); asm volatile("" ::: "memory");
    f32x16 p[5];
    {   const int lk = fresh(lane), ck = lk & 31, hk = lk >> 5;
        const unsigned swz = ((unsigned)(ck & 3) << 2) | ((unsigned)(ck >> 2) & 3u);
        unsigned kx[8];
#pragma unroll
        for (int s = 0; s < 8; ++s) kx[s] = 256u * (unsigned)(32 * w + ck) + 16u * (((unsigned)(2 * s + hk)) ^ swz);
#pragma unroll
        for (int i = 0; i < 5; ++i) {
            f32x16 a = {0.f, 0.f, 0.f, 0.f, 0.f, 0.f, 0.f, 0.f, 0.f, 0.f, 0.f, 0.f, 0.f, 0.f, 0.f, 0.f};
#pragma unroll
            for (int s = 0; s < 8; ++s) { const bf16x8 kf = *(const LAS bf16x8*)(img + kx[s] + 8192 * i); a = __builtin_amdgcn_mfma_f32_32x32x16_bf16(kf, qf[s], a, 0, 0, 0); }
            p[i] = a;
        }
    }
    asm volatile("s_waitcnt lgkmcnt(0)" ::: "memory"); __builtin_amdgcn_s_barrier(); asm volatile("" ::: "memory");
    attn_dma(img, Vh, U, seq_lo, seq_hi, au.sh, w, lane);
    const bool lo_edge = (U == seq_lo), hi_edge = (U + 256 == seq_hi);
    const int lm = fresh(lane);
    const float dbase = (float)(4 * (lm >> 5) - (lm & 31));
    float mx = -1e30f;
#pragma unroll
    for (int i = 0; i < 5; ++i) {
        const bool tile_dead = (lo_edge && (w + i < 2)) || (hi_edge && (w + i >= 10));
#pragma unroll
        for (int r = 0; r < 16; ++r) {
            const float ad = fabsf((float)(32 * i + (r & 3) + 8 * (r >> 2) - 64) + dbase);
            float s = p[i][r] - slope2 * ad;
            if (i == 0 || i == 4) s = (ad <= 64.0f) ? s : -1e30f;
            if (tile_dead) s = -1e30f;
            p[i][r] = s; mx = fmaxf(mx, s);
        }
    }
    mx = fmaxf(mx, __shfl_xor(mx, 32));
    float l = 0.f;
    u32x4 pa[5][2];
#pragma unroll
    for (int i = 0; i < 5; ++i) {
#pragma unroll
        for (int r = 0; r < 16; ++r) { const float e = __builtin_amdgcn_exp2f(p[i][r] - mx); p[i][r] = e; l += e; }
#pragma unroll
        for (int s = 0; s < 2; ++s) {
            pa[i][s].x = cvtpk_c(p[i][8 * s + 0], p[i][8 * s + 1]); pa[i][s].y = cvtpk_c(p[i][8 * s + 2], p[i][8 * s + 3]);
            pa[i][s].z = cvtpk_c(p[i][8 * s + 4], p[i][8 * s + 5]); pa[i][s].w = cvtpk_c(p[i][8 * s + 6], p[i][8 * s + 7]);
        }
    }
    l += __shfl_xor(l, 32);
    const float inv = __builtin_amdgcn_rcpf(l);
    if (hi == 0 && !dry) ((float*)(F.ws + WS_LSE))[(size_t)bh * SEQ + qtok] = mx + __builtin_amdgcn_logf(l);
    asm volatile("s_waitcnt vmcnt(0)" ::: "memory"); __builtin_amdgcn_s_barrier(); asm volatile("" ::: "memory");
    f32x16 o[4];
#pragma unroll
    for (int c4 = 0; c4 < 4; ++c4) o[c4] = (f32x16){0.f, 0.f, 0.f, 0.f, 0.f, 0.f, 0.f, 0.f, 0.f, 0.f, 0.f, 0.f, 0.f, 0.f, 0.f, 0.f};
    {   const int lv = fresh(lane), blk = (lv >> 4) & 1, q = (lv & 15) >> 2, pp = lv & 3, hv = lv >> 5;
        unsigned vx[4][2];
#pragma unroll
        for (int c4 = 0; c4 < 4; ++c4)
#pragma unroll
            for (int t = 0; t < 2; ++t)
                vx[c4][t] = 256u * (unsigned)(32 * w + 8 * t + 4 * hv + q) + 16u * ((((unsigned)(c4 ^ q)) << 2) | (((unsigned)(2 * blk + (pp >> 1))) ^ ((unsigned)(2 * t + hv)))) + 8u * (unsigned)(pp & 1);
#pragma unroll
        for (int i = 0; i < 5; ++i)
#pragma unroll
            for (int s = 0; s < 2; ++s) {
                const bf16x8 pf = __builtin_bit_cast(bf16x8, pa[i][s]);
#pragma unroll
                for (int c4 = 0; c4 < 4; ++c4) {
                    const s16x4 v0 = __builtin_bit_cast(s16x4, __builtin_amdgcn_ds_read_tr16_b64_v4i16((LAS s16x4*)(img + vx[c4][0] + 8192 * i + 4096 * s)));
                    const s16x4 v1 = __builtin_bit_cast(s16x4, __builtin_amdgcn_ds_read_tr16_b64_v4i16((LAS s16x4*)(img + vx[c4][1] + 8192 * i + 4096 * s)));
                    const bf16x8 vf = (bf16x8){v0[0], v0[1], v0[2], v0[3], v1[0], v1[1], v1[2], v1[3]};
                    o[c4] = __builtin_amdgcn_mfma_f32_32x32x16_bf16(vf, pf, o[c4], 0, 0, 0);
                }
            }
    }
    asm volatile("s_waitcnt lgkmcnt(0)" ::: "memory"); __builtin_amdgcn_s_barrier(); asm volatile("" ::: "memory");
    if (next_unit < BATCH * NH * 32) { const AttnUnit nu = attn_decode(next_unit);
        attn_dma(img, (const bf16_t*)(F.ws + WS_K) + (size_t)nu.bh * SEQ * HD, nu.U, nu.seq_lo, nu.seq_hi, nu.sh, w, lane); }
    {   LAS unsigned char* stg = F.lds + ATT_STG + w * 4096;
        const int otok0 = ((U + 32 * w - seq_lo) << au.sh) + rseq;
#pragma unroll
        for (int rnd = 0; rnd < 2; ++rnd) {
            if ((c >> 4) == rnd) {
                const int rr = c & 15;
#pragma unroll
                for (int c4 = 0; c4 < 4; ++c4)
#pragma unroll
                    for (int g = 0; g < 4; ++g) {
                        u32x2 v; v.x = cvtpk_c(o[c4][4 * g + 0] * inv, o[c4][4 * g + 1] * inv); v.y = cvtpk_c(o[c4][4 * g + 2] * inv, o[c4][4 * g + 3] * inv);
                        *(LAS u32x2*)(stg + rr * 256 + (((4 * c4 + g) ^ rr) << 4) + 8 * hi) = v;
                    }
            }
            asm volatile("s_waitcnt lgkmcnt(0)" ::: "memory");
#pragma unroll
            for (int it = 0; it < 4; ++it) { const int row = it * 4 + (lane >> 4), ch = lane & 15;
                const u32x4 v = *(const LAS u32x4*)(stg + row * 256 + ((ch ^ row) << 4));
                if (!dry) *(u32x4*)(Qh + (size_t)(otok0 + ((rnd * 16 + row) << au.sh)) * HD + ch * 8) = v; }
            asm volatile("s_waitcnt lgkmcnt(0)" ::: "memory");
        }
    }
}
__device__ __forceinline__ void attn_phase(Frame& F, bool dry) {
    int unit = F.vcu;
    if (unit < BATCH * NH * 32) { const AttnUnit au = attn_decode(unit);
        attn_dma(F.lds, (const bf16_t*)(F.ws + WS_K) + (size_t)au.bh * SEQ * HD, au.U, au.seq_lo, au.seq_hi, au.sh, F.wave, F.lane); }
    for (; unit < BATCH * NH * 32; unit += F.G) attn_unit(F, unit, unit + F.G, dry);
    __syncthreads();
}

__device__ __forceinline__ void attn_mix(unsigned char* ws, int pm, int slot, int part, bool dry) {
    const bf16_t* O = (const bf16_t*)(ws + WS_Q); const float* LSE = (const float*)(ws + WS_LSE); bf16_t* SGA = (bf16_t*)(ws + WS_SGA);
    const int it0 = part * 1024 + fresh(threadIdx.x);
    float l[2][3]; u32x4 o[2][3], sg[2];
#pragma unroll
    for (int j = 0; j < 2; ++j) {
        const int it = it0 + 512 * j, row = pm * 256 + (it >> 4), ch = it & 15, b = row >> 13, p = row & 8191;
#pragma unroll
        for (int g = 0; g < 3; ++g) { const int hh = 4 * g + slot;
            const size_t r = (size_t)(b * NH + hh) * SEQ + p; l[j][g] = LSE[r]; o[j][g] = *(const u32x4*)(O + r * HD + 8 * ch); }
        sg[j] = *(const u32x4*)(SGA + (size_t)row * 512 + slot * 128 + 8 * ch);
    }
#pragma unroll
    for (int j = 0; j < 2; ++j) {
        const int it = it0 + 512 * j, row = pm * 256 + (it >> 4), ch = it & 15;
        const float mx = fmaxf(fmaxf(l[j][0], l[j][1]), l[j][2]);
        float w0 = __builtin_amdgcn_exp2f(l[j][0] - mx), w1 = __builtin_amdgcn_exp2f(l[j][1] - mx), w2 = __builtin_amdgcn_exp2f(l[j][2] - mx); const float inv = __builtin_amdgcn_rcpf(w0 + w1 + w2); w0 *= inv; w1 *= inv; w2 *= inv;
        u32x4 y;
#define MIXW(f) { const float lo = (w0 * bf_lo(o[j][0].f) + w1 * bf_lo(o[j][1].f) + w2 * bf_lo(o[j][2].f)) * bf_lo(sg[j].f); const float hi = (w0 * bf_hi(o[j][0].f) + w1 * bf_hi(o[j][1].f) + w2 * bf_hi(o[j][2].f)) * bf_hi(sg[j].f); y.f = cvt_pk_bf16(lo, hi); }
        MIXW(x) MIXW(y) MIXW(z) MIXW(w)
#undef MIXW
        if (!dry) *(u32x4*)(SGA + (size_t)row * 512 + slot * 128 + 8 * ch) = y;
    }
}

__device__ __forceinline__ void lru_conv(Frame& F, int pm, int n, const float* conv_w, const float* conv_b) {
    const bf16_t* XL = (const bf16_t*)(F.ws + WS_XLRU); bf16_t* XC = (bf16_t*)(F.ws + WS_XB);
    const int tid = fresh(threadIdx.x), c0 = n * 256 + (tid & 31) * 8, r0 = pm * 256 + (tid >> 5) * 16, t0 = r0 & 8191;
    float w[4][8], b[8];
#pragma unroll
    for (int j = 0; j < 4; ++j) { const f32x4 w0 = *(const f32x4*)(conv_w + j * DM + c0), w1 = *(const f32x4*)(conv_w + j * DM + c0 + 4);
        w[j][0] = w0[0]; w[j][1] = w0[1]; w[j][2] = w0[2]; w[j][3] = w0[3]; w[j][4] = w1[0]; w[j][5] = w1[1]; w[j][6] = w1[2]; w[j][7] = w1[3]; }
    { const f32x4 b0 = *(const f32x4*)(conv_b + c0), b1 = *(const f32x4*)(conv_b + c0 + 4); b[0] = b0[0]; b[1] = b0[1]; b[2] = b0[2]; b[3] = b0[3]; b[4] = b1[0]; b[5] = b1[1]; b[6] = b1[2]; b[7] = b1[3]; }
    u32x4 xr[19];
#pragma unroll
    for (int i = 0; i < 19; ++i) { const int tt = t0 + i - 2;
        xr[i] = (tt >= 0 && tt < SEQ) ? *(const u32x4*)(XL + (size_t)(r0 + i - 2) * DM + c0) : (u32x4){0u, 0u, 0u, 0u}; }
#pragma unroll
    for (int i = 0; i < 16; ++i) {
        float a[8];
#pragma unroll
        for (int e = 0; e < 8; ++e) a[e] = b[e];
#pragma unroll
        for (int j = 0; j < 4; ++j) { const u32x4 xv = xr[i + j];
            a[0] += w[j][0] * bf_lo(xv.x); a[1] += w[j][1] * bf_hi(xv.x); a[2] += w[j][2] * bf_lo(xv.y); a[3] += w[j][3] * bf_hi(xv.y);
            a[4] += w[j][4] * bf_lo(xv.z); a[5] += w[j][5] * bf_hi(xv.z); a[6] += w[j][6] * bf_lo(xv.w); a[7] += w[j][7] * bf_hi(xv.w); }
        u32x4 o; o.x = cvt_pk_bf16(a[0], a[1]); o.y = cvt_pk_bf16(a[2], a[3]); o.z = cvt_pk_bf16(a[4], a[5]); o.w = cvt_pk_bf16(a[6], a[7]);
        *(u32x4*)(XC + (size_t)(r0 + i) * DM + c0) = o;
    }
}
#ifndef LRU_REP_P1
#define LRU_REP_P1 1
#endif
#ifndef LRU_REP_SWA
#define LRU_REP_SWA 1
#endif
#ifndef LRU_REP_FOLD
#define LRU_REP_FOLD 1
#endif
#ifndef LRU_REP_OUT
#define LRU_REP_OUT 1
#endif
#ifndef LRU_REP_MIX
#define LRU_REP_MIX 1
#endif
#ifndef LRU_REP_GEMM
#define LRU_REP_GEMM 1
#endif
#ifndef LRU_REP_CONV
#define LRU_REP_CONV 1
#endif
struct EpiNone { static constexpr bool PERM = false, AFTER_DRAIN = true;
    __device__ __forceinline__ void fused(f32x4 (&acc)[2][2][4][2], const pg8::Unit& u, int wr, int wc, int fr, int fq, LAS unsigned char* lds, int wid, int lane) const { asm volatile("" :: "v"(acc[0][0][0][0]), "v"(acc[1][1][3][1])); } };
struct EpiLru {
    static constexpr bool PERM = false, AFTER_DRAIN = true;
    const bf16_t* XC; const f32x4* LC;
    unsigned long long* TIL; unsigned* cnt; unsigned* tmo; const bf16_t* SGL; bf16_t* YL; unsigned char* ws; int n, qq; bool dry; const float* const* fin;
    __device__ __forceinline__ void fused(f32x4 (&acc)[2][2][4][2], const pg8::Unit& u, int wr, int wc, int fr, int fq, LAS unsigned char* lds, int wid, int lane) const {
        const int cu0 = 16 * wc + 4 * fq, ch0 = 256 * n + 64 * qq + cu0;
        u32x2 xw8[2][4];
#pragma unroll
        for (int ai = 0; ai < 2; ++ai)
#pragma unroll
            for (int m = 0; m < 4; ++m) xw8[ai][m] = *(const u32x2*)(XC + (size_t)(u.pm * 256 + ai * 128 + wr * 64 + m * 16 + fr) * DM + ch0);
#pragma unroll 1
        for (int rp1 = 0; rp1 < LRU_REP_P1; ++rp1)
#pragma unroll
        for (int d = 0; d < 2; ++d) {
            f32x4 lc[4];
#pragma unroll
            for (int e = 0; e < 4; ++e) lc[e] = LC[d * DM + ch0 + e];
#pragma unroll
            for (int ai = 0; ai < 2; ++ai)
#pragma unroll
                for (int m = 0; m < 4; ++m) {
                    const int rl = ai * 128 + wr * 64 + m * 16 + fr, row = u.pm * 256 + rl, t = row & 8191;
                    const u32x2 xw = xw8[ai][m];
                    const float xc[4] = {bf_lo(xw.x), bf_hi(xw.x), bf_lo(xw.y), bf_hi(xw.y)};
                    const bool first = (d == 0) ? (ai == 0 && m == 0 && t == 0) : (ai == 1 && m == 3 && t == SEQ - 1);
                    u32x4 w;
#pragma unroll
                    for (int e = 0; e < 4; ++e) {
                        const float r = __builtin_amdgcn_rcpf(1.0f + __builtin_amdgcn_exp2f(acc[ai][d][m][0][e] + lc[e][0]));
                        const float ig = __builtin_amdgcn_rcpf(1.0f + __builtin_amdgcn_exp2f(acc[ai][d][m][1][e] + lc[e][1]));
                        const float av = __builtin_amdgcn_exp2f(r * lc[e][2]);
                        const float mult = first ? 1.0f : __builtin_amdgcn_sqrtf(1.0f - av * av);
                        w[e] = cvt_pk_bf16(1.0f - av, mult * ig * xc[e]);
                    }
                    *(LAS u32x4*)(lds + rl * LRU_PITCH + d * 256 + cu0 * 4) = w;
                }
        }
        LDS_WAIT(); __builtin_amdgcn_s_barrier(); asm volatile("" ::: "memory");
        const int tid = wid * 64 + lane, seg = tid >> 7, dir = (tid >> 6) & 1, cu = tid & 63;
        {   LAS unsigned char* pp = lds + dir * 256 + cu * 4 + (dir ? (seg * 64 + 63) : seg * 64) * LRU_PITCH;
            const int rstep = dir ? -LRU_PITCH : LRU_PITCH;
            float P = 1.0f, H = 0.0f;
#pragma unroll 1
            for (int rsa = 0; rsa < LRU_REP_SWA; ++rsa) { P = 1.0f; H = 0.0f; LAS unsigned char* p2 = pp;
#pragma unroll 8
              for (int i = 0; i < 64; ++i) { const unsigned w = *(LAS unsigned*)p2; const float a = 1.0f - bf_lo(w); H = a * H + bf_hi(w); P *= a;
                  if (rsa + 1 == LRU_REP_SWA) *(LAS unsigned*)p2 = cvt_pk_bf16(H, P); p2 += rstep; } }
            ((LAS f32x2*)(lds + LRU_XCH))[(dir * 4 + seg) * 64 + cu] = (f32x2){P, H};
        }
        LDS_WAIT(); __builtin_amdgcn_s_barrier(); asm volatile("" ::: "memory");
        LAS f32x2* xch = (LAS f32x2*)(lds + LRU_XCH);
        const size_t tslot = (size_t)(n * 4 + qq) * 128 + dir * 64 + cu;
        if (seg == 0) {
            float Pt = 1.0f, Ht = 0.0f;
#pragma unroll
            for (int s = 0; s < 4; ++s) { const f32x2 v = xch[(dir * 4 + (dir ? 3 - s : s)) * 64 + cu]; Ht = v.x * Ht + v.y; Pt *= v.x; }
            __hip_atomic_store(TIL + (size_t)u.pm * 2048 + tslot, ((unsigned long long)__float_as_uint(Ht) << 32) | __float_as_uint(Pt), __ATOMIC_RELAXED, __HIP_MEMORY_SCOPE_AGENT);
        }
        if (seg == 0) { asm volatile("s_waitcnt vmcnt(0)" ::: "memory");
            if (lane == 0) __hip_atomic_fetch_add(cnt, 1u, __ATOMIC_RELAXED, __HIP_MEMORY_SCOPE_AGENT); }
        if (fin) {
            const int uidx = (u.pm * 4 + n) * 4 + qq;
            int item = -1;
            if (wid >= 2) item = uidx * 6 + (wid - 2); else if (wid == 0 && uidx < P1_MINI - 6144) item = 6144 + uidx;
            if (item >= 0) p0_layer1_mini(fin, ws, item, lane);
        }
        for (int rmx = 1; rmx < LRU_REP_MIX; ++rmx) attn_mix(ws, u.pm, n, qq, true);
        attn_mix(ws, u.pm, n, qq, dry);
        if (seg == 0) {
            unsigned sp = 0;
            while ((unsigned)__builtin_amdgcn_readfirstlane(__hip_atomic_load(cnt, __ATOMIC_RELAXED, __HIP_MEMORY_SCOPE_AGENT)) < 64u) {
                __builtin_amdgcn_s_sleep(1);
                if ((++sp & 1023u) == 0u) { if (__hip_atomic_load(tmo, __ATOMIC_RELAXED, __HIP_MEMORY_SCOPE_AGENT) != 0u) break; if (sp > (1u << 22)) { if (lane == 0) __hip_atomic_store(tmo, 1u, __ATOMIC_RELAXED, __HIP_MEMORY_SCOPE_AGENT); break; } }
            }
            asm volatile("" ::: "memory");
            float h = 0.0f;
#pragma unroll 1
            for (int rfo = 0; rfo < LRU_REP_FOLD; ++rfo)
            {   h = 0.0f; const int pb = u.pm & ~31;
                unsigned long long tv[31];
#pragma unroll
                for (int k = 0; k < 31; ++k) {
                    const int q = dir ? (pb + 31 - k) : (pb + k); const bool use = dir ? (q > u.pm) : (q < u.pm);
                    tv[k] = use ? __hip_atomic_load(TIL + (size_t)q * 2048 + tslot, __ATOMIC_RELAXED, __HIP_MEMORY_SCOPE_AGENT) : 0x000000003f800000ull;
                }
#pragma unroll
                for (int k = 0; k < 31; ++k) h = __uint_as_float((unsigned)tv[k]) * h + __uint_as_float((unsigned)(tv[k] >> 32));
            }
            LAS float* hin = (LAS float*)(lds + LRU_XCH + 4096);
#pragma unroll
            for (int s = 0; s < 4; ++s) { const int sg2 = dir ? 3 - s : s; hin[(dir * 4 + sg2) * 64 + cu] = h; const f32x2 v = xch[(dir * 4 + sg2) * 64 + cu]; h = v.x * h + v.y; }
        }
        LDS_WAIT(); __builtin_amdgcn_s_barrier(); asm volatile("" ::: "memory");
        const int qd = tid & 15, rg = tid >> 4;
#pragma unroll 1
        for (int rou = 0; rou < LRU_REP_OUT; ++rou)
#pragma unroll 4
        for (int i = 0; i < 8; ++i) {
            const int rl = i * 32 + rg, row = u.pm * 256 + rl, sgm = rl >> 6;
            const u32x4 wf = *(const LAS u32x4*)(lds + rl * LRU_PITCH + qd * 16), wb = *(const LAS u32x4*)(lds + rl * LRU_PITCH + 256 + qd * 16);
            const f32x4 cf = *(const LAS f32x4*)(lds + LRU_XCH + 4096 + ((0 * 4 + sgm) * 64 + 4 * qd) * 4), cb = *(const LAS f32x4*)(lds + LRU_XCH + 4096 + ((1 * 4 + sgm) * 64 + 4 * qd) * 4);
            const size_t off = (size_t)row * DM + 256 * n + 64 * qq + 4 * qd;
            const u32x2 sg = *(const u32x2*)(SGL + off);
            float hh[4];
#pragma unroll
            for (int e = 0; e < 4; ++e) hh[e] = (bf_lo(wf[e]) + bf_hi(wf[e]) * cf[e]) + (bf_lo(wb[e]) + bf_hi(wb[e]) * cb[e]);
            u32x2 y; y.x = cvt_pk_bf16(hh[0] * bf_lo(sg.x), hh[1] * bf_hi(sg.x)); y.y = cvt_pk_bf16(hh[2] * bf_lo(sg.y), hh[3] * bf_hi(sg.y));
            if (!dry) *(u32x2*)(YL + off) = y;
        }
        LDS_WAIT(); __builtin_amdgcn_s_barrier(); asm volatile("" ::: "memory");
    }
};


template <int CTRL> __device__ __forceinline__ float dpp_zero(float v) { return __int_as_float(__builtin_amdgcn_update_dpp(0, __float_as_int(v), CTRL, 0xf, 0xf, true)); }
#define LRU_SCAN_STEP(SH) { const float bs_ = dpp_zero<SH>(Bt), am_ = dpp_zero<SH>(At - 1.0f); Bt = __builtin_fmaf(At, bs_, Bt); At = __builtin_fmaf(At, am_, At); }
struct EpiLruReg {
    static constexpr bool PERM = false, AFTER_DRAIN = false, APERM = true;
    LAS unsigned char* lds; const bf16_t* XC; const f32x4* LC;
    unsigned long long* TIL; unsigned* cnt0; unsigned* tmo; const bf16_t* SGL; bf16_t* YL; unsigned char* ws; int n; const float* const* fin;
    __device__ __forceinline__ void operator()(f32x4 (&acc)[2][2][4][2], const pg8::Unit& u, int wr, int wc, int fr, int fq) const {
        const int qq = u.pn, wid = wr * 4 + wc, lane = fq * 16 + fr;
        const int cu0 = 16 * wc + 4 * fq, ch0 = 256 * n + 64 * qq + cu0;
        unsigned* cnt = cnt0 + qq * 64;
        const size_t off0 = (size_t)(u.pm * 256 + wr * 64 + 4 * fr) * DM + ch0;
        u32x2 xw8[2][4], sg8[2][4];
#pragma unroll
        for (int ai = 0; ai < 2; ++ai)
#pragma unroll
            for (int m = 0; m < 4; ++m) xw8[ai][m] = *(const u32x2*)(XC + off0 + (size_t)(ai * 128 + m) * DM);
        LAS f32x2* xch = (LAS f32x2*)(lds + LRU_XCH);
        LAS f32x2* xtot = xch; const int dummy = 768 + wid * 64 + lane;
#pragma unroll
        for (int d = 0; d < 2; ++d) {
            asm volatile("" ::: "memory");
            f32x4 lc[4];
#pragma unroll
            for (int e = 0; e < 4; ++e) lc[e] = LC[d * DM + ch0 + e];
#pragma unroll
            for (int ai = 0; ai < 2; ++ai) {
#pragma unroll
                for (int m = 0; m < 4; ++m) {
                    const int t = (u.pm * 256 + ai * 128 + wr * 64 + 4 * fr + m) & 8191;
                    const bool first = (d == 0) ? (ai == 0 && m == 0 && t == 0) : (ai == 1 && m == 3 && t == SEQ - 1);
                    u32x2 xw = xw8[ai][m]; asm volatile("" : "+v"(xw.x), "+v"(xw.y));
                    const float xc[4] = {bf_lo(xw.x), bf_hi(xw.x), bf_lo(xw.y), bf_hi(xw.y)};
#pragma unroll
                    for (int e = 0; e < 4; ++e) {
                        const float r = __builtin_amdgcn_rcpf(1.0f + __builtin_amdgcn_exp2f(acc[ai][d][m][0][e] + lc[e][0]));
                        const float ig = __builtin_amdgcn_rcpf(1.0f + __builtin_amdgcn_exp2f(acc[ai][d][m][1][e] + lc[e][1]));
                        const float av = __builtin_amdgcn_exp2f(r * lc[e][2]);
                        const float mult = first ? 1.0f : __builtin_amdgcn_sqrtf(1.0f - av * av);
                        acc[ai][d][m][0][e] = av; acc[ai][d][m][1][e] = mult * ig * xc[e];
                    }
                }
#pragma unroll
                for (int e = 0; e < 4; ++e) {
                    if (d == 0) {
#pragma unroll
                        for (int m = 1; m < 4; ++m) { acc[ai][d][m][1][e] = __builtin_fmaf(acc[ai][d][m][0][e], acc[ai][d][m - 1][1][e], acc[ai][d][m][1][e]); acc[ai][d][m][0][e] *= acc[ai][d][m - 1][0][e]; }
                    } else {
#pragma unroll
                        for (int m = 2; m >= 0; --m) { acc[ai][d][m][1][e] = __builtin_fmaf(acc[ai][d][m][0][e], acc[ai][d][m + 1][1][e], acc[ai][d][m][1][e]); acc[ai][d][m][0][e] *= acc[ai][d][m + 1][0][e]; }
                    }
                    float At = acc[ai][d][d ? 0 : 3][0][e], Bt = acc[ai][d][d ? 0 : 3][1][e];
                    float Ae, Be;
                    if (d == 0) { LRU_SCAN_STEP(0x111) LRU_SCAN_STEP(0x112) LRU_SCAN_STEP(0x114) LRU_SCAN_STEP(0x118) Be = dpp_zero<0x111>(Bt); Ae = 1.0f + dpp_zero<0x111>(At - 1.0f); }
                    else        { LRU_SCAN_STEP(0x101) LRU_SCAN_STEP(0x102) LRU_SCAN_STEP(0x104) LRU_SCAN_STEP(0x108) Be = dpp_zero<0x101>(Bt); Ae = 1.0f + dpp_zero<0x101>(At - 1.0f); }
#pragma unroll
                    for (int m = 0; m < 4; ++m) { acc[ai][d][m][1][e] = __builtin_fmaf(acc[ai][d][m][0][e], Be, acc[ai][d][m][1][e]); acc[ai][d][m][0][e] *= Ae; }
                    xtot[(fr == (d ? 0 : 15)) ? ((d * 4 + 2 * ai + wr) * 64 + cu0 + e) : dummy] = (f32x2){At, Bt};
                }
                __builtin_amdgcn_sched_barrier(0);
            }
        }
#pragma unroll
        for (int ai = 0; ai < 2; ++ai)
#pragma unroll
            for (int m = 0; m < 4; ++m)
#pragma unroll
                for (int e = 0; e < 4; ++e) {
                    float S = acc[ai][0][m][1][e] + acc[ai][1][m][1][e]; unsigned pk = cvt_pk_bf16(acc[ai][0][m][0][e], acc[ai][1][m][0][e]);
                    asm volatile("" : "+v"(S), "+v"(pk));
                    acc[ai][0][m][0][e] = S; acc[ai][0][m][1][e] = __uint_as_float(pk);
                }
        LDS_WAIT(); __builtin_amdgcn_s_barrier(); asm volatile("" ::: "memory");
        const int tid = wid * 64 + lane, seg = tid >> 7, dir = (tid >> 6) & 1, cu = tid & 63;
        const size_t tslot = (size_t)(n * 4 + qq) * 128 + dir * 64 + cu;
        if (seg == 0) {
            float Pt = 1.0f, Ht = 0.0f;
#pragma unroll
            for (int s = 0; s < 4; ++s) { const f32x2 v = xch[(dir * 4 + (dir ? 3 - s : s)) * 64 + cu]; Ht = v.x * Ht + v.y; Pt *= v.x; }
            __hip_atomic_store(TIL + (size_t)u.pm * 2048 + tslot, ((unsigned long long)__float_as_uint(Ht) << 32) | __float_as_uint(Pt), __ATOMIC_RELAXED, __HIP_MEMORY_SCOPE_AGENT);
        }
        if (seg == 0) { asm volatile("s_waitcnt vmcnt(0)" ::: "memory");
            if (lane == 0) __hip_atomic_fetch_add(cnt, 1u, __ATOMIC_RELAXED, __HIP_MEMORY_SCOPE_AGENT); }
        if (fin) {
            const int uidx = (u.pm * 4 + n) * 4 + qq;
            int item = -1;
            if (wid >= 2) item = uidx * 6 + (wid - 2); else if (wid == 0 && uidx < P1_MINI - 6144) item = 6144 + uidx;
            if (item >= 0) p0_layer1_mini(fin, ws, item, lane);
        }
        attn_mix(ws, u.pm, n, qq, false);
#pragma unroll
        for (int ai = 0; ai < 2; ++ai)
#pragma unroll
            for (int m = 0; m < 4; ++m) sg8[ai][m] = *(const u32x2*)(SGL + off0 + (size_t)(ai * 128 + m) * DM);
        if (seg == 0) {
            unsigned sp = 0;
            while ((unsigned)__builtin_amdgcn_readfirstlane(__hip_atomic_load(cnt, __ATOMIC_RELAXED, __HIP_MEMORY_SCOPE_AGENT)) < 64u) {
                __builtin_amdgcn_s_sleep(1);
                if ((++sp & 1023u) == 0u) { if (__hip_atomic_load(tmo, __ATOMIC_RELAXED, __HIP_MEMORY_SCOPE_AGENT) != 0u) break; if (sp > (1u << 22)) { if (lane == 0) __hip_atomic_store(tmo, 1u, __ATOMIC_RELAXED, __HIP_MEMORY_SCOPE_AGENT); break; } }
            }
            asm volatile("" ::: "memory");
            float h = 0.0f;
            {   const int pb = u.pm & ~31;
#pragma unroll
                for (int hb = 0; hb < 2; ++hb) {
                    unsigned long long tv[16];
#pragma unroll
                    for (int k = 0; k < 16; ++k) {
                        const int kk = hb * 16 + k, q = dir ? (pb + 31 - kk) : (pb + kk); const bool use = (kk < 31) && (dir ? (q > u.pm) : (q < u.pm));
                        tv[k] = use ? __hip_atomic_load(TIL + (size_t)q * 2048 + tslot, __ATOMIC_RELAXED, __HIP_MEMORY_SCOPE_AGENT) : 0x000000003f800000ull;
                    }
#pragma unroll
                    for (int k = 0; k < 16; ++k) h = __uint_as_float((unsigned)tv[k]) * h + __uint_as_float((unsigned)(tv[k] >> 32));
                    asm volatile("" ::: "memory");
                }
            }
            LAS float* hin = (LAS float*)(lds + LRU_XCH + 4096);
#pragma unroll
            for (int s = 0; s < 4; ++s) { const int sg2 = dir ? 3 - s : s; hin[(dir * 4 + sg2) * 64 + cu] = h; const f32x2 v = xch[(dir * 4 + sg2) * 64 + cu]; h = v.x * h + v.y; }
        }
        LDS_WAIT(); __builtin_amdgcn_s_barrier(); asm volatile("" ::: "memory");
#pragma unroll
        for (int ai = 0; ai < 2; ++ai) {
            const f32x4 cf = *(const LAS f32x4*)(lds + LRU_XCH + 4096 + ((0 * 4 + 2 * ai + wr) * 64 + cu0) * 4), cb = *(const LAS f32x4*)(lds + LRU_XCH + 4096 + ((1 * 4 + 2 * ai + wr) * 64 + cu0) * 4);
#pragma unroll
            for (int m = 0; m < 4; ++m) {
                float hh[4];
#pragma unroll
                for (int e = 0; e < 4; ++e) { const unsigned pk = __float_as_uint(acc[ai][0][m][1][e]); hh[e] = __builtin_fmaf(bf_hi(pk), cb[e], __builtin_fmaf(bf_lo(pk), cf[e], acc[ai][0][m][0][e])); }
                const u32x2 sg = sg8[ai][m];
                u32x2 y; y.x = cvt_pk_bf16(hh[0] * bf_lo(sg.x), hh[1] * bf_hi(sg.x)); y.y = cvt_pk_bf16(hh[2] * bf_lo(sg.y), hh[3] * bf_hi(sg.y));
                *(u32x2*)(YL + off0 + (size_t)(ai * 128 + m) * DM) = y;
            }
        }
    }
};

__device__ __forceinline__ void final_norm(Frame& F, float* out, const float* ss, const float* g, bool dry) {
    const int gw = F.vcu * 8 + F.wave, NGW = F.G * 8;
    f32x4 gv[4];
#pragma unroll
    for (int j = 0; j < 4; ++j) gv[j] = ((const f32x4*)g)[F.lane + 64 * j];
    for (int m = gw; m < M; m += NGW) {
        const float rstd = __builtin_amdgcn_rsqf(ss[m] * (1.0f / DM) + NORM_EPS);
        f32x4* xr = (f32x4*)(out + (size_t)m * DM) + F.lane;
#pragma unroll
        for (int j = 0; j < 4; ++j) { const f32x4 v = xr[64 * j]; if (!dry) xr[64 * j] = v * rstd * gv[j]; }
    }
}

constexpr int N_PHASES = 13;
__global__ void __launch_bounds__(512, 2) hybrid_fwd(Args args) {
    extern __shared__ __attribute__((aligned(16))) unsigned char lds_raw[];
    Frame F;
    F.lds = (LAS unsigned char*)lds_raw;
    F.tid = threadIdx.x; F.lane = F.tid & 63; F.wave = __builtin_amdgcn_readfirstlane(F.tid >> 6);
    F.G = gridDim.x; { const int bx = blockIdx.x; F.vcu = (F.G % 8 == 0) ? (bx % 8) * (F.G / 8) + bx / 8 : bx; }
    F.ws = args.ws; F.ctl = (unsigned*)(args.ws + WS_CTL);
    volatile LAS unsigned* MISC = (volatile LAS unsigned*)(F.lds + LDSCTL_OFF);
    if (F.tid < 64) MISC[F.tid] = 0u;
    __syncthreads();
    XcdBarrier bar; bar.bar = F.ctl + CW_BAR; bar.x = 0; bar.st = nullptr;
    if (MK_N_LAUNCHES == 1) bar = xcd_barrier_post(F.ctl + CW_BAR, MISC + 8);
    if (F.tid == 0) __hip_atomic_store(F.ctl + CW_XTAB + F.vcu, xb_xcc_id() + 1u, __ATOMIC_RELAXED, __HIP_MEMORY_SCOPE_AGENT);
    bf16_t* Wb = (bf16_t*)(F.ws + WS_W);
    float* ss = (float*)(F.ctl + CW_SS);

#ifndef PHMASK
#define PHMASK 0x3ff
#endif
#ifndef REPEAT_PH
#define REPEAT_PH -1
#endif
#ifndef REPEAT_N
#define REPEAT_N 2
#endif
#ifdef TS_PROBE
    volatile LAS unsigned long long* TS = (volatile LAS unsigned long long*)(F.lds + LDSCTL_OFF + 256);
    int nts = 0;
#define TSTAMP() do { if (blockIdx.x == 0 && threadIdx.x == 0) TS[nts] = __builtin_amdgcn_s_memrealtime(); ++nts; } while (0)
    TSTAMP();
#else
#define TSTAMP() do {} while (0)
#endif
    for (int ph = args.ph_lo; ph < args.ph_hi; ++ph) {
#if REPEAT_PH >= 0
      const int reps = (ph == REPEAT_PH) ? REPEAT_N : 1;
      for (int rep = 0; rep < reps; ++rep) {
        const bool dry = (rep + 1 < reps);
        if (rep > 0) xcd_barrier(bar);
#else
      {
        constexpr bool dry = false;
#endif
        { int tv = threadIdx.x; asm volatile("" : "+v"(tv)); F.tid = tv; F.lane = tv & 63; F.wave = __builtin_amdgcn_readfirstlane(tv >> 6); }
        if (ph == 0) { if (PHMASK & 1) p0_prologue(F, args); }
        else {
            const int l = (ph - 1) / 6; int sub = (ph - 1) % 6; if (sub >= 4) ++sub;
            const bf16_t* XB = (const bf16_t*)(F.ws + WS_XB);
            if (sub == 0 && (PHMASK & 4)) {
                pg8::Gemm g{XB, Wb + W_IN_T / 2 + (size_t)l * NIN * DM, DM, DM, DM};
                pg8::StaticOrder S; S.init(M, NCOL_A, F.G, (int)blockIdx.x, DM, DM);
#ifdef STAGGER_TICKS
                if ((blockIdx.x >> 3) & 1) { const unsigned long long t0 = __builtin_amdgcn_s_memrealtime(); while (__builtin_amdgcn_s_memrealtime() - t0 < STAGGER_TICKS) __builtin_amdgcn_s_sleep(8); }
#endif
                EpiProjA E{F.ws, dry};
                pg8::gemm_phase(fresh(threadIdx.x), F.lds, g, S, E);
            } else if (sub == 1 && (PHMASK & 8)) {
                attn_phase(F, dry);
            } else if (sub == 2 && (PHMASK & 16)) {
                pg8::Gemm g{XB, Wb + W_IN_T / 2 + ((size_t)l * NIN + NCOL_A) * DM, DM, DM, DM};
                pg8::StaticOrder S; S.init(M, NCOL_B, F.G, (int)blockIdx.x, DM, DM);
#ifdef STAGGER_TICKS
                if ((blockIdx.x >> 3) & 1) { const unsigned long long t0 = __builtin_amdgcn_s_memrealtime(); while (__builtin_amdgcn_s_memrealtime() - t0 < STAGGER_TICKS) __builtin_amdgcn_s_sleep(8); }
#endif
                EpiProjB E{F.ws, args.in[3] + l * 2048};
                pg8::gemm_phase(fresh(threadIdx.x), F.lds, g, S, E);
            } else if (sub == 3 && (PHMASK & 32)) {
                for (int task = F.vcu; task < 256; task += F.G) {
                    const int pm = task >> 2, n = task & 3;
                    for (int rcv = 0; rcv < LRU_REP_CONV; ++rcv) lru_conv(F, pm, n, args.in[4] + l * 4 * DM, args.in[5] + l * DM);
                    VM_WAIT(); __syncthreads();
                    {   pg8::Gemm g{XB, Wb + W_RG_T / 2, DM, 256, 256};
                        pg8::QuadUnit S; S.u0.pm = pm; S.u0.pn = 0; S.u0.abyte = (pm * 256 * DM + n * 256) * 2; S.u0.bbyte = ((l * 4 + n) * 4) * 65536 * 2; S.bstep = 65536 * 2;
                        EpiLruReg E{F.lds, XB, (const f32x4*)(F.ws + WS_LC) + l * 2048, (unsigned long long*)(F.ws + WS_TIL + (size_t)l * MiB),
                                    F.ctl + CW_CNT + (((l * 2 + (pm >> 5)) * 4 + n) * 4) * 64, F.ctl + CW_TMO, (const bf16_t*)(F.ws + WS_SGL), (bf16_t*)(F.ws + WS_XLRU), F.ws, n, (l == 0 && F.G == 256) ? args.in : nullptr};
                        pg8::gemm_phase(fresh(threadIdx.x), F.lds, g, S, E);
                    }
                }
            } else if (sub == 5 && (PHMASK & 128)) {
                pg8::Gemm2 g{(const bf16_t*)(F.ws + WS_SGA), Wb + W_OATT_T / 2 + (size_t)l * DM * 512, 512, 512, 512,
                             (const bf16_t*)(F.ws + WS_XLRU), Wb + W_OLRU_T / 2 + (size_t)l * DM * DM, DM, DM, DM};
                pg8::StaticOrder S; S.init(M, DM, F.G, (int)blockIdx.x, DM, DM);
                EpiMerge2 E{(bf16_t*)(F.ws + WS_SGL), (const bf16_t*)(F.ws + WS_GATE)};
                pg8::gemm_phase2(fresh(threadIdx.x), F.lds, g, S, E);
            } else if (sub == 6 && (PHMASK & 256)) {
                pg8::Gemm g{(const bf16_t*)(F.ws + WS_SGL), Wb + W_OUT_T / 2 + (size_t)l * DM * DM, DM, DM, DM};
                pg8::StaticOrder S; S.init(M, DM, F.G, (int)blockIdx.x, DM, DM);
                if (l + 1 < DEPTH) { EpiResidNorm<false, false> E{l == 0 ? args.in[0] : args.out, args.out, (bf16_t*)(F.ws + WS_XB), ss + (l + 1) * M, args.in[14], F.ctl + CW_PAN + l * 4096, F.ctl + CW_TMO}; pg8::gemm_phase(fresh(threadIdx.x), F.lds, g, S, E); }
                else { EpiResidNorm<true, true> E{l == 0 ? args.in[0] : args.out, args.out, (bf16_t*)(F.ws + WS_XB), ss + (l + 1) * M, args.in[14], F.ctl + CW_PAN + l * 4096, F.ctl + CW_TMO}; pg8::gemm_phase(fresh(threadIdx.x), F.lds, g, S, E); }
            }
        }
      }
        TSTAMP();
        if (ph + 1 < args.ph_hi) {
            const int subp = (ph == 0) ? -1 : (ph - 1) % 6;
            const bool fast_seams = MISC[10] != 0u;
            if (fast_seams && (subp == 3 || subp == 4)) { const unsigned gen = MISC[11] + 1u; __syncthreads(); if (F.tid == 0) MISC[11] = gen; group_barrier(F.ctl + CW_GBAR + (F.vcu >> 5) * 64, 32u * gen, F.ctl + CW_TMO); }
            else xcd_barrier(bar);
            if (ph == 0 && F.G == 256) {
#ifndef NO_FAST_SEAMS
                const int t = F.tid & 255;
                const unsigned mine = __hip_atomic_load(F.ctl + CW_XTAB + t, __ATOMIC_RELAXED, __HIP_MEMORY_SCOPE_AGENT), ref = __hip_atomic_load(F.ctl + CW_XTAB + (t & ~31), __ATOMIC_RELAXED, __HIP_MEMORY_SCOPE_AGENT);
                if ((mine != ref) || (mine == 0u)) MISC[12] = 1u;
                __syncthreads();
                if (F.tid == 0) MISC[10] = (MISC[12] == 0u) ? 1u : 0u;
                __syncthreads();
#endif
            }
        }
        TSTAMP();
        if (REPEAT_PH == 100 && ph == 1) { xcd_barrier(bar); xcd_barrier(bar); xcd_barrier(bar); xcd_barrier(bar); xcd_barrier(bar); xcd_barrier(bar); xcd_barrier(bar); xcd_barrier(bar); }
    }
#ifdef TS_PROBE
    if (blockIdx.x == 0 && threadIdx.x == 0) {
        const unsigned long long dt = TS[TS_PROBE + 1] - TS[TS_PROBE], t0 = __builtin_amdgcn_s_memrealtime();
        while (__builtin_amdgcn_s_memrealtime() - t0 < 16ull * dt) __builtin_amdgcn_s_sleep(4);
    }
#endif
}

extern "C" void kernel_launch(void* const* d_in, const int* in_sizes, int n_in, void* d_out, int out_size, void* d_ws, size_t ws_size, hipStream_t stream) {
    static int grid = 0;
    if (grid == 0) {
        if (n_in != 15 || in_sizes[0] != M * DM || out_size != M * DM || ws_size < WS_END) { fprintf(stderr, "kernel_launch: unexpected shapes / workspace (%d inputs, ws %zu < %zu)\n", n_in, ws_size, (size_t)WS_END); grid = -1; return; }
        int dev = 0, cus = 0, per_cu = 0;
        if (hipGetDevice(&dev) != hipSuccess || hipDeviceGetAttribute(&cus, hipDeviceAttributeMultiprocessorCount, dev) != hipSuccess) { grid = -1; return; }
        if (hipFuncSetAttribute((const void*)hybrid_fwd, hipFuncAttributeMaxDynamicSharedMemorySize, LDS_BYTES) != hipSuccess) { fprintf(stderr, "kernel_launch: hipFuncSetAttribute failed\n"); grid = -1; return; }
        if (hipOccupancyMaxActiveBlocksPerMultiprocessor(&per_cu, (const void*)hybrid_fwd, 512, LDS_BYTES) != hipSuccess || per_cu < 1) { fprintf(stderr, "kernel_launch: occupancy query says %d\n", per_cu); grid = -1; return; }
        (void)hipGetLastError();
        grid = cus;
    }
    if (grid < 0) return;
    (void)hipMemsetAsync((char*)d_ws + WS_CTL, 0, CTL_ZERO_BYTES, stream);
    Args a{};
    for (int i = 0; i < 15; ++i) a.in[i] = (const float*)d_in[i];
    a.out = (float*)d_out; a.ws = (unsigned char*)d_ws;
    if (MK_N_LAUNCHES == 1) { a.ph_lo = 0; a.ph_hi = N_PHASES; a.li = 0; hipLaunchKernelGGL(hybrid_fwd, dim3(grid), dim3(512), LDS_BYTES, stream, a); }
    else for (int ph = 0; ph < N_PHASES; ++ph) { a.ph_lo = ph; a.ph_hi = ph + 1; a.li = ph; hipLaunchKernelGGL(hybrid_fwd, dim3(grid), dim3(512), LDS_BYTES, stream, a); }
}
```

```cpp
#include <hip/hip_runtime.h>
#include <cstdio>
#include <cstdint>

#ifndef MK_N_LAUNCHES
#define MK_N_LAUNCHES 1
#endif

#define LAS __attribute__((address_space(3)))
#define GAS __attribute__((address_space(1)))
typedef unsigned short bf16_t;
typedef short bf16x8 __attribute__((ext_vector_type(8)));
typedef float f32x4 __attribute__((ext_vector_type(4)));
typedef float f32x3 __attribute__((ext_vector_type(3)));
typedef float f32x2 __attribute__((ext_vector_type(2)));
typedef unsigned u32x4 __attribute__((ext_vector_type(4)));
typedef unsigned u32x2 __attribute__((ext_vector_type(2)));

constexpr int BATCH = 2, SEQ = 8192, DM = 1024, M = BATCH * SEQ, DEPTH = 2;
constexpr int NIN = 9216, NH = 12, HD = 128;
constexpr int NCOL_A = 5120, NCOL_B = 4096;
constexpr float LOG2E = 1.4426950408889634f;
constexpr float QSCALE = 0.08838834764831845f * LOG2E;
constexpr float NORM_EPS = 1e-6f;

constexpr size_t MiB = 1u << 20;
constexpr size_t WS_CTL = 0, CTL_ZERO_BYTES = 1 * MiB;
constexpr size_t WS_LSE = 1 * MiB;
constexpr size_t WS_LC  = 4 * MiB;
constexpr size_t WS_TIL = 2 * MiB;
constexpr size_t WS_W   = 8 * MiB;
constexpr size_t W_IN_T = 0;
constexpr size_t W_OATT_T = W_IN_T + (size_t)2 * NIN * DM * 2;
constexpr size_t W_OLRU_T = W_OATT_T + (size_t)2 * DM * 512 * 2;
constexpr size_t W_OUT_T  = W_OLRU_T + (size_t)2 * DM * DM * 2;
constexpr size_t W_RG_T   = W_OUT_T + (size_t)2 * DM * DM * 2;
constexpr size_t W_END    = W_RG_T + (size_t)2 * 16 * 65536 * 2;
static_assert(W_END == 50 * MiB, "weight map");
constexpr size_t WS_XB  = 58 * MiB;
constexpr size_t WS_Q   = 90 * MiB;
constexpr size_t WS_K   = 138 * MiB;
constexpr size_t WS_V   = 186 * MiB;
constexpr size_t WS_XLRU = WS_K;
constexpr size_t WS_SGL  = WS_K + 32 * MiB;
constexpr size_t WS_GATE = WS_K + 64 * MiB;
constexpr size_t WS_SGA  = 266 * MiB;
constexpr size_t WS_END  = 282 * MiB;
static_assert(WS_V - WS_K == WS_K - WS_Q, "q/k/v spacing");
constexpr int CW_BAR = 4096;
constexpr int CW_TMO = 0;
constexpr int CW_PAN = 24576;
constexpr int CW_CNT = 16384;
constexpr int CW_XTAB = 32768;
constexpr int CW_GBAR = 33024;
constexpr int CW_SS = 65536;
static_assert((CW_SS + 3 * M) * 4 <= (int)CTL_ZERO_BYTES, "ctl");

constexpr int RING_BYTES = 131072;
constexpr int LRU_PITCH = 528;
constexpr int LRU_IMG = 256 * LRU_PITCH;
constexpr int LRU_XCH = LRU_IMG;
constexpr int LDSCTL_OFF = 147456;
constexpr int LDS_BYTES = 148480;
static_assert(LRU_XCH + 4096 + 2048 + 4096 <= LDSCTL_OFF, "lds");

#define RLX_AGENT __ATOMIC_RELAXED, __HIP_MEMORY_SCOPE_AGENT
#define LDS_WAIT() asm volatile("s_waitcnt lgkmcnt(0)" ::: "memory")
#define VM_WAIT() asm volatile("s_waitcnt vmcnt(0)" ::: "memory")

__device__ __forceinline__ unsigned cvt_pk_bf16(float lo, float hi) { unsigned r; asm volatile("v_cvt_pk_bf16_f32 %0, %1, %2" : "=v"(r) : "v"(lo), "v"(hi)); return r; }
__device__ __forceinline__ float bf_lo(unsigned w) { return __uint_as_float(w << 16); }
__device__ __forceinline__ float bf_hi(unsigned w) { return __uint_as_float(w & 0xffff0000u); }
__device__ __forceinline__ float fast_sigmoid(float v) { return __builtin_amdgcn_rcpf(1.0f + __builtin_amdgcn_exp2f(-LOG2E * v)); }
__device__ __forceinline__ float fast_silu(float v) { return v * fast_sigmoid(v); }

namespace pg8 {
constexpr int BM = 256, BK = 64, HALF = 128, HTB = HALF * BK * 2, STAGE_BYTES = 8 * HTB, NXCD = 8, WGM = 8;
__host__ __device__ __forceinline__ int lds_byte(int r, int c) { const int st = (r >> 4) * 2 + (c >> 5), rr = r & 15, cc = c & 31, ob = rr * 64 + cc * 2; return st * 1024 + (ob ^ (((ob >> 9) & 1) << 5)); }
__host__ __device__ __forceinline__ void stage_rc(int b, int& R, int& C) { const int st = b / 1024, sb = b % 1024, swz = sb ^ (((sb >> 9) & 1) << 5); R = (st >> 1) * 16 + swz / 64; C = (st & 1) * 32 + (swz % 64) / 2; }
__host__ __device__ __forceinline__ int perm32(int rho) { const int n = rho >> 4, i = rho & 15; return 8 * (i >> 2) + 4 * n + (i & 3); }

struct Unit { int pm, pn; int abyte, bbyte; };
struct Gemm { const bf16_t* A; const bf16_t* Bt; int lda, ldb, K; };

struct StaticOrder {
    int nM, nN, nwg, G, c, ta, tb;
    __device__ void init(int Mr, int N, int G_, int c_, int lda, int ldb) { nM = Mr / BM; nN = N / BM; nwg = nM * nN; G = G_; c = c_; ta = BM * lda * 2; tb = BM * ldb * 2; }
    __device__ bool next(int i, Unit& u) const {
        const int L = i * G + c; if (L >= nwg) return false;
        int wgid = L; { const int q = nwg / NXCD, r = nwg % NXCD, xcd = wgid % NXCD, off = wgid / NXCD; wgid = (xcd < r ? xcd * (q + 1) : r * (q + 1) + (xcd - r) * q) + off; }
        const int nig = WGM * nN, gid = wgid / nig, fm = gid * WGM, gsz = (nM - fm) < WGM ? (nM - fm) : WGM;
        u.pm = fm + ((wgid % nig) % gsz); u.pn = (wgid % nig) / gsz; u.abyte = u.pm * ta; u.bbyte = u.pn * tb; return true;
    }
};
struct SingleUnit {
    Unit u0;
    __device__ bool next(int i, Unit& u) const { if (i != 0) return false; u = u0; return true; }
};
struct QuadUnit {
    Unit u0; int bstep;
    __device__ bool next(int i, Unit& u) const { if (i >= 4) return false; u = u0; u.pn = i; u.bbyte = u0.bbyte + i * bstep; return true; }
};
template <class E, class = void> struct aperm_of { static constexpr bool value = false; };
template <class E> struct aperm_of<E, decltype((void)E::APERM)> { static constexpr bool value = E::APERM; };

template <class Epi, class Sched>
__device__ __forceinline__ void gemm_phase(int tid_in, LAS unsigned char* lds, const Gemm g, const Sched& S, const Epi& E) {
    int tid = tid_in; asm volatile("" : "+v"(tid));
    const int wid = __builtin_amdgcn_readfirstlane(tid >> 6), lane = tid & 63, wr = wid >> 2, wc = wid & 3, fr = lane & 15, fq = lane >> 4;
    const int K = g.K, nt = K / BK;
    unsigned voffA[2], voffB[2];
#pragma unroll
    for (int i = 0; i < 2; ++i) { int R, C; stage_rc(tid * 16 + i * 8192, R, C); const int Rb = Epi::PERM ? ((R & ~31) + perm32(R & 31)) : R;
        const int Ra = aperm_of<Epi>::value ? ((R & ~63) + 4 * (R & 15) + ((R >> 4) & 3)) : R;
        voffA[i] = (unsigned)(Ra * g.lda + C) * 2u; voffB[i] = (unsigned)(Rb * g.ldb + C) * 2u; }
    const int kstep = BK * 2;
    const int hstepA = HALF * g.lda * 2, hstepB = HALF * g.ldb * 2;
    const __amdgpu_buffer_rsrc_t rsA = __builtin_amdgcn_make_buffer_rsrc((void*)g.A, 0, 0x7ffffff0, 0x00020000);
    const __amdgpu_buffer_rsrc_t rsB = __builtin_amdgcn_make_buffer_rsrc((void*)g.Bt, 0, 0x7ffffff0, 0x00020000);
    const unsigned ldsw = (unsigned)wid * 1024u;
    const int aoff = lds_byte(wr * 64 + fr, fq * 8), boff = lds_byte(wc * 32 + fr, fq * 8);
#define PG8_SA(b, h) (((b) * 2 + (h)) * HTB)
#define PG8_SB(b, h) ((4 + (b) * 2 + (h)) * HTB)
#define PG8_STAGEA(bufoff, soff) do { _Pragma("unroll") for (int _i = 0; _i < 2; ++_i) \
        __builtin_amdgcn_raw_ptr_buffer_load_lds(rsA, (LAS void*)(lds + (bufoff) + ldsw + _i * 8192), 16, (int)voffA[_i], (soff), 0, 0); } while (0)
#define PG8_STAGEB(bufoff, soff) do { _Pragma("unroll") for (int _i = 0; _i < 2; ++_i) \
        __builtin_amdgcn_raw_ptr_buffer_load_lds(rsB, (LAS void*)(lds + (bufoff) + ldsw + _i * 8192), 16, (int)voffB[_i], (soff), 0, 0); } while (0)
#define PG8_LDA(dst, b, h) do { _Pragma("unroll") for (int m = 0; m < 4; ++m) _Pragma("unroll") for (int k = 0; k < 2; ++k) dst[m][k] = *(const LAS bf16x8*)(lds + PG8_SA(b, h) + aoff + m * 2048 + k * 1024); } while (0)
#define PG8_LDB(dst, b, h) do { _Pragma("unroll") for (int n = 0; n < 2; ++n) _Pragma("unroll") for (int k = 0; k < 2; ++k) dst[n][k] = *(const LAS bf16x8*)(lds + PG8_SB(b, h) + boff + n * 2048 + k * 1024); } while (0)
#define PG8_MMA(ai, bj, At, Bt) do { __builtin_amdgcn_s_setprio(1); _Pragma("unroll") for (int m = 0; m < 4; ++m) _Pragma("unroll") for (int n = 0; n < 2; ++n) _Pragma("unroll") for (int k = 0; k < 2; ++k) \
        acc[ai][bj][m][n] = __builtin_amdgcn_mfma_f32_16x16x32_bf16(Bt[n][k], At[m][k], acc[ai][bj][m][n], 0, 0, 0); __builtin_amdgcn_s_setprio(0); } while (0)
#define PG8_WAIT_V(n) asm volatile("s_waitcnt vmcnt(" #n ")" ::: "memory")
#define PG8_WAIT_L(n) asm volatile("s_waitcnt lgkmcnt(" #n ")" ::: "memory")
#define PG8_BAR __builtin_amdgcn_s_barrier()
#define PG8_SCHED __builtin_amdgcn_sched_barrier(0)
    Unit cur, nxt; int ui = 0;
    if (!S.next(0, cur)) return;
    f32x4 acc[2][2][4][2];
#pragma unroll
    for (int a = 0; a < 2; ++a)
#pragma unroll
        for (int b = 0; b < 2; ++b)
#pragma unroll
            for (int m = 0; m < 4; ++m)
#pragma unroll
                for (int n = 0; n < 2; ++n) acc[a][b][m][n] = (f32x4){0.f, 0.f, 0.f, 0.f};
    bf16x8 At[4][2], B0[2][2], B1[2][2];
    int cA = cur.abyte, cB = cur.bbyte;
    PG8_STAGEB(PG8_SB(0, 0), cB); PG8_STAGEB(PG8_SB(0, 1), cB + hstepB); PG8_STAGEA(PG8_SA(0, 0), cA); PG8_STAGEA(PG8_SA(0, 1), cA + hstepA);
    if (wr == 1) PG8_BAR;
    PG8_WAIT_V(2); PG8_BAR;
    PG8_STAGEB(PG8_SB(1, 0), cB + kstep); PG8_STAGEA(PG8_SA(1, 0), cA + kstep); PG8_STAGEB(PG8_SB(1, 1), cB + hstepB + kstep);
    PG8_WAIT_V(6); PG8_BAR;
    for (;;) {
        const bool has_next = S.next(ui + 1, nxt);
        const int nA = has_next ? nxt.abyte : cA, nB = has_next ? nxt.bbyte : cB;
#pragma unroll 1
        for (int t = 0; t < nt; t += 2) {
            const bool last = (t == nt - 2);
            const int a1 = cA + (t + 1) * kstep;
            const int a2 = last ? nA : cA + (t + 2) * kstep, b2 = last ? nB : cB + (t + 2) * kstep;
            const int a3 = a2 + kstep, b3 = b2 + kstep;
            PG8_LDB(B0, 0, 0); PG8_LDB(B1, 0, 1); PG8_SCHED; PG8_LDA(At, 0, 0); PG8_STAGEA(PG8_SA(1, 1), a1 + hstepA);
            PG8_WAIT_V(8); PG8_WAIT_L(0); PG8_BAR; PG8_MMA(0, 0, At, B0); PG8_MMA(0, 1, At, B1); PG8_BAR; PG8_SCHED;
            PG8_LDA(At, 0, 1); PG8_STAGEB(PG8_SB(0, 0), b2); PG8_STAGEB(PG8_SB(0, 1), b2 + hstepB); PG8_STAGEA(PG8_SA(0, 0), a2);
            PG8_WAIT_V(8); PG8_WAIT_L(0); PG8_BAR; PG8_MMA(1, 0, At, B0); PG8_MMA(1, 1, At, B1); PG8_BAR; PG8_SCHED;
            PG8_LDB(B0, 1, 0); PG8_LDB(B1, 1, 1); PG8_SCHED; PG8_LDA(At, 1, 0); PG8_STAGEA(PG8_SA(0, 1), a2 + hstepA);
            PG8_WAIT_V(8); PG8_WAIT_L(0); PG8_BAR; PG8_MMA(0, 0, At, B0); PG8_MMA(0, 1, At, B1); PG8_BAR; PG8_SCHED;
            PG8_LDA(At, 1, 1); PG8_STAGEB(PG8_SB(1, 0), b3); PG8_STAGEB(PG8_SB(1, 1), b3 + hstepB); PG8_STAGEA(PG8_SA(1, 0), a3);
            PG8_WAIT_V(8); PG8_WAIT_L(0); PG8_BAR; PG8_MMA(1, 0, At, B0); PG8_MMA(1, 1, At, B1); PG8_BAR; PG8_SCHED;
        }
        if constexpr (!Epi::AFTER_DRAIN) { if (wr == 0) PG8_BAR; int l2 = lane; asm volatile("" : "+v"(l2)); int w2 = wid; asm volatile("" : "+s"(w2)); E(acc, cur, w2 >> 2, w2 & 3, l2 & 15, l2 >> 4); }
        if (!has_next) break;
#pragma unroll
        for (int a = 0; a < 2; ++a)
#pragma unroll
            for (int b = 0; b < 2; ++b)
#pragma unroll
                for (int m = 0; m < 4; ++m)
#pragma unroll
                    for (int n = 0; n < 2; ++n) acc[a][b][m][n] = (f32x4){0.f, 0.f, 0.f, 0.f};
        cur = nxt; cA = nA; cB = nB; ++ui;
        if constexpr (!Epi::AFTER_DRAIN) { if (wr == 1) PG8_BAR; }
    }
    PG8_WAIT_V(0);
    if constexpr (Epi::AFTER_DRAIN) { if (wr == 0) PG8_BAR; }
    PG8_BAR;
    if constexpr (Epi::AFTER_DRAIN) { int l2 = lane; asm volatile("" : "+v"(l2)); int w2 = wid; asm volatile("" : "+s"(w2)); E.fused(acc, cur, w2 >> 2, w2 & 3, l2 & 15, l2 >> 4, lds, w2, l2); }
#undef PG8_SA
#undef PG8_SB
#undef PG8_STAGEA
#undef PG8_STAGEB
#undef PG8_LDA
#undef PG8_LDB
#undef PG8_MMA
#undef PG8_WAIT_V
#undef PG8_WAIT_L
#undef PG8_BAR
#undef PG8_SCHED
}

struct Gemm2 { const bf16_t* A0; const bf16_t* B0; int lda0, ldb0, K0; const bf16_t* A1; const bf16_t* B1; int lda1, ldb1, K1; };
template <class Epi, class Sched>
__device__ __forceinline__ void gemm_phase2(int tid_in, LAS unsigned char* lds, const Gemm2 g, const Sched& S, const Epi& E) {
    int tid = tid_in; asm volatile("" : "+v"(tid));
    const int wid = __builtin_amdgcn_readfirstlane(tid >> 6), lane = tid & 63, wr = wid >> 2, wc = wid & 3, fr = lane & 15, fq = lane >> 4;
    const int nt0 = g.K0 / BK, nt = (g.K0 + g.K1) / BK;
    unsigned voffA[2][2], voffB[2][2];
#pragma unroll
    for (int i = 0; i < 2; ++i) { int R, C; stage_rc(tid * 16 + i * 8192, R, C); const int Rb = Epi::PERM ? ((R & ~31) + perm32(R & 31)) : R;
        voffA[0][i] = (unsigned)(R * g.lda0 + C) * 2u; voffB[0][i] = (unsigned)(Rb * g.ldb0 + C) * 2u;
        voffA[1][i] = (unsigned)(R * g.lda1 + C) * 2u; voffB[1][i] = (unsigned)(Rb * g.ldb1 + C) * 2u; }
    const int kstep = BK * 2;
    const __amdgpu_buffer_rsrc_t rsA0 = __builtin_amdgcn_make_buffer_rsrc((void*)g.A0, 0, 0x7ffffff0, 0x00020000), rsA1 = __builtin_amdgcn_make_buffer_rsrc((void*)g.A1, 0, 0x7ffffff0, 0x00020000);
    const __amdgpu_buffer_rsrc_t rsB0 = __builtin_amdgcn_make_buffer_rsrc((void*)g.B0, 0, 0x7ffffff0, 0x00020000), rsB1 = __builtin_amdgcn_make_buffer_rsrc((void*)g.B1, 0, 0x7ffffff0, 0x00020000);
    const unsigned ldsw = (unsigned)wid * 1024u;
    const int aoff = lds_byte(wr * 64 + fr, fq * 8), boff = lds_byte(wc * 32 + fr, fq * 8);
#define PG8_SA(b, h) (((b) * 2 + (h)) * HTB)
#define PG8_SB(b, h) ((4 + (b) * 2 + (h)) * HTB)
#define PG8_STAGEA2(bufoff, T, h) do { int _T = (T); if (_T >= nt) _T -= nt; const bool _s = _T >= nt0; \
        const int _so = _s ? (pm * 256 * g.lda1 * 2 + (_T - nt0) * kstep + (h) * HALF * g.lda1 * 2) : (pm * 256 * g.lda0 * 2 + _T * kstep + (h) * HALF * g.lda0 * 2); \
        _Pragma("unroll") for (int _i = 0; _i < 2; ++_i) { if (_s) __builtin_amdgcn_raw_ptr_buffer_load_lds(rsA1, (LAS void*)(lds + (bufoff) + ldsw + _i * 8192), 16, (int)voffA[1][_i], _so, 0, 0); \
            else __builtin_amdgcn_raw_ptr_buffer_load_lds(rsA0, (LAS void*)(lds + (bufoff) + ldsw + _i * 8192), 16, (int)voffA[0][_i], _so, 0, 0); } } while (0)
#define PG8_STAGEB2(bufoff, T, h) do { int _T = (T); if (_T >= nt) _T -= nt; const bool _s = _T >= nt0; \
        const int _so = _s ? (pn * 256 * g.ldb1 * 2 + (_T - nt0) * kstep + (h) * HALF * g.ldb1 * 2) : (pn * 256 * g.ldb0 * 2 + _T * kstep + (h) * HALF * g.ldb0 * 2); \
        _Pragma("unroll") for (int _i = 0; _i < 2; ++_i) { if (_s) __builtin_amdgcn_raw_ptr_buffer_load_lds(rsB1, (LAS void*)(lds + (bufoff) + ldsw + _i * 8192), 16, (int)voffB[1][_i], _so, 0, 0); \
            else __builtin_amdgcn_raw_ptr_buffer_load_lds(rsB0, (LAS void*)(lds + (bufoff) + ldsw + _i * 8192), 16, (int)voffB[0][_i], _so, 0, 0); } } while (0)
#define PG8_LDA(dst, b, h) do { _Pragma("unroll") for (int m = 0; m < 4; ++m) _Pragma("unroll") for (int k = 0; k < 2; ++k) dst[m][k] = *(const LAS bf16x8*)(lds + PG8_SA(b, h) + aoff + m * 2048 + k * 1024); } while (0)
#define PG8_LDB(dst, b, h) do { _Pragma("unroll") for (int n = 0; n < 2; ++n) _Pragma("unroll") for (int k = 0; k < 2; ++k) dst[n][k] = *(const LAS bf16x8*)(lds + PG8_SB(b, h) + boff + n * 2048 + k * 1024); } while (0)
#define PG8_MMA(ai, bj, At, Bt) do { __builtin_amdgcn_s_setprio(1); _Pragma("unroll") for (int m = 0; m < 4; ++m) _Pragma("unroll") for (int n = 0; n < 2; ++n) _Pragma("unroll") for (int k = 0; k < 2; ++k) \
        acc[ai][bj][m][n] = __builtin_amdgcn_mfma_f32_16x16x32_bf16(Bt[n][k], At[m][k], acc[ai][bj][m][n], 0, 0, 0); __builtin_amdgcn_s_setprio(0); } while (0)
#define PG8_WAIT_V(n) asm volatile("s_waitcnt vmcnt(" #n ")" ::: "memory")
#define PG8_WAIT_L(n) asm volatile("s_waitcnt lgkmcnt(" #n ")" ::: "memory")
#define PG8_BAR __builtin_amdgcn_s_barrier()
#define PG8_SCHED __builtin_amdgcn_sched_barrier(0)
    Unit cur;
    for (int ui = 0; S.next(ui, cur); ++ui) {
        const int pm = cur.pm, pn = cur.pn;
        f32x4 acc[2][2][4][2];
#pragma unroll
        for (int a = 0; a < 2; ++a)
#pragma unroll
            for (int b = 0; b < 2; ++b)
#pragma unroll
                for (int m = 0; m < 4; ++m)
#pragma unroll
                    for (int n = 0; n < 2; ++n) acc[a][b][m][n] = (f32x4){0.f, 0.f, 0.f, 0.f};
        bf16x8 At[4][2], B0[2][2], B1[2][2];
        PG8_STAGEB2(PG8_SB(0, 0), 0, 0); PG8_STAGEB2(PG8_SB(0, 1), 0, 1); PG8_STAGEA2(PG8_SA(0, 0), 0, 0); PG8_STAGEA2(PG8_SA(0, 1), 0, 1);
        if (wr == 1) PG8_BAR;
        PG8_WAIT_V(2); PG8_BAR;
        PG8_STAGEB2(PG8_SB(1, 0), 1, 0); PG8_STAGEA2(PG8_SA(1, 0), 1, 0); PG8_STAGEB2(PG8_SB(1, 1), 1, 1);
        PG8_WAIT_V(6); PG8_BAR;
#pragma unroll 1
        for (int t = 0; t < nt; t += 2) {
            if (t == nt0) { int l2 = lane; asm volatile("" : "+v"(l2)); int w2 = wid; asm volatile("" : "+s"(w2)); E.mid(acc, cur, w2 >> 2, w2 & 3, l2 & 15, l2 >> 4); }
            PG8_LDB(B0, 0, 0); PG8_LDB(B1, 0, 1); PG8_SCHED; PG8_LDA(At, 0, 0); PG8_STAGEA2(PG8_SA(1, 1), t + 1, 1);
            PG8_WAIT_V(8); PG8_WAIT_L(0); PG8_BAR; PG8_MMA(0, 0, At, B0); PG8_MMA(0, 1, At, B1); PG8_BAR; PG8_SCHED;
            PG8_LDA(At, 0, 1); PG8_STAGEB2(PG8_SB(0, 0), t + 2, 0); PG8_STAGEB2(PG8_SB(0, 1), t + 2, 1); PG8_STAGEA2(PG8_SA(0, 0), t + 2, 0);
            PG8_WAIT_V(8); PG8_WAIT_L(0); PG8_BAR; PG8_MMA(1, 0, At, B0); PG8_MMA(1, 1, At, B1); PG8_BAR; PG8_SCHED;
            PG8_LDB(B0, 1, 0); PG8_LDB(B1, 1, 1); PG8_SCHED; PG8_LDA(At, 1, 0); PG8_STAGEA2(PG8_SA(0, 1), t + 2, 1);
            PG8_WAIT_V(8); PG8_WAIT_L(0); PG8_BAR; PG8_MMA(0, 0, At, B0); PG8_MMA(0, 1, At, B1); PG8_BAR; PG8_SCHED;
            PG8_LDA(At, 1, 1); PG8_STAGEB2(PG8_SB(1, 0), t + 3, 0); PG8_STAGEB2(PG8_SB(1, 1), t + 3, 1); PG8_STAGEA2(PG8_SA(1, 0), t + 3, 0);
            PG8_WAIT_V(8); PG8_WAIT_L(0); PG8_BAR; PG8_MMA(1, 0, At, B0); PG8_MMA(1, 1, At, B1); PG8_BAR; PG8_SCHED;
        }
        PG8_WAIT_V(0);
        if (wr == 0) PG8_BAR;
        PG8_BAR;
        { int l2 = lane; asm volatile("" : "+v"(l2)); int w2 = wid; asm volatile("" : "+s"(w2)); E(acc, cur, w2 >> 2, w2 & 3, l2 & 15, l2 >> 4); }
        PG8_WAIT_V(0); PG8_BAR;
    }
#undef PG8_SA
#undef PG8_SB
#undef PG8_STAGEA2
#undef PG8_STAGEB2
#undef PG8_LDA
#undef PG8_LDB
#undef PG8_MMA
#undef PG8_WAIT_V
#undef PG8_WAIT_L
#undef PG8_BAR
#undef PG8_SCHED
}
}

#define XB_TMO      128
#define XB_XCNT(j)  (256  + 64 * (j))
#define XB_XSUB(j)  (1280 + 64 * (j))
#define XB_XGEN(j)  (2304 + 64 * (j))
#define XB_TOP      3328
#define XB_TOPGEN   3392
#define XCD_BAR_WORDS 3456
#define XB_SPIN_CAP (1u << 18)
__device__ __forceinline__ unsigned xb_ld(unsigned* p)              { return __hip_atomic_load(p, __ATOMIC_RELAXED, __HIP_MEMORY_SCOPE_AGENT); }
__device__ __forceinline__ unsigned xb_add(unsigned* p, unsigned v) { return __hip_atomic_fetch_add(p, v, __ATOMIC_RELAXED, __HIP_MEMORY_SCOPE_AGENT); }
__device__ __forceinline__ unsigned xb_xcc_id() { return (unsigned)__builtin_amdgcn_s_getreg((3 << 11) | 20) & 0xFu; }
#define XB_SPIN(cond, bar) do { unsigned _sp = 0; while (cond) { __builtin_amdgcn_s_sleep(1); \
    if ((++_sp & 255u) == 0u) { if (xb_ld(&(bar)[XB_TMO])) break; if (_sp > XB_SPIN_CAP) { atomicAdd(&(bar)[XB_TMO], 1u); break; } } } } while (0)
struct XcdBarrier { unsigned* bar; unsigned x; volatile LAS unsigned* st; };
__device__ __forceinline__ XcdBarrier xcd_barrier_post(unsigned* bar, volatile LAS unsigned* st) {
    XcdBarrier b; b.bar = bar; b.x = xb_xcc_id(); b.st = st;
    if (threadIdx.x == 0) (void)xb_add(&bar[XB_XCNT(b.x)], 1u);
    return b;
}
__device__ __forceinline__ void xcd_barrier_complete(unsigned* bar, unsigned x, unsigned& nloc, unsigned& nx) {
    const unsigned G = gridDim.x * gridDim.y * gridDim.z;
    unsigned sum, cnt, mine, sp = 0u;
    for (;;) {
        sum = 0u; cnt = 0u; mine = 0u;
#pragma unroll
        for (unsigned j = 0; j < 16; ++j) { const unsigned c = xb_ld(&bar[XB_XCNT(j)]); sum += c; cnt += (c > 0u) ? 1u : 0u; mine = (j == x) ? c : mine; }
        if (sum == G) break;
        __builtin_amdgcn_s_sleep(1);
        if ((++sp & 255u) == 0u) { if (xb_ld(&bar[XB_TMO])) break; if (sp > XB_SPIN_CAP) { atomicAdd(&bar[XB_TMO], 1u); break; } }
    }
    nloc = mine > 0u ? mine : 1u; nx = cnt > 0u ? cnt : 1u;
}
__device__ __forceinline__ void xcd_barrier(const XcdBarrier& b) {
    asm volatile("s_waitcnt vmcnt(0)" ::: "memory");
    __syncthreads();
    if (threadIdx.x == 0) {
        unsigned* bar = b.bar;
        __builtin_amdgcn_s_waitcnt(0);
        unsigned nloc = b.st[0], nx = b.st[1];
        if (nloc == 0u) { xcd_barrier_complete(bar, b.x, nloc, nx); b.st[0] = nloc; b.st[1] = nx; }
        const unsigned old = xb_add(&bar[XB_XSUB(b.x)], 1u);
        const unsigned gen = old / nloc;
        if (old + 1u == (gen + 1u) * nloc) {
            __builtin_amdgcn_fence(__ATOMIC_RELEASE, "agent");
            asm volatile("s_waitcnt vmcnt(0)" ::: "memory");
            const unsigned og = xb_add(&bar[XB_TOP], 1u);
            const unsigned tg = og / nx;
            if (og + 1u == (tg + 1u) * nx) xb_add(&bar[XB_TOPGEN], 1u);
            else XB_SPIN(xb_ld(&bar[XB_TOPGEN]) == tg, bar);
            __builtin_amdgcn_fence(__ATOMIC_ACQUIRE, "agent");
            xb_add(&bar[XB_XGEN(b.x)], 1u);
            asm volatile("s_waitcnt vmcnt(0)" ::: "memory");
        } else {
            XB_SPIN(xb_ld(&bar[XB_XGEN(b.x)]) == gen, bar);
            __builtin_amdgcn_fence(__ATOMIC_ACQUIRE, "agent");
            asm volatile("s_waitcnt vmcnt(0)" ::: "memory");
        }
    }
    __syncthreads();
}


__device__ __forceinline__ void group_barrier(unsigned* gcnt, unsigned target, unsigned* tmo) {
    asm volatile("s_waitcnt vmcnt(0)" ::: "memory");
    __syncthreads();
    if (threadIdx.x == 0) {
        __hip_atomic_fetch_add(gcnt, 1u, __ATOMIC_RELAXED, __HIP_MEMORY_SCOPE_AGENT);
        unsigned sp = 0;
        while (__hip_atomic_load(gcnt, __ATOMIC_RELAXED, __HIP_MEMORY_SCOPE_AGENT) < target) {
            __builtin_amdgcn_s_sleep(1);
            if ((++sp & 1023u) == 0u) { if (__hip_atomic_load(tmo, __ATOMIC_RELAXED, __HIP_MEMORY_SCOPE_AGENT) != 0u) break; if (sp > (1u << 22)) { __hip_atomic_store(tmo, 1u, __ATOMIC_RELAXED, __HIP_MEMORY_SCOPE_AGENT); break; } }
        }
        __builtin_amdgcn_fence(__ATOMIC_ACQUIRE, "agent");
        asm volatile("s_waitcnt vmcnt(0)" ::: "memory");
    }
    __syncthreads();
}
struct Frame {
    LAS unsigned char* lds;
    unsigned* ctl;
    int tid, lane, wave, vcu, G;
    unsigned char* ws;
};
struct Args { const float* in[15]; float* out; unsigned char* ws; int ph_lo, ph_hi, li, pad; };

__device__ __forceinline__ int fresh(int v) { asm volatile("" : "+v"(v)); return v; }
__device__ __forceinline__ float wave_sum(float v) {
#pragma unroll
    for (int o = 1; o < 64; o <<= 1) v += __shfl_xor(v, o);
    return v;
}
__device__ __forceinline__ float wave_max(float v) {
#pragma unroll
    for (int o = 1; o < 64; o <<= 1) v = fmaxf(v, __shfl_xor(v, o));
    return v;
}

__host__ __device__ __forceinline__ int win_row(int n) { if (n < 7168) return n; const int g = (n - 7168) >> 10, c = (n - 7168) & 1023; return 7168 + 256 * (c >> 7) + 128 * g + (c & 127); }
template <class RowFn>
__device__ __forceinline__ void p0_transpose_item(const float* W, int K, int N, const float* kscale, float gscale, const RowFn& rowptr, LAS float* scr, int item, int lane) {
    const int nblk = N / 32, kb = item / nblk, nb = item % nblk, k0 = 64 * kb, n0 = 32 * nb;
    float wv[32];
#pragma unroll
    for (int i = 0; i < 32; ++i) wv[i] = __builtin_nontemporal_load(W + (size_t)(k0 + 2 * i + (lane >> 5)) * N + n0 + (lane & 31));
#pragma unroll
    for (int i = 0; i < 32; ++i) { const int kk = 2 * i + (lane >> 5); const float sc = kscale ? kscale[k0 + kk] * gscale : gscale; scr[kk * 33 + (lane & 31)] = wv[i] * sc; }
    LDS_WAIT(); asm volatile("" ::: "memory");
    const int c = lane & 7;
#pragma unroll
    for (int j = 0; j < 4; ++j) { const int n = (lane >> 3) + 8 * j; const LAS float* s = scr + (8 * c) * 33 + n;
        u32x4 o; o.x = cvt_pk_bf16(s[0 * 33], s[1 * 33]); o.y = cvt_pk_bf16(s[2 * 33], s[3 * 33]); o.z = cvt_pk_bf16(s[4 * 33], s[5 * 33]); o.w = cvt_pk_bf16(s[6 * 33], s[7 * 33]);
        *(u32x4*)(rowptr(n0 + n) + k0 + 8 * c) = o; }
    LDS_WAIT(); asm volatile("" ::: "memory");
}

template <class RowFn>
__device__ __forceinline__ void p0_mini_item(const float* W, int N, const float* kscale, float gscale, const RowFn& rowptr, int kb, int nb, int lane) {
    const int k0 = 32 * kb, n = 64 * nb + lane;
    float v[32];
#pragma unroll
    for (int j = 0; j < 32; ++j) v[j] = __builtin_nontemporal_load(W + (size_t)(k0 + j) * N + n);
#pragma unroll
    for (int j = 0; j < 32; ++j) v[j] *= kscale ? kscale[k0 + j] * gscale : gscale;
    bf16_t* dst = rowptr(n) + k0;
#pragma unroll
    for (int q = 0; q < 4; ++q) { u32x4 o; o.x = cvt_pk_bf16(v[8 * q], v[8 * q + 1]); o.y = cvt_pk_bf16(v[8 * q + 2], v[8 * q + 3]); o.z = cvt_pk_bf16(v[8 * q + 4], v[8 * q + 5]); o.w = cvt_pk_bf16(v[8 * q + 6], v[8 * q + 7]);
        *(u32x4*)(dst + 8 * q) = o; }
}
constexpr int P1_MINI = 32 * 144 + 16 * 16 + 2 * 32 * 16 + 16 * 32;
__device__ __forceinline__ void p0_layer1_mini(const float* const* in, unsigned char* ws, int idx, int lane) {
    bf16_t* Wb = (bf16_t*)(ws + WS_W);
    if (idx < 32 * 144) { bf16_t* dst = Wb + W_IN_T / 2 + (size_t)NIN * DM;
        p0_mini_item(in[2] + (size_t)DM * NIN, NIN, in[1] + DM, 1.0f, [=](int n) { return dst + (size_t)win_row(n) * DM; }, idx / 144, idx % 144, lane); return; } idx -= 32 * 144;
    if (idx < 256) { bf16_t* dst = Wb + W_OATT_T / 2 + (size_t)DM * 512;
        p0_mini_item(in[11] + (size_t)512 * DM, DM, nullptr, 1.0f, [=](int n) { return dst + (size_t)n * 512; }, idx / 16, idx % 16, lane); return; } idx -= 256;
    if (idx < 512) { bf16_t* dst = Wb + W_OLRU_T / 2 + (size_t)DM * DM;
        p0_mini_item(in[12] + (size_t)DM * DM, DM, nullptr, 1.0f, [=](int n) { return dst + (size_t)n * DM; }, idx / 16, idx % 16, lane); return; } idx -= 512;
    if (idx < 512) { bf16_t* dst = Wb + W_OUT_T / 2 + (size_t)DM * DM;
        p0_mini_item(in[13] + (size_t)DM * DM, DM, nullptr, 1.0f, [=](int n) { return dst + (size_t)n * DM; }, idx / 16, idx % 16, lane); return; } idx -= 512;
    {   const int s = idx / 32, item = idx % 32, dir = s >> 3, kind = (s >> 2) & 1, n = s & 3;
        const float* src = (kind ? in[8] : in[6]) + ((size_t)((1 * 2 + dir) * 4 + n)) * 65536;
        bf16_t* dst = Wb + W_RG_T / 2 + (size_t)(1 * 4 + n) * 4 * 65536;
        p0_mini_item(src, 256, nullptr, -LOG2E, [=](int j) { return dst + (size_t)(j >> 6) * 65536 + (size_t)(128 * dir + 32 * ((j >> 4) & 3) + 16 * kind + (j & 15)) * 256; }, item / 4, item % 4, lane);
    }
}
__device__ __forceinline__ void p0_prologue(Frame& F, const Args& a) {
    LAS float* scr = (LAS float*)(F.lds + F.wave * 16384);
    const int gw = F.vcu * 8 + F.wave, NGW = F.G * 8;
    bf16_t* Wb = (bf16_t*)(F.ws + WS_W);
    constexpr int I_IN = (DM / 64) * (NIN / 32), I_OA = (512 / 64) * (DM / 32), I_OL = (DM / 64) * (DM / 32), I_RG = (256 / 64) * (256 / 32);
    constexpr int PER_LAYER = I_IN + I_OA + 2 * I_OL + 16 * I_RG;
    const int n_items = (F.G == 256) ? PER_LAYER : DEPTH * PER_LAYER;
    for (int it = gw; it < n_items; it += NGW) {
        const int l = it / PER_LAYER; int r = it % PER_LAYER;
        if (r < I_IN) { bf16_t* dst = Wb + W_IN_T / 2 + (size_t)l * NIN * DM;
            p0_transpose_item(a.in[2] + (size_t)l * DM * NIN, DM, NIN, a.in[1] + l * DM, 1.0f, [=](int n) { return dst + (size_t)win_row(n) * DM; }, scr, r, F.lane); continue; } r -= I_IN;
        if (r < I_OA) { bf16_t* dst = Wb + W_OATT_T / 2 + (size_t)l * DM * 512;
            p0_transpose_item(a.in[11] + (size_t)l * 512 * DM, 512, DM, nullptr, 1.0f, [=](int n) { return dst + (size_t)n * 512; }, scr, r, F.lane); continue; } r -= I_OA;
        if (r < I_OL) { bf16_t* dst = Wb + W_OLRU_T / 2 + (size_t)l * DM * DM;
            p0_transpose_item(a.in[12] + (size_t)l * DM * DM, DM, DM, nullptr, 1.0f, [=](int n) { return dst + (size_t)n * DM; }, scr, r, F.lane); continue; } r -= I_OL;
        if (r < I_OL) { bf16_t* dst = Wb + W_OUT_T / 2 + (size_t)l * DM * DM;
            p0_transpose_item(a.in[13] + (size_t)l * DM * DM, DM, DM, nullptr, 1.0f, [=](int n) { return dst + (size_t)n * DM; }, scr, r, F.lane); continue; } r -= I_OL;
        {
            const int s = r / I_RG, item = r % I_RG, dir = s >> 3, kind = (s >> 2) & 1, n = s & 3;
            const float* src = (kind ? a.in[8] : a.in[6]) + ((size_t)((l * 2 + dir) * 4 + n)) * 65536;
            bf16_t* dst = Wb + W_RG_T / 2 + (size_t)(l * 4 + n) * 4 * 65536;
            p0_transpose_item(src, 256, 256, nullptr, -LOG2E, [=](int j) { return dst + (size_t)(j >> 6) * 65536 + (size_t)(128 * dir + 32 * ((j >> 4) & 3) + 16 * kind + (j & 15)) * 256; }, scr, item, F.lane);
        }
    }
    for (int i = gw * 64 + F.lane; i < DEPTH * 2 * DM; i += NGW * 64) {
        const float c2 = -8.0f * LOG2E * log1pf(expf(-a.in[10][i]));
        ((f32x4*)(F.ws + WS_LC))[i] = (f32x4){-LOG2E * a.in[7][i], -LOG2E * a.in[9][i], c2, 2.0f * c2};
    }
    const float* x = a.in[0]; bf16_t* XB = (bf16_t*)(F.ws + WS_XB);
    for (int m0 = gw * 4; m0 < M; m0 += NGW * 4) {
        f32x4 v[4][4];
#pragma unroll
        for (int r = 0; r < 4; ++r)
#pragma unroll
            for (int j = 0; j < 4; ++j) v[r][j] = __builtin_nontemporal_load((const f32x4*)(x + (size_t)(m0 + r) * DM) + F.lane + 64 * j);
#pragma unroll
        for (int r = 0; r < 4; ++r) { float s = 0.f;
#pragma unroll
            for (int j = 0; j < 4; ++j) { const f32x4 t = v[r][j]; s += (t.x * t.x + t.y * t.y) + (t.z * t.z + t.w * t.w); }
            const float rstd = __builtin_amdgcn_rsqf(wave_sum(s) * (1.0f / DM) + NORM_EPS);
            unsigned long long* o8 = (unsigned long long*)(XB + (size_t)(m0 + r) * DM) + F.lane;
#pragma unroll
            for (int j = 0; j < 4; ++j) { const f32x4 t = v[r][j] * rstd;
                o8[64 * j] = (unsigned long long)cvt_pk_bf16(t.x, t.y) | ((unsigned long long)cvt_pk_bf16(t.z, t.w) << 32); } }
    }
}

struct EpiProjA {
    static constexpr bool PERM = true, AFTER_DRAIN = false;
    unsigned char* ws; bool dry;
    __device__ __forceinline__ void operator()(const f32x4 (&acc)[2][2][4][2], const pg8::Unit& u, int wr, int wc, int fr, int fq) const {
        const int kind = u.pn / 6;
#pragma unroll
        for (int ai = 0; ai < 2; ++ai)
#pragma unroll
            for (int m = 0; m < 4; ++m) {
                const int row = u.pm * 256 + ai * 128 + wr * 64 + m * 16 + fr;
                if (kind < 3) {
                    const int b = row >> 13, p = row & 8191; const float sc = (kind == 0) ? QSCALE : 1.0f;
                    bf16_t* base = (bf16_t*)(ws + WS_Q + (size_t)kind * (WS_K - WS_Q));
#pragma unroll
                    for (int bj = 0; bj < 2; ++bj) {
                        const int hh = 2 * (u.pn - 6 * kind) + bj;
                        bf16_t* dst = base + ((size_t)(b * NH + hh) * SEQ + p) * HD + wc * 32 + 8 * fq;
                        const f32x4 v0 = acc[ai][bj][m][0] * sc, v1 = acc[ai][bj][m][1] * sc;
                        u32x4 w; w.x = cvt_pk_bf16(v0[0], v0[1]); w.y = cvt_pk_bf16(v0[2], v0[3]); w.z = cvt_pk_bf16(v1[0], v1[1]); w.w = cvt_pk_bf16(v1[2], v1[3]);
                        if (!dry) *(u32x4*)dst = w;
#if defined(DRY_SCRATCH)
                        else *(u32x4*)(ws + 234 * MiB + (size_t)blockIdx.x * 131072 + ((ai * 4 + m) * 2 + bj) * 8192 + (wr * 4 + wc) * 1024 + (fq * 16 + fr) * 16) = w;
#elif defined(DRY_FRESH)
                        else *(u32x4*)(ws + WS_Q + (size_t)(u.pm * 20 + u.pn) * 131072 + ((ai * 4 + m) * 2 + bj) * 8192 + (wr * 4 + wc) * 1024 + (fq * 16 + fr) * 16) = w;
#elif defined(DRY_REAL)
                        else *(u32x4*)dst = w;
#else
                        else asm volatile("" :: "v"(w));
#endif
                    }
                } else {
#pragma unroll
                    for (int bj = 0; bj < 2; ++bj) {
                        bf16_t* dst = (bf16_t*)(ws + WS_SGA) + (size_t)row * 512 + (u.pn - 18) * 256 + bj * 128 + wc * 32 + 8 * fq;
                        const f32x4 v0 = acc[ai][bj][m][0], v1 = acc[ai][bj][m][1];
                        u32x4 w; w.x = cvt_pk_bf16(fast_silu(v0[0]), fast_silu(v0[1])); w.y = cvt_pk_bf16(fast_silu(v0[2]), fast_silu(v0[3]));
                        w.z = cvt_pk_bf16(fast_silu(v1[0]), fast_silu(v1[1])); w.w = cvt_pk_bf16(fast_silu(v1[2]), fast_silu(v1[3]));
                        *(u32x4*)dst = w;
                    }
                }
            }
    }
};
struct EpiProjB {
    static constexpr bool PERM = true, AFTER_DRAIN = false;
    unsigned char* ws; const float* bgate;
    __device__ __forceinline__ void operator()(const f32x4 (&acc)[2][2][4][2], const pg8::Unit& u, int wr, int wc, int fr, int fq) const {
        const int kind = u.pn < 4 ? 0 : (u.pn < 8 ? 1 : 2);
        if (kind == 2) {
            const int c0 = (u.pn - 8) * 128 + wc * 32 + 8 * fq;
            f32x4 ba[2], bl[2];
#pragma unroll
            for (int n = 0; n < 2; ++n) { ba[n] = *(const f32x4*)(bgate + c0 + 4 * n); bl[n] = *(const f32x4*)(bgate + 1024 + c0 + 4 * n); }
#pragma unroll
            for (int ai = 0; ai < 2; ++ai)
#pragma unroll
                for (int m = 0; m < 4; ++m) {
                    const int row = u.pm * 256 + ai * 128 + wr * 64 + m * 16 + fr;
                    float ra[8], gl[8];
#pragma unroll
                    for (int n = 0; n < 2; ++n)
#pragma unroll
                        for (int e = 0; e < 4; ++e) { const float ga = fast_sigmoid(acc[ai][0][m][n][e] + ba[n][e]); const float g2 = fast_sigmoid(acc[ai][1][m][n][e] + bl[n][e]);
                            gl[4 * n + e] = g2; ra[4 * n + e] = ga * __builtin_amdgcn_rcpf(fmaxf(g2, 1e-30f)); }
                    bf16_t* dst = (bf16_t*)(ws + WS_GATE) + (size_t)row * 2048 + c0;
                    u32x4 w; w.x = cvt_pk_bf16(ra[0], ra[1]); w.y = cvt_pk_bf16(ra[2], ra[3]); w.z = cvt_pk_bf16(ra[4], ra[5]); w.w = cvt_pk_bf16(ra[6], ra[7]);
                    *(u32x4*)dst = w;
                    w.x = cvt_pk_bf16(gl[0], gl[1]); w.y = cvt_pk_bf16(gl[2], gl[3]); w.z = cvt_pk_bf16(gl[4], gl[5]); w.w = cvt_pk_bf16(gl[6], gl[7]);
                    *(u32x4*)(dst + 1024) = w;
                }
            return;
        }
#pragma unroll
        for (int ai = 0; ai < 2; ++ai)
#pragma unroll
            for (int m = 0; m < 4; ++m) {
                const int row = u.pm * 256 + ai * 128 + wr * 64 + m * 16 + fr;
#pragma unroll
                for (int bj = 0; bj < 2; ++bj) {
                    const int cin = bj * 128 + wc * 32 + 8 * fq;
                    f32x4 v0 = acc[ai][bj][m][0], v1 = acc[ai][bj][m][1];
                    bf16_t* dst;
                    if (kind == 0) dst = (bf16_t*)(ws + WS_XLRU) + (size_t)row * DM + u.pn * 256 + cin;
                    else { dst = (bf16_t*)(ws + WS_SGL) + (size_t)row * DM + (u.pn - 4) * 256 + cin;
#pragma unroll
                        for (int e = 0; e < 4; ++e) { v0[e] = fast_silu(v0[e]); v1[e] = fast_silu(v1[e]); } }
                    u32x4 w; w.x = cvt_pk_bf16(v0[0], v0[1]); w.y = cvt_pk_bf16(v0[2], v0[3]); w.z = cvt_pk_bf16(v1[0], v1[1]); w.w = cvt_pk_bf16(v1[2], v1[3]);
                    *(u32x4*)dst = w;
                }
            }
    }
};
struct EpiMerge2 {
    static constexpr bool PERM = true;
    bf16_t* MG; const bf16_t* GATE;
    __device__ __forceinline__ void mid(f32x4 (&acc)[2][2][4][2], const pg8::Unit& u, int wr, int wc, int fr, int fq) const {
#pragma unroll
        for (int ai = 0; ai < 2; ++ai) {
            u32x4 ra[4][2];
#pragma unroll
            for (int m = 0; m < 4; ++m)
#pragma unroll
                for (int bj = 0; bj < 2; ++bj) {
                    const int row = u.pm * 256 + ai * 128 + wr * 64 + m * 16 + fr, col = u.pn * 256 + bj * 128 + wc * 32 + 8 * fq;
                    ra[m][bj] = *(const u32x4*)(GATE + (size_t)row * 2048 + col);
                }
#pragma unroll
            for (int m = 0; m < 4; ++m)
#pragma unroll
                for (int bj = 0; bj < 2; ++bj) {
                    const u32x4 r4 = ra[m][bj];
                    f32x4& v0 = acc[ai][bj][m][0]; f32x4& v1 = acc[ai][bj][m][1];
                    v0[0] *= bf_lo(r4.x); v0[1] *= bf_hi(r4.x); v0[2] *= bf_lo(r4.y); v0[3] *= bf_hi(r4.y);
                    v1[0] *= bf_lo(r4.z); v1[1] *= bf_hi(r4.z); v1[2] *= bf_lo(r4.w); v1[3] *= bf_hi(r4.w);
                }
        }
    }
    __device__ __forceinline__ void operator()(const f32x4 (&acc)[2][2][4][2], const pg8::Unit& u, int wr, int wc, int fr, int fq) const {
#pragma unroll
        for (int ai = 0; ai < 2; ++ai) {
            u32x4 gl[4][2];
#pragma unroll
            for (int m = 0; m < 4; ++m)
#pragma unroll
                for (int bj = 0; bj < 2; ++bj) {
                    const int row = u.pm * 256 + ai * 128 + wr * 64 + m * 16 + fr, col = u.pn * 256 + bj * 128 + wc * 32 + 8 * fq;
                    gl[m][bj] = *(const u32x4*)(GATE + (size_t)row * 2048 + 1024 + col);
                }
#pragma unroll
            for (int m = 0; m < 4; ++m)
#pragma unroll
                for (int bj = 0; bj < 2; ++bj) {
                    const int row = u.pm * 256 + ai * 128 + wr * 64 + m * 16 + fr, col = u.pn * 256 + bj * 128 + wc * 32 + 8 * fq;
                    const u32x4 g4 = gl[m][bj];
                    f32x4 v0 = acc[ai][bj][m][0], v1 = acc[ai][bj][m][1];
                    v0[0] *= fmaxf(bf_lo(g4.x), 1e-30f); v0[1] *= fmaxf(bf_hi(g4.x), 1e-30f); v0[2] *= fmaxf(bf_lo(g4.y), 1e-30f); v0[3] *= fmaxf(bf_hi(g4.y), 1e-30f);
                    v1[0] *= fmaxf(bf_lo(g4.z), 1e-30f); v1[1] *= fmaxf(bf_hi(g4.z), 1e-30f); v1[2] *= fmaxf(bf_lo(g4.w), 1e-30f); v1[3] *= fmaxf(bf_hi(g4.w), 1e-30f);
                    u32x4 w; w.x = cvt_pk_bf16(v0[0], v0[1]); w.y = cvt_pk_bf16(v0[2], v0[3]); w.z = cvt_pk_bf16(v1[0], v1[1]); w.w = cvt_pk_bf16(v1[2], v1[3]);
                    *(u32x4*)(MG + (size_t)row * DM + col) = w;
                }
        }
    }
};
template <bool LAST, bool XBF> struct EpiResidNorm {
    static constexpr bool PERM = false, AFTER_DRAIN = true;
    const float* xin; float* out; bf16_t* XB; float* ssn; const float* g; unsigned* pan; unsigned* tmo;
    __device__ __forceinline__ void fused(f32x4 (&acc)[2][2][4][2], const pg8::Unit& u, int wr, int wc, int fr, int fq, LAS unsigned char* lds, int wid, int lane) const {
#pragma unroll
        for (int ai = 0; ai < 2; ++ai)
#pragma unroll
            for (int mp = 0; mp < 2; ++mp) {
                f32x4 xi[2][2][2];
#pragma unroll
                for (int mm = 0; mm < 2; ++mm)
#pragma unroll
                    for (int bj = 0; bj < 2; ++bj)
#pragma unroll
                        for (int n = 0; n < 2; ++n) {
                            const int row = u.pm * 256 + ai * 128 + wr * 64 + (mp * 2 + mm) * 16 + fr;
                            if (XBF) { const u32x2 w = *(const u32x2*)((const unsigned char*)xin + (size_t)row * (DM * 4) + u.pn * 1024 + (bj * 128 + wc * 32 + n * 16 + 4 * fq) * 2);
                                xi[mm][bj][n] = (f32x4){bf_lo(w.x), bf_hi(w.x), bf_lo(w.y), bf_hi(w.y)}; }
                            else xi[mm][bj][n] = *(const f32x4*)(xin + (size_t)row * DM + u.pn * 256 + bj * 128 + wc * 32 + n * 16 + 4 * fq);
                        }
#pragma unroll
                for (int mm = 0; mm < 2; ++mm) {
                    const int m = mp * 2 + mm, row = u.pm * 256 + ai * 128 + wr * 64 + m * 16 + fr; float s = 0.f;
#pragma unroll
                    for (int bj = 0; bj < 2; ++bj)
#pragma unroll
                        for (int n = 0; n < 2; ++n) { const f32x4 v = xi[mm][bj][n] + acc[ai][bj][m][n]; acc[ai][bj][m][n] = v; s += (v[0] * v[0] + v[1] * v[1]) + (v[2] * v[2] + v[3] * v[3]); }
                    s += __shfl_xor(s, 16); s += __shfl_xor(s, 32);
                    if (fq == 0) atomicAdd(ssn + row, s);
                }
            }
        asm volatile("s_waitcnt vmcnt(0)" ::: "memory"); __builtin_amdgcn_s_barrier(); asm volatile("" ::: "memory");
        unsigned* cnt = pan + 64 * u.pm;
        if (wid == 0 && lane == 0) __hip_atomic_fetch_add(cnt, 1u, __ATOMIC_RELAXED, __HIP_MEMORY_SCOPE_AGENT);
        if (!LAST) {
#pragma unroll
            for (int ai = 0; ai < 2; ++ai)
#pragma unroll
                for (int m = 0; m < 4; ++m) { const int row = u.pm * 256 + ai * 128 + wr * 64 + m * 16 + fr;
#pragma unroll
                    for (int bj = 0; bj < 2; ++bj)
#pragma unroll
                        for (int n = 0; n < 2; ++n) { const f32x4 v = acc[ai][bj][m][n]; u32x2 w; w.x = cvt_pk_bf16(v[0], v[1]); w.y = cvt_pk_bf16(v[2], v[3]);
                            *(u32x2*)((unsigned char*)out + (size_t)row * (DM * 4) + u.pn * 1024 + (bj * 128 + wc * 32 + n * 16 + 4 * fq) * 2) = w; } }
        }
        if (wid == 0) {
            unsigned sp = 0;
            while ((unsigned)__builtin_amdgcn_readfirstlane(__hip_atomic_load(cnt, __ATOMIC_RELAXED, __HIP_MEMORY_SCOPE_AGENT)) < 4u) {
                __builtin_amdgcn_s_sleep(1);
                if ((++sp & 1023u) == 0u) { if (__hip_atomic_load(tmo, __ATOMIC_RELAXED, __HIP_MEMORY_SCOPE_AGENT) != 0u) break; if (sp > (1u << 22)) { if (lane == 0) __hip_atomic_store(tmo, 1u, __ATOMIC_RELAXED, __HIP_MEMORY_SCOPE_AGENT); break; } }
            }
        }
        __builtin_amdgcn_s_barrier(); asm volatile("" ::: "memory");
        float rs[2][4];
#pragma unroll
        for (int ai = 0; ai < 2; ++ai)
#pragma unroll
            for (int m = 0; m < 4; ++m) rs[ai][m] = __hip_atomic_load(ssn + u.pm * 256 + ai * 128 + wr * 64 + m * 16 + fr, __ATOMIC_RELAXED, __HIP_MEMORY_SCOPE_AGENT);
        f32x4 gv[2][2];
#pragma unroll
        for (int bj = 0; bj < 2; ++bj)
#pragma unroll
            for (int n = 0; n < 2; ++n) gv[bj][n] = LAST ? *(const f32x4*)(g + u.pn * 256 + bj * 128 + wc * 32 + n * 16 + 4 * fq) : (f32x4){1.f, 1.f, 1.f, 1.f};
#pragma unroll
        for (int ai = 0; ai < 2; ++ai)
#pragma unroll
            for (int m = 0; m < 4; ++m) {
                const int row = u.pm * 256 + ai * 128 + wr * 64 + m * 16 + fr;
                const float rstd = __builtin_amdgcn_rsqf(rs[ai][m] * (1.0f / DM) + NORM_EPS);
#pragma unroll
                for (int bj = 0; bj < 2; ++bj)
#pragma unroll
                    for (int n = 0; n < 2; ++n) {
                        const size_t off = (size_t)row * DM + u.pn * 256 + bj * 128 + wc * 32 + n * 16 + 4 * fq;
                        if (LAST) *(f32x4*)(out + off) = acc[ai][bj][m][n] * rstd * gv[bj][n];
                        else { const f32x4 v = acc[ai][bj][m][n] * rstd; u32x2 w; w.x = cvt_pk_bf16(v[0], v[1]); w.y = cvt_pk_bf16(v[2], v[3]); *(u32x2*)(XB + off) = w; }
                    }
            }
    }
};

typedef float f32x16 __attribute__((ext_vector_type(16)));
typedef short s16x4 __attribute__((ext_vector_type(4)));
typedef __bf16 bf16x2_t __attribute__((ext_vector_type(2)));
__device__ __forceinline__ unsigned cvtpk_c(float lo, float hi) { f32x2 v = {lo, hi}; bf16x2_t b = __builtin_convertvector(v, bf16x2_t); return __builtin_bit_cast(unsigned, b); }
__device__ __forceinline__ int crow(int r, int hi) { return (r & 3) + 8 * (r >> 2) + 4 * hi; }
__device__ __forceinline__ void attn_dma(LAS unsigned char* img, const bf16_t* base, int U, int seq_lo, int seq_hi, int sh, int w, int lane) {
    const int rseq = seq_lo >> (13 - sh);
    const __amdgpu_buffer_rsrc_t rs = __builtin_amdgcn_make_buffer_rsrc((void*)base, 0, SEQ * 256, 0x00020000);
    const int rl0 = lane >> 4, cp = lane & 15;
#pragma unroll
    for (int i = 0; i < 12; ++i) {
        const int pc = w * 12 + i, row_local = 4 * pc + rl0;
        int grow = U - 64 + row_local; grow = grow < seq_lo ? seq_lo : grow; grow = grow > seq_hi - 1 ? seq_hi - 1 : grow;
        const int tok = ((grow - seq_lo) << sh) + rseq;
        const int voff = tok * 256 + ((cp ^ ((rl0 << 2) | (i & 3))) << 4);
        __builtin_amdgcn_raw_ptr_buffer_load_lds(rs, (LAS void*)(img + pc * 1024), 16, voff, 0, 0, 0);
    }
}
constexpr int ATT_STG = 98304;
struct AttnUnit { int bh, U, seq_lo, seq_hi, hh, sh; };
__device__ __forceinline__ AttnUnit attn_decode(int unit) {
    AttnUnit a; a.bh = unit >> 5; const int qb = unit & 31; a.hh = a.bh % NH; a.sh = 2 * (a.hh >> 2); const int ng = SEQ >> a.sh;
    a.U = qb * 256; a.seq_lo = a.U & ~(ng - 1); a.seq_hi = a.seq_lo + ng; return a;
}
__device__ __forceinline__ void attn_unit(Frame& F, int unit, int next_unit, bool dry) {
    LAS unsigned char* img = F.lds;
    const int lane = F.lane, w = F.wave, c = lane & 31, hi = lane >> 5;
    const AttnUnit au = attn_decode(unit);
    const int bh = au.bh, U = au.U, seq_lo = au.seq_lo, seq_hi = au.seq_hi;
    bf16_t* Qh = (bf16_t*)(F.ws + WS_Q) + (size_t)bh * SEQ * HD;
    const bf16_t* Vh = (const bf16_t*)(F.ws + WS_V) + (size_t)bh * SEQ * HD;
    bf16x8 qf[8];
    const int rseq = seq_lo >> (13 - au.sh);
    const int qtok = ((U + 32 * w + c - seq_lo) << au.sh) + rseq;
    { const bf16_t* qrow = Qh + (size_t)qtok * HD + 8 * hi;
#pragma unroll
      for (int s = 0; s < 8; ++s) qf[s] = *(const bf16x8*)(qrow + 16 * s); }
    const float slope2 = __builtin_amdgcn_exp2f(-8.0f * (float)(au.hh + 1) / 12.0f) * (float)(1 << au.sh) * LOG2E;
    asm volatile("s_waitcnt vmcnt(0)" ::: "memory"); __builtin_amdgcn_s_barrier(); asm volatile("" ::: "memory");
    f32x16 p[5];
    {   const int lk = fresh(lane), ck = lk & 31, hk = lk >> 5;
        const unsigned swz = ((unsigned)(ck & 3) << 2) | ((unsigned)(ck >> 2) & 3u);
        unsigned kx[8];
#pragma unroll
        for (int s = 0; s < 8; ++s) kx[s] = 256u * (unsigned)(32 * w + ck) + 16u * (((unsigned)(2 * s + hk)) ^ swz);
#pragma unroll
        for (int i = 0; i < 5; ++i) {
            f32x16 a = {0.f, 0.f, 0.f, 0.f, 0.f, 0.f, 0.f, 0.f, 0.f, 0.f, 0.f, 0.f, 0.f, 0.f, 0.f, 0.f};
#pragma unroll
            for (int s = 0; s < 8; ++s) { const bf16x8 kf = *(const LAS bf16x8*)(img + kx[s] + 8192 * i); a = __builtin_amdgcn_mfma_f32_32x32x16_bf16(kf, qf[s], a, 0, 0, 0); }
            p[i] = a;
        }
    }
    asm volatile("s_waitcnt lgkmcnt(0)" ::: "memory"); __builtin_amdgcn_s_barrier(); asm volatile("" ::: "memory");
    attn_dma(img, Vh, U, seq_lo, seq_hi, au.sh, w, lane);
    const bool lo_edge = (U == seq_lo), hi_edge = (U + 256 == seq_hi);
    const int lm = fresh(lane);
    const float dbase = (float)(4 * (lm >> 5) - (lm & 31));
    float mx = -1e30f;
#pragma unroll
    for (int i = 0; i < 5; ++i) {
        const bool tile_dead = (lo_edge && (w + i < 2)) || (hi_edge && (w + i >= 10));
#pragma unroll
        for (int r = 0; r < 16; ++r) {
            const float ad = fabsf((float)(32 * i + (r & 3) + 8 * (r >> 2) - 64) + dbase);
            float s = p[i][r] - slope2 * ad;
            if (i == 0 || i == 4) s = (ad <= 64.0f) ? s : -1e30f;
            if (tile_dead) s = -1e30f;
            p[i][r] = s; mx = fmaxf(mx, s);
        }
    }
    mx = fmaxf(mx, __shfl_xor(mx, 32));
    float l = 0.f;
    u32x4 pa[5][2];
#pragma unroll
    for (int i = 0; i < 5; ++i) {
#pragma unroll
        for (int r = 0; r < 16; ++r) { const float e = __builtin_amdgcn_exp2f(p[i][r] - mx); p[i][r] = e; l += e; }
#pragma unroll
        for (int s = 0; s < 2; ++s) {
            pa[i][s].x = cvtpk_c(p[i][8 * s + 0], p[i][8 * s + 1]); pa[i][s].y = cvtpk_c(p[i][8 * s + 2], p[i][8 * s + 3]);
            pa[i][s].z = cvtpk_c(p[i][8 * s + 4], p[i][8 * s + 5]); pa[i][s].w = cvtpk_c(p[i][8 * s + 6], p[i][8 * s + 7]);
        }
    }
    l += __shfl_xor(l, 32);
    const float inv = __builtin_amdgcn_rcpf(l);
    if (hi == 0 && !dry) ((float*)(F.ws + WS_LSE))[(size_t)bh * SEQ + qtok] = mx + __builtin_amdgcn_logf(l);
    asm volatile("s_waitcnt vmcnt(0)" ::: "memory"); __builtin_amdgcn_s_barrier(); asm volatile("" ::: "memory");
    f32x16 o[4];
#pragma unroll
    for (int c4 = 0; c4 < 4; ++c4) o[c4] = (f32x16){0.f, 0.f, 0.f, 0.f, 0.f, 0.f, 0.f, 0.f, 0.f, 0.f, 0.f, 0.f, 0.f, 0.f, 0.f, 0.f};
    {   const int lv = fresh(lane), blk = (lv >> 4) & 1, q = (lv & 15) >> 2, pp = lv & 3, hv = lv >> 5;
        unsigned vx[4][2];
#pragma unroll
        for (int c4 = 0; c4 < 4; ++c4)
#pragma unroll
            for (int t = 0; t < 2; ++t)
                vx[c4][t] = 256u * (unsigned)(32 * w + 8 * t + 4 * hv + q) + 16u * ((((unsigned)(c4 ^ q)) << 2) | (((unsigned)(2 * blk + (pp >> 1))) ^ ((unsigned)(2 * t + hv)))) + 8u * (unsigned)(pp & 1);
#pragma unroll
        for (int i = 0; i < 5; ++i)
#pragma unroll
            for (int s = 0; s < 2; ++s) {
                const bf16x8 pf = __builtin_bit_cast(bf16x8, pa[i][s]);
#pragma unroll
                for (int c4 = 0; c4 < 4; ++c4) {
                    const s16x4 v0 = __builtin_bit_cast(s16x4, __builtin_amdgcn_ds_read_tr16_b64_v4i16((LAS s16x4*)(img + vx[c4][0] + 8192 * i + 4096 * s)));
                    const s16x4 v1 = __builtin_bit_cast(s16x4, __builtin_amdgcn_ds_read_tr16_b64_v4i16((LAS s16x4*)(img + vx[c4][1] + 8192 * i + 4096 * s)));
                    const bf16x8 vf = (bf16x8){v0[0], v0[1], v0[2], v0[3], v1[0], v1[1], v1[2], v1[3]};
                    o[c4] = __builtin_amdgcn_mfma_f32_32x32x16_bf16(vf, pf, o[c4], 0, 0, 0);
                }
            }
    }
    asm volatile("s_waitcnt lgkmcnt(0)" ::: "memory"); __builtin_amdgcn_s_barrier(); asm volatile("" ::: "memory");
    if (next_unit < BATCH * NH * 32) { const AttnUnit nu = attn_decode(next_unit);
        attn_dma(img, (const bf16_t*)(F.ws + WS_K) + (size_t)nu.bh * SEQ * HD, nu.U, nu.seq_lo, nu.seq_hi, nu.sh, w, lane); }
    {   LAS unsigned char* stg = F.lds + ATT_STG + w * 4096;
        const int otok0 = ((U + 32 * w - seq_lo) << au.sh) + rseq;
#pragma unroll
        for (int rnd = 0; rnd < 2; ++rnd) {
            if ((c >> 4) == rnd) {
                const int rr = c & 15;
#pragma unroll
                for (int c4 = 0; c4 < 4; ++c4)
#pragma unroll
                    for (int g = 0; g < 4; ++g) {
                        u32x2 v; v.x = cvtpk_c(o[c4][4 * g + 0] * inv, o[c4][4 * g + 1] * inv); v.y = cvtpk_c(o[c4][4 * g + 2] * inv, o[c4][4 * g + 3] * inv);
                        *(LAS u32x2*)(stg + rr * 256 + (((4 * c4 + g) ^ rr) << 4) + 8 * hi) = v;
                    }
            }
            asm volatile("s_waitcnt lgkmcnt(0)" ::: "memory");
#pragma unroll
            for (int it = 0; it < 4; ++it) { const int row = it * 4 + (lane >> 4), ch = lane & 15;
                const u32x4 v = *(const LAS u32x4*)(stg + row * 256 + ((ch ^ row) << 4));
                if (!dry) *(u32x4*)(Qh + (size_t)(otok0 + ((rnd * 16 + row) << au.sh)) * HD + ch * 8) = v; }
            asm volatile("s_waitcnt lgkmcnt(0)" ::: "memory");
        }
    }
}
__device__ __forceinline__ void attn_phase(Frame& F, bool dry) {
    int unit = F.vcu;
    if (unit < BATCH * NH * 32) { const AttnUnit au = attn_decode(unit);
        attn_dma(F.lds, (const bf16_t*)(F.ws + WS_K) + (size_t)au.bh * SEQ * HD, au.U, au.seq_lo, au.seq_hi, au.sh, F.wave, F.lane); }
    for (; unit < BATCH * NH * 32; unit += F.G) attn_unit(F, unit, unit + F.G, dry);
    __syncthreads();
}

struct MixItem { float l[3]; u32x4 o[3], sg; };
__device__ __forceinline__ void attn_mix_load(MixItem& R, const unsigned char* ws, int pm, int slot, int part, int j) {
    const bf16_t* O = (const bf16_t*)(ws + WS_Q); const float* LSE = (const float*)(ws + WS_LSE); const bf16_t* SGA = (const bf16_t*)(ws + WS_SGA);
    const int it = part * 1024 + 512 * j + fresh(threadIdx.x), row = pm * 256 + (it >> 4), ch = it & 15, b = row >> 13, p = row & 8191;
#pragma unroll
    for (int g = 0; g < 3; ++g) { const int hh = 4 * g + slot;
        const size_t r = (size_t)(b * NH + hh) * SEQ + p; R.l[g] = LSE[r]; R.o[g] = *(const u32x4*)(O + r * HD + 8 * ch); }
    R.sg = *(const u32x4*)(SGA + (size_t)row * 512 + slot * 128 + 8 * ch);
}
__device__ __forceinline__ void attn_mix_finish(const MixItem& R, unsigned char* ws, int pm, int slot, int part, int j, bool dry) {
    bf16_t* SGA = (bf16_t*)(ws + WS_SGA);
    const int it = part * 1024 + 512 * j + fresh(threadIdx.x), row = pm * 256 + (it >> 4), ch = it & 15;
    const float mx = fmaxf(fmaxf(R.l[0], R.l[1]), R.l[2]);
    float w0 = __builtin_amdgcn_exp2f(R.l[0] - mx), w1 = __builtin_amdgcn_exp2f(R.l[1] - mx), w2 = __builtin_amdgcn_exp2f(R.l[2] - mx); const float inv = __builtin_amdgcn_rcpf(w0 + w1 + w2); w0 *= inv; w1 *= inv; w2 *= inv;
    u32x4 y;
#define MIXW(f) { const float lo = (w0 * bf_lo(R.o[0].f) + w1 * bf_lo(R.o[1].f) + w2 * bf_lo(R.o[2].f)) * bf_lo(R.sg.f); const float hi = (w0 * bf_hi(R.o[0].f) + w1 * bf_hi(R.o[1].f) + w2 * bf_hi(R.o[2].f)) * bf_hi(R.sg.f); y.f = cvt_pk_bf16(lo, hi); }
    MIXW(x) MIXW(y) MIXW(z) MIXW(w)
#undef MIXW
    if (!dry) *(u32x4*)(SGA + (size_t)row * 512 + slot * 128 + 8 * ch) = y;
}
__device__ __forceinline__ void attn_mix(unsigned char* ws, int pm, int slot, int part, bool dry) {
    MixItem R0, R1; attn_mix_load(R0, ws, pm, slot, part, 0); attn_mix_load(R1, ws, pm, slot, part, 1); attn_mix_finish(R0, ws, pm, slot, part, 0, dry); attn_mix_finish(R1, ws, pm, slot, part, 1, dry); }

__device__ __forceinline__ void lru_conv(Frame& F, int pm, int n, const float* conv_w, const float* conv_b) {
    const bf16_t* XL = (const bf16_t*)(F.ws + WS_XLRU); bf16_t* XC = (bf16_t*)(F.ws + WS_XB);
    const int tid = fresh(threadIdx.x), c0 = n * 256 + (tid & 31) * 8, r0 = pm * 256 + (tid >> 5) * 16, t0 = r0 & 8191;
    float w[4][8], b[8];
#pragma unroll
    for (int j = 0; j < 4; ++j) { const f32x4 w0 = *(const f32x4*)(conv_w + j * DM + c0), w1 = *(const f32x4*)(conv_w + j * DM + c0 + 4);
        w[j][0] = w0[0]; w[j][1] = w0[1]; w[j][2] = w0[2]; w[j][3] = w0[3]; w[j][4] = w1[0]; w[j][5] = w1[1]; w[j][6] = w1[2]; w[j][7] = w1[3]; }
    { const f32x4 b0 = *(const f32x4*)(conv_b + c0), b1 = *(const f32x4*)(conv_b + c0 + 4); b[0] = b0[0]; b[1] = b0[1]; b[2] = b0[2]; b[3] = b0[3]; b[4] = b1[0]; b[5] = b1[1]; b[6] = b1[2]; b[7] = b1[3]; }
    u32x4 xr[19];
#pragma unroll
    for (int i = 0; i < 19; ++i) { const int tt = t0 + i - 2;
        xr[i] = (tt >= 0 && tt < SEQ) ? *(const u32x4*)(XL + (size_t)(r0 + i - 2) * DM + c0) : (u32x4){0u, 0u, 0u, 0u}; }
#pragma unroll
    for (int i = 0; i < 16; ++i) {
        float a[8];
#pragma unroll
        for (int e = 0; e < 8; ++e) a[e] = b[e];
#pragma unroll
        for (int j = 0; j < 4; ++j) { const u32x4 xv = xr[i + j];
            a[0] += w[j][0] * bf_lo(xv.x); a[1] += w[j][1] * bf_hi(xv.x); a[2] += w[j][2] * bf_lo(xv.y); a[3] += w[j][3] * bf_hi(xv.y);
            a[4] += w[j][4] * bf_lo(xv.z); a[5] += w[j][5] * bf_hi(xv.z); a[6] += w[j][6] * bf_lo(xv.w); a[7] += w[j][7] * bf_hi(xv.w); }
        u32x4 o; o.x = cvt_pk_bf16(a[0], a[1]); o.y = cvt_pk_bf16(a[2], a[3]); o.z = cvt_pk_bf16(a[4], a[5]); o.w = cvt_pk_bf16(a[6], a[7]);
        *(u32x4*)(XC + (size_t)(r0 + i) * DM + c0) = o;
    }
}
#ifndef LRU_REP_P1
#define LRU_REP_P1 1
#endif
#ifndef LRU_REP_SWA
#define LRU_REP_SWA 1
#endif
#ifndef LRU_REP_FOLD
#define LRU_REP_FOLD 1
#endif
#ifndef LRU_REP_OUT
#define LRU_REP_OUT 1
#endif
#ifndef LRU_REP_MIX
#define LRU_REP_MIX 1
#endif
#ifndef LRU_REP_GEMM
#define LRU_REP_GEMM 1
#endif
#ifndef LRU_REP_CONV
#define LRU_REP_CONV 1
#endif
struct EpiNone { static constexpr bool PERM = false, AFTER_DRAIN = true;
    __device__ __forceinline__ void fused(f32x4 (&acc)[2][2][4][2], const pg8::Unit& u, int wr, int wc, int fr, int fq, LAS unsigned char* lds, int wid, int lane) const { asm volatile("" :: "v"(acc[0][0][0][0]), "v"(acc[1][1][3][1])); } };
struct EpiLru {
    static constexpr bool PERM = false, AFTER_DRAIN = true;
    const bf16_t* XC; const f32x4* LC;
    unsigned long long* TIL; unsigned* cnt; unsigned* tmo; const bf16_t* SGL; bf16_t* YL; unsigned char* ws; int n, qq; bool dry; const float* const* fin;
    __device__ __forceinline__ void fused(f32x4 (&acc)[2][2][4][2], const pg8::Unit& u, int wr, int wc, int fr, int fq, LAS unsigned char* lds, int wid, int lane) const {
        const int cu0 = 16 * wc + 4 * fq, ch0 = 256 * n + 64 * qq + cu0;
        u32x2 xw8[2][4];
#pragma unroll
        for (int ai = 0; ai < 2; ++ai)
#pragma unroll
            for (int m = 0; m < 4; ++m) xw8[ai][m] = *(const u32x2*)(XC + (size_t)(u.pm * 256 + ai * 128 + wr * 64 + m * 16 + fr) * DM + ch0);
#pragma unroll 1
        for (int rp1 = 0; rp1 < LRU_REP_P1; ++rp1)
#pragma unroll
        for (int d = 0; d < 2; ++d) {
            f32x4 lc[4];
#pragma unroll
            for (int e = 0; e < 4; ++e) lc[e] = LC[d * DM + ch0 + e];
#pragma unroll
            for (int ai = 0; ai < 2; ++ai)
#pragma unroll
                for (int m = 0; m < 4; ++m) {
                    const int rl = ai * 128 + wr * 64 + m * 16 + fr, row = u.pm * 256 + rl, t = row & 8191;
                    const u32x2 xw = xw8[ai][m];
                    const float xc[4] = {bf_lo(xw.x), bf_hi(xw.x), bf_lo(xw.y), bf_hi(xw.y)};
                    const bool first = (d == 0) ? (ai == 0 && m == 0 && t == 0) : (ai == 1 && m == 3 && t == SEQ - 1);
                    u32x4 w;
#pragma unroll
                    for (int e = 0; e < 4; ++e) {
                        const float r = __builtin_amdgcn_rcpf(1.0f + __builtin_amdgcn_exp2f(acc[ai][d][m][0][e] + lc[e][0]));
                        const float ig = __builtin_amdgcn_rcpf(1.0f + __builtin_amdgcn_exp2f(acc[ai][d][m][1][e] + lc[e][1]));
                        const float av = __builtin_amdgcn_exp2f(r * lc[e][2]);
                        const float mult = first ? 1.0f : __builtin_amdgcn_sqrtf(1.0f - av * av);
                        w[e] = cvt_pk_bf16(1.0f - av, mult * ig * xc[e]);
                    }
                    *(LAS u32x4*)(lds + rl * LRU_PITCH + d * 256 + cu0 * 4) = w;
                }
        }
        LDS_WAIT(); __builtin_amdgcn_s_barrier(); asm volatile("" ::: "memory");
        const int tid = wid * 64 + lane, seg = tid >> 7, dir = (tid >> 6) & 1, cu = tid & 63;
        {   LAS unsigned char* pp = lds + dir * 256 + cu * 4 + (dir ? (seg * 64 + 63) : seg * 64) * LRU_PITCH;
            const int rstep = dir ? -LRU_PITCH : LRU_PITCH;
            float P = 1.0f, H = 0.0f;
#pragma unroll 1
            for (int rsa = 0; rsa < LRU_REP_SWA; ++rsa) { P = 1.0f; H = 0.0f; LAS unsigned char* p2 = pp;
#pragma unroll 8
              for (int i = 0; i < 64; ++i) { const unsigned w = *(LAS unsigned*)p2; const float a = 1.0f - bf_lo(w); H = a * H + bf_hi(w); P *= a;
                  if (rsa + 1 == LRU_REP_SWA) *(LAS unsigned*)p2 = cvt_pk_bf16(H, P); p2 += rstep; } }
            ((LAS f32x2*)(lds + LRU_XCH))[(dir * 4 + seg) * 64 + cu] = (f32x2){P, H};
        }
        LDS_WAIT(); __builtin_amdgcn_s_barrier(); asm volatile("" ::: "memory");
        LAS f32x2* xch = (LAS f32x2*)(lds + LRU_XCH);
        const size_t tslot = (size_t)(n * 4 + qq) * 128 + dir * 64 + cu;
        if (seg == 0) {
            float Pt = 1.0f, Ht = 0.0f;
#pragma unroll
            for (int s = 0; s < 4; ++s) { const f32x2 v = xch[(dir * 4 + (dir ? 3 - s : s)) * 64 + cu]; Ht = v.x * Ht + v.y; Pt *= v.x; }
            __hip_atomic_store(TIL + (size_t)u.pm * 2048 + tslot, ((unsigned long long)__float_as_uint(Ht) << 32) | __float_as_uint(Pt), __ATOMIC_RELAXED, __HIP_MEMORY_SCOPE_AGENT);
        }
        if (seg == 0) { asm volatile("s_waitcnt vmcnt(0)" ::: "memory");
            if (lane == 0) __hip_atomic_fetch_add(cnt, 1u, __ATOMIC_RELAXED, __HIP_MEMORY_SCOPE_AGENT); }
        if (fin) {
            const int uidx = (u.pm * 4 + n) * 4 + qq;
            int item = -1;
            if (wid >= 2) item = uidx * 6 + (wid - 2); else if (wid == 0 && uidx < P1_MINI - 6144) item = 6144 + uidx;
            if (item >= 0) p0_layer1_mini(fin, ws, item, lane);
        }
        for (int rmx = 1; rmx < LRU_REP_MIX; ++rmx) attn_mix(ws, u.pm, n, qq, true);
        attn_mix(ws, u.pm, n, qq, dry);
        if (seg == 0) {
            unsigned sp = 0;
            while ((unsigned)__builtin_amdgcn_readfirstlane(__hip_atomic_load(cnt, __ATOMIC_RELAXED, __HIP_MEMORY_SCOPE_AGENT)) < 64u) {
                __builtin_amdgcn_s_sleep(1);
                if ((++sp & 1023u) == 0u) { if (__hip_atomic_load(tmo, __ATOMIC_RELAXED, __HIP_MEMORY_SCOPE_AGENT) != 0u) break; if (sp > (1u << 22)) { if (lane == 0) __hip_atomic_store(tmo, 1u, __ATOMIC_RELAXED, __HIP_MEMORY_SCOPE_AGENT); break; } }
            }
            asm volatile("" ::: "memory");
            float h = 0.0f;
#pragma unroll 1
            for (int rfo = 0; rfo < LRU_REP_FOLD; ++rfo)
            {   h = 0.0f; const int pb = u.pm & ~31;
                unsigned long long tv[31];
#pragma unroll
                for (int k = 0; k < 31; ++k) {
                    const int q = dir ? (pb + 31 - k) : (pb + k); const bool use = dir ? (q > u.pm) : (q < u.pm);
                    tv[k] = use ? __hip_atomic_load(TIL + (size_t)q * 2048 + tslot, __ATOMIC_RELAXED, __HIP_MEMORY_SCOPE_AGENT) : 0x000000003f800000ull;
                }
#pragma unroll
                for (int k = 0; k < 31; ++k) h = __uint_as_float((unsigned)tv[k]) * h + __uint_as_float((unsigned)(tv[k] >> 32));
            }
            LAS float* hin = (LAS float*)(lds + LRU_XCH + 4096);
#pragma unroll
            for (int s = 0; s < 4; ++s) { const int sg2 = dir ? 3 - s : s; hin[(dir * 4 + sg2) * 64 + cu] = h; const f32x2 v = xch[(dir * 4 + sg2) * 64 + cu]; h = v.x * h + v.y; }
        }
        LDS_WAIT(); __builtin_amdgcn_s_barrier(); asm volatile("" ::: "memory");
        const int qd = tid & 15, rg = tid >> 4;
#pragma unroll 1
        for (int rou = 0; rou < LRU_REP_OUT; ++rou)
#pragma unroll 4
        for (int i = 0; i < 8; ++i) {
            const int rl = i * 32 + rg, row = u.pm * 256 + rl, sgm = rl >> 6;
            const u32x4 wf = *(const LAS u32x4*)(lds + rl * LRU_PITCH + qd * 16), wb = *(const LAS u32x4*)(lds + rl * LRU_PITCH + 256 + qd * 16);
            const f32x4 cf = *(const LAS f32x4*)(lds + LRU_XCH + 4096 + ((0 * 4 + sgm) * 64 + 4 * qd) * 4), cb = *(const LAS f32x4*)(lds + LRU_XCH + 4096 + ((1 * 4 + sgm) * 64 + 4 * qd) * 4);
            const size_t off = (size_t)row * DM + 256 * n + 64 * qq + 4 * qd;
            const u32x2 sg = *(const u32x2*)(SGL + off);
            float hh[4];
#pragma unroll
            for (int e = 0; e < 4; ++e) hh[e] = (bf_lo(wf[e]) + bf_hi(wf[e]) * cf[e]) + (bf_lo(wb[e]) + bf_hi(wb[e]) * cb[e]);
            u32x2 y; y.x = cvt_pk_bf16(hh[0] * bf_lo(sg.x), hh[1] * bf_hi(sg.x)); y.y = cvt_pk_bf16(hh[2] * bf_lo(sg.y), hh[3] * bf_hi(sg.y));
            if (!dry) *(u32x2*)(YL + off) = y;
        }
        LDS_WAIT(); __builtin_amdgcn_s_barrier(); asm volatile("" ::: "memory");
    }
};


template <int CTRL> __device__ __forceinline__ float dpp_zero(float v) { return __int_as_float(__builtin_amdgcn_update_dpp(0, __float_as_int(v), CTRL, 0xf, 0xf, true)); }
#define LRU_SCAN_STEP(SH) { const float bs_ = dpp_zero<SH>(Bt), am_ = dpp_zero<SH>(At - 1.0f); Bt = __builtin_fmaf(At, bs_, Bt); At = __builtin_fmaf(At, am_, At); }
struct EpiLruReg {
    static constexpr bool PERM = false, AFTER_DRAIN = false, APERM = true;
    LAS unsigned char* lds; const bf16_t* XC; const f32x4* LC;
    unsigned long long* TIL; unsigned* cnt0; unsigned* tmo; const bf16_t* SGL; bf16_t* YL; unsigned char* ws; int n; const float* const* fin;
    __device__ __forceinline__ void operator()(f32x4 (&acc)[2][2][4][2], const pg8::Unit& u, int wr, int wc, int fr, int fq) const {
        const int qq = u.pn, wid = wr * 4 + wc, lane = fq * 16 + fr;
        const int cu0 = 16 * wc + 4 * fq, ch0 = 256 * n + 64 * qq + cu0;
        unsigned* cnt = cnt0 + qq * 64;
        const size_t off0 = (size_t)(u.pm * 256 + wr * 64 + 4 * fr) * DM + ch0;
        u32x2 xw8[2][4], sg8[2][4];
#pragma unroll
        for (int ai = 0; ai < 2; ++ai)
#pragma unroll
            for (int m = 0; m < 4; ++m) xw8[ai][m] = *(const u32x2*)(XC + off0 + (size_t)(ai * 128 + m) * DM);
        MixItem M0, M1; attn_mix_load(M0, ws, u.pm, n, qq, 0); attn_mix_load(M1, ws, u.pm, n, qq, 1);
        LAS f32x2* xch = (LAS f32x2*)(lds + LRU_XCH);
        LAS f32x2* xtot = xch; const int dummy = 768 + wid * 64 + lane;
#pragma unroll
        for (int d = 0; d < 2; ++d) {
            asm volatile("" ::: "memory");
            f32x3 lc[4];
#pragma unroll
            for (int e = 0; e < 4; ++e) { const float* lp = (const float*)(LC + d * DM + ch0 + e); const f32x2 v = *(const f32x2*)lp; lc[e][0] = v.x; lc[e][1] = v.y; lc[e][2] = lp[2]; }
#pragma unroll
            for (int ai = 0; ai < 2; ++ai) {
#pragma unroll
                for (int m = 0; m < 4; ++m) {
                    const int t = (u.pm * 256 + ai * 128 + wr * 64 + 4 * fr + m) & 8191;
                    const bool first = (d == 0) ? (ai == 0 && m == 0 && t == 0) : (ai == 1 && m == 3 && t == SEQ - 1);
                    u32x2 xw = xw8[ai][m]; asm volatile("" : "+v"(xw.x), "+v"(xw.y));
                    const float xc[4] = {bf_lo(xw.x), bf_hi(xw.x), bf_lo(xw.y), bf_hi(xw.y)};
#pragma unroll
                    for (int e = 0; e < 4; ++e) {
                        const float r = __builtin_amdgcn_rcpf(1.0f + __builtin_amdgcn_exp2f(acc[ai][d][m][0][e] + lc[e][0]));
                        const float ig = __builtin_amdgcn_rcpf(1.0f + __builtin_amdgcn_exp2f(acc[ai][d][m][1][e] + lc[e][1]));
                        const float av = __builtin_amdgcn_exp2f(r * lc[e][2]);
                        const float mult = first ? 1.0f : __builtin_amdgcn_sqrtf(1.0f - av * av);
                        acc[ai][d][m][0][e] = av; acc[ai][d][m][1][e] = mult * ig * xc[e];
                    }
                }
#pragma unroll
                for (int e = 0; e < 4; ++e) {
                    if (d == 0) {
#pragma unroll
                        for (int m = 1; m < 4; ++m) { acc[ai][d][m][1][e] = __builtin_fmaf(acc[ai][d][m][0][e], acc[ai][d][m - 1][1][e], acc[ai][d][m][1][e]); acc[ai][d][m][0][e] *= acc[ai][d][m - 1][0][e]; }
                    } else {
#pragma unroll
                        for (int m = 2; m >= 0; --m) { acc[ai][d][m][1][e] = __builtin_fmaf(acc[ai][d][m][0][e], acc[ai][d][m + 1][1][e], acc[ai][d][m][1][e]); acc[ai][d][m][0][e] *= acc[ai][d][m + 1][0][e]; }
                    }
                    float At = acc[ai][d][d ? 0 : 3][0][e], Bt = acc[ai][d][d ? 0 : 3][1][e];
                    float Ae, Be;
                    if (d == 0) { LRU_SCAN_STEP(0x111) LRU_SCAN_STEP(0x112) LRU_SCAN_STEP(0x114) LRU_SCAN_STEP(0x118) Be = dpp_zero<0x111>(Bt); Ae = 1.0f + dpp_zero<0x111>(At - 1.0f); }
                    else        { LRU_SCAN_STEP(0x101) LRU_SCAN_STEP(0x102) LRU_SCAN_STEP(0x104) LRU_SCAN_STEP(0x108) Be = dpp_zero<0x101>(Bt); Ae = 1.0f + dpp_zero<0x101>(At - 1.0f); }
#pragma unroll
                    for (int m = 0; m < 4; ++m) { acc[ai][d][m][1][e] = __builtin_fmaf(acc[ai][d][m][0][e], Be, acc[ai][d][m][1][e]); acc[ai][d][m][0][e] *= Ae; }
                    xtot[(fr == (d ? 0 : 15)) ? ((d * 4 + 2 * ai + wr) * 64 + cu0 + e) : dummy] = (f32x2){At, Bt};
                }
                __builtin_amdgcn_sched_barrier(0);
            }
            if (d == 0) {
#pragma unroll
                for (int ai = 0; ai < 2; ++ai)
#pragma unroll
                    for (int m = 0; m < 4; ++m) {
                        unsigned p0 = cvt_pk_bf16(acc[ai][0][m][0][0], acc[ai][0][m][0][1]), p1 = cvt_pk_bf16(acc[ai][0][m][0][2], acc[ai][0][m][0][3]);
                        asm volatile("" : "+v"(p0), "+v"(p1));
                        acc[ai][0][m][0][0] = __uint_as_float(p0); acc[ai][0][m][0][1] = __uint_as_float(p1);
                    }
            }
        }
#pragma unroll
        for (int ai = 0; ai < 2; ++ai)
#pragma unroll
            for (int m = 0; m < 4; ++m) {
                unsigned p0 = cvt_pk_bf16(acc[ai][1][m][0][0], acc[ai][1][m][0][1]), p1 = cvt_pk_bf16(acc[ai][1][m][0][2], acc[ai][1][m][0][3]);
                asm volatile("" : "+v"(p0), "+v"(p1));
                acc[ai][0][m][0][2] = __uint_as_float(p0); acc[ai][0][m][0][3] = __uint_as_float(p1);
#pragma unroll
                for (int e = 0; e < 4; ++e) { float S = acc[ai][0][m][1][e] + acc[ai][1][m][1][e]; asm volatile("" : "+v"(S)); acc[ai][0][m][1][e] = S; }
            }
        LDS_WAIT(); __builtin_amdgcn_s_barrier(); asm volatile("" ::: "memory");
        const int tid = wid * 64 + lane, seg = tid >> 7, dir = (tid >> 6) & 1, cu = tid & 63;
        const size_t tslot = (size_t)(n * 4 + qq) * 128 + dir * 64 + cu;
        if (seg == 0) {
            float Pt = 1.0f, Ht = 0.0f;
#pragma unroll
            for (int s = 0; s < 4; ++s) { const f32x2 v = xch[(dir * 4 + (dir ? 3 - s : s)) * 64 + cu]; Ht = v.x * Ht + v.y; Pt *= v.x; }
            __hip_atomic_store(TIL + (size_t)u.pm * 2048 + tslot, ((unsigned long long)__float_as_uint(Ht) << 32) | __float_as_uint(Pt), __ATOMIC_RELAXED, __HIP_MEMORY_SCOPE_AGENT);
        }
        if (seg == 0) { asm volatile("s_waitcnt vmcnt(0)" ::: "memory");
            if (lane == 0) __hip_atomic_fetch_add(cnt, 1u, __ATOMIC_RELAXED, __HIP_MEMORY_SCOPE_AGENT); }
        if (fin) {
            const int uidx = (u.pm * 4 + n) * 4 + qq;
            int item = -1;
            if (wid >= 2) item = uidx * 6 + (wid - 2); else if (wid == 0 && uidx < P1_MINI - 6144) item = 6144 + uidx;
            if (item >= 0) p0_layer1_mini(fin, ws, item, lane);
        }
        attn_mix_finish(M0, ws, u.pm, n, qq, 0, false); attn_mix_finish(M1, ws, u.pm, n, qq, 1, false);
#pragma unroll
        for (int ai = 0; ai < 2; ++ai)
#pragma unroll
            for (int m = 0; m < 4; ++m) sg8[ai][m] = *(const u32x2*)(SGL + off0 + (size_t)(ai * 128 + m) * DM);
        if (seg == 0) {
            unsigned sp = 0;
            while ((unsigned)__builtin_amdgcn_readfirstlane(__hip_atomic_load(cnt, __ATOMIC_RELAXED, __HIP_MEMORY_SCOPE_AGENT)) < 64u) {
                __builtin_amdgcn_s_sleep(1);
                if ((++sp & 1023u) == 0u) { if (__hip_atomic_load(tmo, __ATOMIC_RELAXED, __HIP_MEMORY_SCOPE_AGENT) != 0u) break; if (sp > (1u << 22)) { if (lane == 0) __hip_atomic_store(tmo, 1u, __ATOMIC_RELAXED, __HIP_MEMORY_SCOPE_AGENT); break; } }
            }
            asm volatile("" ::: "memory");
            float h = 0.0f;
            {   const int pb = u.pm & ~31;
#pragma unroll
                for (int hb = 0; hb < 2; ++hb) {
                    unsigned long long tv[16];
#pragma unroll
                    for (int k = 0; k < 16; ++k) {
                        const int kk = hb * 16 + k, q = dir ? (pb + 31 - kk) : (pb + kk); const bool use = (kk < 31) && (dir ? (q > u.pm) : (q < u.pm));
                        tv[k] = use ? __hip_atomic_load(TIL + (size_t)q * 2048 + tslot, __ATOMIC_RELAXED, __HIP_MEMORY_SCOPE_AGENT) : 0x000000003f800000ull;
                    }
#pragma unroll
                    for (int k = 0; k < 16; ++k) h = __uint_as_float((unsigned)tv[k]) * h + __uint_as_float((unsigned)(tv[k] >> 32));
                    asm volatile("" ::: "memory");
                }
            }
            LAS float* hin = (LAS float*)(lds + LRU_XCH + 4096);
#pragma unroll
            for (int s = 0; s < 4; ++s) { const int sg2 = dir ? 3 - s : s; hin[(dir * 4 + sg2) * 64 + cu] = h; const f32x2 v = xch[(dir * 4 + sg2) * 64 + cu]; h = v.x * h + v.y; }
        }
        LDS_WAIT(); __builtin_amdgcn_s_barrier(); asm volatile("" ::: "memory");
#pragma unroll
        for (int ai = 0; ai < 2; ++ai) {
            const f32x4 cf = *(const LAS f32x4*)(lds + LRU_XCH + 4096 + ((0 * 4 + 2 * ai + wr) * 64 + cu0) * 4), cb = *(const LAS f32x4*)(lds + LRU_XCH + 4096 + ((1 * 4 + 2 * ai + wr) * 64 + cu0) * 4);
#pragma unroll
            for (int m = 0; m < 4; ++m) {
                float hh[4];
#pragma unroll
                for (int e = 0; e < 4; ++e) { const unsigned pf = __float_as_uint(acc[ai][0][m][0][e >> 1]), pb = __float_as_uint(acc[ai][0][m][0][2 + (e >> 1)]);
                    hh[e] = __builtin_fmaf((e & 1) ? bf_hi(pb) : bf_lo(pb), cb[e], __builtin_fmaf((e & 1) ? bf_hi(pf) : bf_lo(pf), cf[e], acc[ai][0][m][1][e])); }
                const u32x2 sg = sg8[ai][m];
                u32x2 y; y.x = cvt_pk_bf16(hh[0] * bf_lo(sg.x), hh[1] * bf_hi(sg.x)); y.y = cvt_pk_bf16(hh[2] * bf_lo(sg.y), hh[3] * bf_hi(sg.y));
                *(u32x2*)(YL + off0 + (size_t)(ai * 128 + m) * DM) = y;
            }
        }
    }
};

__device__ __forceinline__ void final_norm(Frame& F, float* out, const float* ss, const float* g, bool dry) {
    const int gw = F.vcu * 8 + F.wave, NGW = F.G * 8;
    f32x4 gv[4];
#pragma unroll
    for (int j = 0; j < 4; ++j) gv[j] = ((const f32x4*)g)[F.lane + 64 * j];
    for (int m = gw; m < M; m += NGW) {
        const float rstd = __builtin_amdgcn_rsqf(ss[m] * (1.0f / DM) + NORM_EPS);
        f32x4* xr = (f32x4*)(out + (size_t)m * DM) + F.lane;
#pragma unroll
        for (int j = 0; j < 4; ++j) { const f32x4 v = xr[64 * j]; if (!dry) xr[64 * j] = v * rstd * gv[j]; }
    }
}

constexpr int N_PHASES = 13;
__global__ void __launch_bounds__(512, 2) hybrid_fwd(Args args) {
    extern __shared__ __attribute__((aligned(16))) unsigned char lds_raw[];
    Frame F;
    F.lds = (LAS unsigned char*)lds_raw;
    F.tid = threadIdx.x; F.lane = F.tid & 63; F.wave = __builtin_amdgcn_readfirstlane(F.tid >> 6);
    F.G = gridDim.x; { const int bx = blockIdx.x; F.vcu = (F.G % 8 == 0) ? (bx % 8) * (F.G / 8) + bx / 8 : bx; }
    F.ws = args.ws; F.ctl = (unsigned*)(args.ws + WS_CTL);
    volatile LAS unsigned* MISC = (volatile LAS unsigned*)(F.lds + LDSCTL_OFF);
    if (F.tid < 64) MISC[F.tid] = 0u;
    __syncthreads();
    XcdBarrier bar; bar.bar = F.ctl + CW_BAR; bar.x = 0; bar.st = nullptr;
    if (MK_N_LAUNCHES == 1) bar = xcd_barrier_post(F.ctl + CW_BAR, MISC + 8);
    if (F.tid == 0) __hip_atomic_store(F.ctl + CW_XTAB + F.vcu, xb_xcc_id() + 1u, __ATOMIC_RELAXED, __HIP_MEMORY_SCOPE_AGENT);
    bf16_t* Wb = (bf16_t*)(F.ws + WS_W);
    float* ss = (float*)(F.ctl + CW_SS);

#ifndef PHMASK
#define PHMASK 0x3ff
#endif
#ifndef REPEAT_PH
#define REPEAT_PH -1
#endif
#ifndef REPEAT_N
#define REPEAT_N 2
#endif
#ifdef TS_PROBE
    volatile LAS unsigned long long* TS = (volatile LAS unsigned long long*)(F.lds + LDSCTL_OFF + 256);
    int nts = 0;
#define TSTAMP() do { if (blockIdx.x == 0 && threadIdx.x == 0) TS[nts] = __builtin_amdgcn_s_memrealtime(); ++nts; } while (0)
    TSTAMP();
#else
#define TSTAMP() do {} while (0)
#endif
    for (int ph = args.ph_lo; ph < args.ph_hi; ++ph) {
#if REPEAT_PH >= 0
      const int reps = (ph == REPEAT_PH) ? REPEAT_N : 1;
      for (int rep = 0; rep < reps; ++rep) {
        const bool dry = (rep + 1 < reps);
        if (rep > 0) xcd_barrier(bar);
#else
      {
        constexpr bool dry = false;
#endif
        { int tv = threadIdx.x; asm volatile("" : "+v"(tv)); F.tid = tv; F.lane = tv & 63; F.wave = __builtin_amdgcn_readfirstlane(tv >> 6); }
        if (ph == 0) { if (PHMASK & 1) p0_prologue(F, args); }
        else {
            const int l = (ph - 1) / 6; int sub = (ph - 1) % 6; if (sub >= 4) ++sub;
            const bf16_t* XB = (const bf16_t*)(F.ws + WS_XB);
            if (sub == 0 && (PHMASK & 4)) {
                pg8::Gemm g{XB, Wb + W_IN_T / 2 + (size_t)l * NIN * DM, DM, DM, DM};
                pg8::StaticOrder S; S.init(M, NCOL_A, F.G, (int)blockIdx.x, DM, DM);
#ifdef STAGGER_TICKS
                if ((blockIdx.x >> 3) & 1) { const unsigned long long t0 = __builtin_amdgcn_s_memrealtime(); while (__builtin_amdgcn_s_memrealtime() - t0 < STAGGER_TICKS) __builtin_amdgcn_s_sleep(8); }
#endif
                EpiProjA E{F.ws, dry};
                pg8::gemm_phase(fresh(threadIdx.x), F.lds, g, S, E);
            } else if (sub == 1 && (PHMASK & 8)) {
                attn_phase(F, dry);
            } else if (sub == 2 && (PHMASK & 16)) {
                pg8::Gemm g{XB, Wb + W_IN_T / 2 + ((size_t)l * NIN + NCOL_A) * DM, DM, DM, DM};
                pg8::StaticOrder S; S.init(M, NCOL_B, F.G, (int)blockIdx.x, DM, DM);
#ifdef STAGGER_TICKS
                if ((blockIdx.x >> 3) & 1) { const unsigned long long t0 = __builtin_amdgcn_s_memrealtime(); while (__builtin_amdgcn_s_memrealtime() - t0 < STAGGER_TICKS) __builtin_amdgcn_s_sleep(8); }
#endif
                EpiProjB E{F.ws, args.in[3] + l * 2048};
                pg8::gemm_phase(fresh(threadIdx.x), F.lds, g, S, E);
            } else if (sub == 3 && (PHMASK & 32)) {
                for (int task = F.vcu; task < 256; task += F.G) {
                    const int pm = task >> 2, n = task & 3;
                    for (int rcv = 0; rcv < LRU_REP_CONV; ++rcv) lru_conv(F, pm, n, args.in[4] + l * 4 * DM, args.in[5] + l * DM);
                    VM_WAIT(); __syncthreads();
                    {   pg8::Gemm g{XB, Wb + W_RG_T / 2, DM, 256, 256};
                        pg8::QuadUnit S; S.u0.pm = pm; S.u0.pn = 0; S.u0.abyte = (pm * 256 * DM + n * 256) * 2; S.u0.bbyte = ((l * 4 + n) * 4) * 65536 * 2; S.bstep = 65536 * 2;
                        EpiLruReg E{F.lds, XB, (const f32x4*)(F.ws + WS_LC) + l * 2048, (unsigned long long*)(F.ws + WS_TIL + (size_t)l * MiB),
                                    F.ctl + CW_CNT + (((l * 2 + (pm >> 5)) * 4 + n) * 4) * 64, F.ctl + CW_TMO, (const bf16_t*)(F.ws + WS_SGL), (bf16_t*)(F.ws + WS_XLRU), F.ws, n, (l == 0 && F.G == 256) ? args.in : nullptr};
                        pg8::gemm_phase(fresh(threadIdx.x), F.lds, g, S, E);
                    }
                }
            } else if (sub == 5 && (PHMASK & 128)) {
                pg8::Gemm2 g{(const bf16_t*)(F.ws + WS_SGA), Wb + W_OATT_T / 2 + (size_t)l * DM * 512, 512, 512, 512,
                             (const bf16_t*)(F.ws + WS_XLRU), Wb + W_OLRU_T / 2 + (size_t)l * DM * DM, DM, DM, DM};
                pg8::StaticOrder S; S.init(M, DM, F.G, (int)blockIdx.x, DM, DM);
                EpiMerge2 E{(bf16_t*)(F.ws + WS_SGL), (const bf16_t*)(F.ws + WS_GATE)};
                pg8::gemm_phase2(fresh(threadIdx.x), F.lds, g, S, E);
            } else if (sub == 6 && (PHMASK & 256)) {
                pg8::Gemm g{(const bf16_t*)(F.ws + WS_SGL), Wb + W_OUT_T / 2 + (size_t)l * DM * DM, DM, DM, DM};
                pg8::StaticOrder S; S.init(M, DM, F.G, (int)blockIdx.x, DM, DM);
                if (l + 1 < DEPTH) { EpiResidNorm<false, false> E{l == 0 ? args.in[0] : args.out, args.out, (bf16_t*)(F.ws + WS_XB), ss + (l + 1) * M, args.in[14], F.ctl + CW_PAN + l * 4096, F.ctl + CW_TMO}; pg8::gemm_phase(fresh(threadIdx.x), F.lds, g, S, E); }
                else { EpiResidNorm<true, true> E{l == 0 ? args.in[0] : args.out, args.out, (bf16_t*)(F.ws + WS_XB), ss + (l + 1) * M, args.in[14], F.ctl + CW_PAN + l * 4096, F.ctl + CW_TMO}; pg8::gemm_phase(fresh(threadIdx.x), F.lds, g, S, E); }
            }
        }
      }
        TSTAMP();
        if (ph + 1 < args.ph_hi) {
            const int subp = (ph == 0) ? -1 : (ph - 1) % 6;
            const bool fast_seams = MISC[10] != 0u;
            if (fast_seams && (subp == 3 || subp == 4)) { const unsigned gen = MISC[11] + 1u; __syncthreads(); if (F.tid == 0) MISC[11] = gen; group_barrier(F.ctl + CW_GBAR + (F.vcu >> 5) * 64, 32u * gen, F.ctl + CW_TMO); }
            else xcd_barrier(bar);
            if (ph == 0 && F.G == 256) {
#ifndef NO_FAST_SEAMS
                const int t = F.tid & 255;
                const unsigned mine = __hip_atomic_load(F.ctl + CW_XTAB + t, __ATOMIC_RELAXED, __HIP_MEMORY_SCOPE_AGENT), ref = __hip_atomic_load(F.ctl + CW_XTAB + (t & ~31), __ATOMIC_RELAXED, __HIP_MEMORY_SCOPE_AGENT);
                if ((mine != ref) || (mine == 0u)) MISC[12] = 1u;
                __syncthreads();
                if (F.tid == 0) MISC[10] = (MISC[12] == 0u) ? 1u : 0u;
                __syncthreads();
#endif
            }
        }
        TSTAMP();
        if (REPEAT_PH == 100 && ph == 1) { xcd_barrier(bar); xcd_barrier(bar); xcd_barrier(bar); xcd_barrier(bar); xcd_barrier(bar); xcd_barrier(bar); xcd_barrier(bar); xcd_barrier(bar); }
    }
#ifdef TS_PROBE
    if (blockIdx.x == 0 && threadIdx.x == 0) {
        const unsigned long long dt = TS[TS_PROBE + 1] - TS[TS_PROBE], t0 = __builtin_amdgcn_s_memrealtime();
        while (__builtin_amdgcn_s_memrealtime() - t0 < 16ull * dt) __builtin_amdgcn_s_sleep(4);
    }
#endif
}

extern "C" void kernel_launch(void* const* d_in, const int* in_sizes, int n_in, void* d_out, int out_size, void* d_ws, size_t ws_size, hipStream_t stream) {
    static int grid = 0;
    if (grid == 0) {
        if (n_in != 15 || in_sizes[0] != M * DM || out_size != M * DM || ws_size < WS_END) { fprintf(stderr, "kernel_launch: unexpected shapes / workspace (%d inputs, ws %zu < %zu)\n", n_in, ws_size, (size_t)WS_END); grid = -1; return; }
        int dev = 0, cus = 0, per_cu = 0;
        if (hipGetDevice(&dev) != hipSuccess || hipDeviceGetAttribute(&cus, hipDeviceAttributeMultiprocessorCount, dev) != hipSuccess) { grid = -1; return; }
        if (hipFuncSetAttribute((const void*)hybrid_fwd, hipFuncAttributeMaxDynamicSharedMemorySize, LDS_BYTES) != hipSuccess) { fprintf(stderr, "kernel_launch: hipFuncSetAttribute failed\n"); grid = -1; return; }
        if (hipOccupancyMaxActiveBlocksPerMultiprocessor(&per_cu, (const void*)hybrid_fwd, 512, LDS_BYTES) != hipSuccess || per_cu < 1) { fprintf(stderr, "kernel_launch: occupancy query says %d\n", per_cu); grid = -1; return; }
        (void)hipGetLastError();
        grid = cus;
    }
    if (grid < 0) return;
    (void)hipMemsetAsync((char*)d_ws + WS_CTL, 0, CTL_ZERO_BYTES, stream);
    Args a{};
    for (int i = 0; i < 15; ++i) a.in[i] = (const float*)d_in[i];
    a.out = (float*)d_out; a.ws = (unsigned char*)d_ws;
    if (MK_N_LAUNCHES == 1) { a.ph_lo = 0; a.ph_hi = N_PHASES; a.li = 0; hipLaunchKernelGGL(hybrid_fwd, dim3(grid), dim3(512), LDS_BYTES, stream, a); }
    else for (int ph = 0; ph < N_PHASES; ++ph) { a.ph_lo = ph; a.ph_hi = ph + 1; a.li = ph; hipLaunchKernelGGL(hybrid_fwd, dim3(grid), dim3(512), LDS_BYTES, stream, a); }
}
```

```cpp
#include <hip/hip_runtime.h>
#include <cstdio>
#include <cstdint>

#ifndef MK_N_LAUNCHES
#define MK_N_LAUNCHES 1
#endif

#define LAS __attribute__((address_space(3)))
#define GAS __attribute__((address_space(1)))
typedef unsigned short bf16_t;
typedef short bf16x8 __attribute__((ext_vector_type(8)));
typedef float f32x4 __attribute__((ext_vector_type(4)));
typedef double f64x2 __attribute__((ext_vector_type(2)));
typedef float f32x3 __attribute__((ext_vector_type(3)));
typedef float f32x2 __attribute__((ext_vector_type(2)));
typedef unsigned u32x4 __attribute__((ext_vector_type(4)));
typedef unsigned u32x2 __attribute__((ext_vector_type(2)));

constexpr int BATCH = 2, SEQ = 8192, DM = 1024, M = BATCH * SEQ, DEPTH = 2;
constexpr int NIN = 9216, NH = 12, HD = 128;
constexpr int NCOL_A = 5120, NCOL_B = 4096;
constexpr float LOG2E = 1.4426950408889634f;
constexpr float QSCALE = 0.08838834764831845f * LOG2E;
constexpr float NORM_EPS = 1e-6f;

constexpr size_t MiB = 1u << 20;
constexpr size_t WS_CTL = 0, CTL_ZERO_BYTES = 1 * MiB;
constexpr size_t WS_LSE = 1 * MiB;
constexpr size_t WS_LC  = 4 * MiB;
constexpr size_t WS_TIL = 2 * MiB;
constexpr size_t WS_W   = 8 * MiB;
constexpr size_t W_IN_T = 0;
constexpr size_t W_OATT_T = W_IN_T + (size_t)2 * NIN * DM * 2;
constexpr size_t W_OLRU_T = W_OATT_T + (size_t)2 * DM * 512 * 2;
constexpr size_t W_OUT_T  = W_OLRU_T + (size_t)2 * DM * DM * 2;
constexpr size_t W_RG_T   = W_OUT_T + (size_t)2 * DM * DM * 2;
constexpr size_t W_END    = W_RG_T + (size_t)2 * 16 * 65536 * 2;
static_assert(W_END == 50 * MiB, "weight map");
constexpr size_t WS_XB  = 58 * MiB;
constexpr size_t WS_Q   = 90 * MiB;
constexpr size_t WS_K   = 138 * MiB;
constexpr size_t WS_V   = 186 * MiB;
constexpr size_t WS_XLRU = 234 * MiB;
constexpr size_t WS_GATE = WS_K;
constexpr size_t WS_MG   = 202 * MiB;
constexpr size_t OUT_SGL_BYTES = 32 * MiB;
constexpr size_t WS_SGA  = 266 * MiB;
constexpr size_t WS_END  = 282 * MiB;
static_assert(WS_V - WS_K == WS_K - WS_Q, "q/k/v spacing");
constexpr int CW_BAR = 4096;
constexpr int CW_TMO = 0;
constexpr int CW_PAN = 24576;
constexpr int CW_CNT = 16384;
constexpr int CW_XTAB = 32768;
constexpr int CW_GBAR = 33024;
constexpr int CW_SS = 65536;
static_assert((CW_SS + 3 * M) * 4 <= (int)CTL_ZERO_BYTES, "ctl");

constexpr int RING_BYTES = 131072;
constexpr int LRU_XCH = 135168;
constexpr int LDSCTL_OFF = 147456;
constexpr int LDS_BYTES = 148480;
static_assert(LRU_XCH + 4096 + 2048 + 4096 <= LDSCTL_OFF, "lds");

#define RLX_AGENT __ATOMIC_RELAXED, __HIP_MEMORY_SCOPE_AGENT
#define LDS_WAIT() asm volatile("s_waitcnt lgkmcnt(0)" ::: "memory")
#define VM_WAIT() asm volatile("s_waitcnt vmcnt(0)" ::: "memory")

__device__ __forceinline__ unsigned cvt_pk_bf16(float lo, float hi) { unsigned r; asm volatile("v_cvt_pk_bf16_f32 %0, %1, %2" : "=v"(r) : "v"(lo), "v"(hi)); return r; }
__device__ __forceinline__ float bf_lo(unsigned w) { return __uint_as_float(w << 16); }
__device__ __forceinline__ float bf_hi(unsigned w) { return __uint_as_float(w & 0xffff0000u); }
__device__ __forceinline__ float fast_sigmoid(float v) { return __builtin_amdgcn_rcpf(1.0f + __builtin_amdgcn_exp2f(-LOG2E * v)); }
__device__ __forceinline__ float fast_silu(float v) { return v * fast_sigmoid(v); }

namespace pg8 {
constexpr int BM = 256, BK = 64, HALF = 128, HTB = HALF * BK * 2, STAGE_BYTES = 8 * HTB, NXCD = 8;
__host__ __device__ __forceinline__ int lds_byte(int r, int c) { const int st = (r >> 4) * 2 + (c >> 5), rr = r & 15, cc = c & 31, ob = rr * 64 + cc * 2; return st * 1024 + (ob ^ (((ob >> 9) & 1) << 5)); }
__host__ __device__ __forceinline__ void stage_rc(int b, int& R, int& C) { const int st = b / 1024, sb = b % 1024, swz = sb ^ (((sb >> 9) & 1) << 5); R = (st >> 1) * 16 + swz / 64; C = (st & 1) * 32 + (swz % 64) / 2; }
__host__ __device__ __forceinline__ int perm32(int rho) { const int n = rho >> 4, i = rho & 15; return 8 * (i >> 2) + 4 * n + (i & 3); }

struct Unit { int pm, pn; int abyte, bbyte; };
struct Gemm { const bf16_t* A; const bf16_t* Bt; int lda, ldb, K; };

struct StaticOrder {
    int nM, nN, nwg, G, c, ta, tb, WGM;
    __device__ void init(int Mr, int N, int G_, int c_, int lda, int ldb, int wgm) { nM = Mr / BM; nN = N / BM; nwg = nM * nN; G = G_; c = c_; ta = BM * lda * 2; tb = BM * ldb * 2; WGM = wgm; }
    __device__ bool next(int i, Unit& u) const {
        const int L = i * G + c; if (L >= nwg) return false;
        int wgid = L; { const int q = nwg / NXCD, r = nwg % NXCD, xcd = wgid % NXCD, off = wgid / NXCD; wgid = (xcd < r ? xcd * (q + 1) : r * (q + 1) + (xcd - r) * q) + off; }
        const int nig = WGM * nN, gid = wgid / nig, fm = gid * WGM, gsz = (nM - fm) < WGM ? (nM - fm) : WGM;
        u.pm = fm + ((wgid % nig) % gsz); u.pn = (wgid % nig) / gsz; u.abyte = u.pm * ta; u.bbyte = u.pn * tb; return true;
    }
};
struct RotOrder {
    StaticOrder S; int rot;
    __device__ bool next(int i, Unit& u) const { if (!S.next(i, u)) return false; u.pn += rot; if (u.pn >= S.nN) u.pn -= S.nN; u.bbyte = u.pn * S.tb; return true; }
};
struct SingleUnit {
    Unit u0;
    __device__ bool next(int i, Unit& u) const { if (i != 0) return false; u = u0; return true; }
};
struct PairUnit {
    Unit u0; int tb;
    __device__ bool next(int i, Unit& u) const { if (i >= 2) return false; u = u0; u.pn = u0.pn + i; u.bbyte = u.pn * tb; return true; }
};
struct QuadUnit {
    Unit u0; int bstep;
    __device__ bool next(int i, Unit& u) const { if (i >= 4) return false; u = u0; u.pn = i; u.bbyte = u0.bbyte + i * bstep; return true; }
};
template <class E, class = void> struct aperm_of { static constexpr bool value = false; };
template <class E> struct aperm_of<E, decltype((void)E::APERM)> { static constexpr bool value = E::APERM; };

template <class Epi, class Sched>
__device__ __forceinline__ void gemm_phase(int tid_in, LAS unsigned char* lds, const Gemm g, const Sched& S, const Epi& E) {
    int tid = tid_in; asm volatile("" : "+v"(tid));
    const int wid = __builtin_amdgcn_readfirstlane(tid >> 6), lane = tid & 63, wr = wid >> 2, wc = wid & 3, fr = lane & 15, fq = lane >> 4;
    const int K = g.K, nt = K / BK;
    unsigned voffA[2], voffB[2]; int aoff, boff;
#define PG8_LANE_SETUP(t_) do { const int t__ = (t_); _Pragma("unroll") for (int i = 0; i < 2; ++i) { int R, C; stage_rc(t__ * 16 + i * 8192, R, C); const int Rb = Epi::PERM ? ((R & ~31) + perm32(R & 31)) : R; \
        const int Ra = aperm_of<Epi>::value ? ((R >> 6) * 128 + 8 * (R & 15) + ((R >> 4) & 3)) : R;       \
        voffA[i] = (unsigned)(Ra * g.lda + C) * 2u; voffB[i] = (unsigned)(Rb * g.ldb + C) * 2u; } \
        aoff = lds_byte(wr * 64 + (t__ & 15), ((t__ >> 4) & 3) * 8); boff = lds_byte(wc * 32 + (t__ & 15), ((t__ >> 4) & 3) * 8); } while (0)
    PG8_LANE_SETUP(tid);
    const int kstep = BK * 2;
    const int hstepA = (aperm_of<Epi>::value ? 4 : HALF) * g.lda * 2, hstepB = HALF * g.ldb * 2;
    const __amdgpu_buffer_rsrc_t rsA = __builtin_amdgcn_make_buffer_rsrc((void*)g.A, 0, 0x7ffffff0, 0x00020000);
    const __amdgpu_buffer_rsrc_t rsB = __builtin_amdgcn_make_buffer_rsrc((void*)g.Bt, 0, 0x7ffffff0, 0x00020000);
    const unsigned ldsw = (unsigned)wid * 1024u;
#define PG8_SA(b, h) (((b) * 2 + (h)) * HTB)
#define PG8_SB(b, h) ((4 + (b) * 2 + (h)) * HTB)
#define PG8_STAGEA(bufoff, soff) do { _Pragma("unroll") for (int _i = 0; _i < 2; ++_i) \
        __builtin_amdgcn_raw_ptr_buffer_load_lds(rsA, (LAS void*)(lds + (bufoff) + ldsw + _i * 8192), 16, (int)voffA[_i], (soff), 0, 0); } while (0)
#define PG8_STAGEB(bufoff, soff) do { _Pragma("unroll") for (int _i = 0; _i < 2; ++_i) \
        __builtin_amdgcn_raw_ptr_buffer_load_lds(rsB, (LAS void*)(lds + (bufoff) + ldsw + _i * 8192), 16, (int)voffB[_i], (soff), 0, 0); } while (0)
#define PG8_LDA(dst, b, h) do { _Pragma("unroll") for (int m = 0; m < 4; ++m) _Pragma("unroll") for (int k = 0; k < 2; ++k) dst[m][k] = *(const LAS bf16x8*)(lds + PG8_SA(b, h) + aoff + m * 2048 + k * 1024); } while (0)
#define PG8_LDB(dst, b, h) do { _Pragma("unroll") for (int n = 0; n < 2; ++n) _Pragma("unroll") for (int k = 0; k < 2; ++k) dst[n][k] = *(const LAS bf16x8*)(lds + PG8_SB(b, h) + boff + n * 2048 + k * 1024); } while (0)
#define PG8_MMA(ai, bj, At, Bt) do { __builtin_amdgcn_s_setprio(1); _Pragma("unroll") for (int m = 0; m < 4; ++m) _Pragma("unroll") for (int n = 0; n < 2; ++n) _Pragma("unroll") for (int k = 0; k < 2; ++k) \
        acc[ai][bj][m][n] = __builtin_amdgcn_mfma_f32_16x16x32_bf16(Bt[n][k], At[m][k], acc[ai][bj][m][n], 0, 0, 0); __builtin_amdgcn_s_setprio(0); } while (0)
#define PG8_WAIT_V(n) asm volatile("s_waitcnt vmcnt(" #n ")" ::: "memory")
#define PG8_WAIT_L(n) asm volatile("s_waitcnt lgkmcnt(" #n ")" ::: "memory")
#define PG8_BAR __builtin_amdgcn_s_barrier()
#define PG8_SCHED __builtin_amdgcn_sched_barrier(0)
#define PG8_ZERO_ACC() do { _Pragma("unroll") for (int a = 0; a < 2; ++a) _Pragma("unroll") for (int b = 0; b < 2; ++b) _Pragma("unroll") for (int m = 0; m < 4; ++m) _Pragma("unroll") for (int n = 0; n < 2; ++n) { \
        f64x2 z_; asm volatile("v_mov_b64 %0, 0\n\tv_mov_b64 %1, 0" : "=v"(z_.x), "=v"(z_.y)); acc[a][b][m][n] = __builtin_bit_cast(f32x4, z_); } } while (0)
    Unit cur, nxt; int ui = 0;
    if (!S.next(0, cur)) return;
    f32x4 acc[2][2][4][2];
    PG8_ZERO_ACC();
    bf16x8 At[4][2], B0[2][2], B1[2][2];
    int cA = cur.abyte, cB = cur.bbyte;
    PG8_STAGEB(PG8_SB(0, 0), cB); PG8_STAGEB(PG8_SB(0, 1), cB + hstepB); PG8_STAGEA(PG8_SA(0, 0), cA); PG8_STAGEA(PG8_SA(0, 1), cA + hstepA);
    if (wr == 1) PG8_BAR;
    PG8_WAIT_V(2); PG8_BAR;
    PG8_STAGEB(PG8_SB(1, 0), cB + kstep); PG8_STAGEA(PG8_SA(1, 0), cA + kstep); PG8_STAGEB(PG8_SB(1, 1), cB + hstepB + kstep);
    PG8_WAIT_V(6); PG8_BAR;
    for (;;) {
        const bool has_next = S.next(ui + 1, nxt);
        const int nA = has_next ? nxt.abyte : cA, nB = has_next ? nxt.bbyte : cB;
#pragma unroll 1
        for (int t = 0; t < nt; t += 2) {
            const bool last = (t == nt - 2);
            const int a1 = cA + (t + 1) * kstep;
            const int a2 = last ? nA : cA + (t + 2) * kstep, b2 = last ? nB : cB + (t + 2) * kstep;
            const int a3 = a2 + kstep, b3 = b2 + kstep;
            PG8_LDB(B0, 0, 0); PG8_LDB(B1, 0, 1); PG8_SCHED; PG8_LDA(At, 0, 0); PG8_STAGEA(PG8_SA(1, 1), a1 + hstepA);
            PG8_WAIT_V(8); PG8_WAIT_L(0); PG8_BAR; PG8_MMA(0, 0, At, B0); PG8_MMA(0, 1, At, B1); PG8_BAR; PG8_SCHED;
            PG8_LDA(At, 0, 1); PG8_STAGEB(PG8_SB(0, 0), b2); PG8_STAGEB(PG8_SB(0, 1), b2 + hstepB); PG8_STAGEA(PG8_SA(0, 0), a2);
            PG8_WAIT_V(8); PG8_WAIT_L(0); PG8_BAR; PG8_MMA(1, 0, At, B0); PG8_MMA(1, 1, At, B1); PG8_BAR; PG8_SCHED;
            PG8_LDB(B0, 1, 0); PG8_LDB(B1, 1, 1); PG8_SCHED; PG8_LDA(At, 1, 0); PG8_STAGEA(PG8_SA(0, 1), a2 + hstepA);
            PG8_WAIT_V(8); PG8_WAIT_L(0); PG8_BAR; PG8_MMA(0, 0, At, B0); PG8_MMA(0, 1, At, B1); PG8_BAR; PG8_SCHED;
            PG8_LDA(At, 1, 1); PG8_STAGEB(PG8_SB(1, 0), b3); PG8_STAGEB(PG8_SB(1, 1), b3 + hstepB); PG8_STAGEA(PG8_SA(1, 0), a3);
            PG8_WAIT_V(8); PG8_WAIT_L(0); PG8_BAR; PG8_MMA(1, 0, At, B0); PG8_MMA(1, 1, At, B1); PG8_BAR; PG8_SCHED;
        }
        if constexpr (!Epi::AFTER_DRAIN) { if (wr == 0) PG8_BAR; int l2 = lane; asm volatile("" : "+v"(l2)); int w2 = wid; asm volatile("" : "+s"(w2)); E(acc, cur, w2 >> 2, w2 & 3, l2 & 15, l2 >> 4);
            if constexpr (aperm_of<Epi>::value) { int t2 = threadIdx.x; asm volatile("" : "+v"(t2)); PG8_LANE_SETUP(t2); } }
        if (!has_next) break;
        PG8_ZERO_ACC();
        cur = nxt; cA = nA; cB = nB; ++ui;
        if constexpr (!Epi::AFTER_DRAIN) { if (wr == 1) PG8_BAR; }
    }
    PG8_WAIT_V(0);
    if constexpr (Epi::AFTER_DRAIN) { if (wr == 0) PG8_BAR; }
    PG8_BAR;
    if constexpr (Epi::AFTER_DRAIN) { int l2 = lane; asm volatile("" : "+v"(l2)); int w2 = wid; asm volatile("" : "+s"(w2)); E.fused(acc, cur, w2 >> 2, w2 & 3, l2 & 15, l2 >> 4, lds, w2, l2); }
#undef PG8_LANE_SETUP
#undef PG8_ZERO_ACC
#undef PG8_SA
#undef PG8_SB
#undef PG8_STAGEA
#undef PG8_STAGEB
#undef PG8_LDA
#undef PG8_LDB
#undef PG8_MMA
#undef PG8_WAIT_V
#undef PG8_WAIT_L
#undef PG8_BAR
#undef PG8_SCHED
}

struct Gemm2 { const bf16_t* A0; const bf16_t* B0; int lda0, ldb0, K0; const bf16_t* A1; const bf16_t* B1; int lda1, ldb1, K1; };
template <class Epi, class Sched>
__device__ __forceinline__ void gemm_phase2(int tid_in, LAS unsigned char* lds, const Gemm2 g, const Sched& S, const Epi& E) {
    int tid = tid_in; asm volatile("" : "+v"(tid));
    const int wid = __builtin_amdgcn_readfirstlane(tid >> 6), lane = tid & 63, wr = wid >> 2, wc = wid & 3, fr = lane & 15, fq = lane >> 4;
    const int nt0 = g.K0 / BK, nt = (g.K0 + g.K1) / BK;
    unsigned voffA[2][2], voffB[2][2];
#pragma unroll
    for (int i = 0; i < 2; ++i) { int R, C; stage_rc(tid * 16 + i * 8192, R, C); const int Rb = Epi::PERM ? ((R & ~31) + perm32(R & 31)) : R;
        voffA[0][i] = (unsigned)(R * g.lda0 + C) * 2u; voffB[0][i] = (unsigned)(Rb * g.ldb0 + C) * 2u;
        voffA[1][i] = (unsigned)(R * g.lda1 + C) * 2u; voffB[1][i] = (unsigned)(Rb * g.ldb1 + C) * 2u; }
    const int kstep = BK * 2;
    const __amdgpu_buffer_rsrc_t rsA0 = __builtin_amdgcn_make_buffer_rsrc((void*)g.A0, 0, 0x7ffffff0, 0x00020000), rsA1 = __builtin_amdgcn_make_buffer_rsrc((void*)g.A1, 0, 0x7ffffff0, 0x00020000);
    const __amdgpu_buffer_rsrc_t rsB0 = __builtin_amdgcn_make_buffer_rsrc((void*)g.B0, 0, 0x7ffffff0, 0x00020000), rsB1 = __builtin_amdgcn_make_buffer_rsrc((void*)g.B1, 0, 0x7ffffff0, 0x00020000);
    const unsigned ldsw = (unsigned)wid * 1024u;
    const int aoff = lds_byte(wr * 64 + fr, fq * 8), boff = lds_byte(wc * 32 + fr, fq * 8);
#define PG8_SA(b, h) (((b) * 2 + (h)) * HTB)
#define PG8_SB(b, h) ((4 + (b) * 2 + (h)) * HTB)
#define PG8_STAGEA2(bufoff, T, h) do { int _T = (T); if (_T >= nt) _T -= nt; const bool _s = _T >= nt0; \
        const int _so = _s ? (pm * 256 * g.lda1 * 2 + (_T - nt0) * kstep + (h) * HALF * g.lda1 * 2) : (pm * 256 * g.lda0 * 2 + _T * kstep + (h) * HALF * g.lda0 * 2); \
        _Pragma("unroll") for (int _i = 0; _i < 2; ++_i) { if (_s) __builtin_amdgcn_raw_ptr_buffer_load_lds(rsA1, (LAS void*)(lds + (bufoff) + ldsw + _i * 8192), 16, (int)voffA[1][_i], _so, 0, 0); \
            else __builtin_amdgcn_raw_ptr_buffer_load_lds(rsA0, (LAS void*)(lds + (bufoff) + ldsw + _i * 8192), 16, (int)voffA[0][_i], _so, 0, 0); } } while (0)
#define PG8_STAGEB2(bufoff, T, h) do { int _T = (T); if (_T >= nt) _T -= nt; const bool _s = _T >= nt0; \
        const int _so = _s ? (pn * 256 * g.ldb1 * 2 + (_T - nt0) * kstep + (h) * HALF * g.ldb1 * 2) : (pn * 256 * g.ldb0 * 2 + _T * kstep + (h) * HALF * g.ldb0 * 2); \
        _Pragma("unroll") for (int _i = 0; _i < 2; ++_i) { if (_s) __builtin_amdgcn_raw_ptr_buffer_load_lds(rsB1, (LAS void*)(lds + (bufoff) + ldsw + _i * 8192), 16, (int)voffB[1][_i], _so, 0, 0); \
            else __builtin_amdgcn_raw_ptr_buffer_load_lds(rsB0, (LAS void*)(lds + (bufoff) + ldsw + _i * 8192), 16, (int)voffB[0][_i], _so, 0, 0); } } while (0)
#define PG8_LDA(dst, b, h) do { _Pragma("unroll") for (int m = 0; m < 4; ++m) _Pragma("unroll") for (int k = 0; k < 2; ++k) dst[m][k] = *(const LAS bf16x8*)(lds + PG8_SA(b, h) + aoff + m * 2048 + k * 1024); } while (0)
#define PG8_LDB(dst, b, h) do { _Pragma("unroll") for (int n = 0; n < 2; ++n) _Pragma("unroll") for (int k = 0; k < 2; ++k) dst[n][k] = *(const LAS bf16x8*)(lds + PG8_SB(b, h) + boff + n * 2048 + k * 1024); } while (0)
#define PG8_MMA(ai, bj, At, Bt) do { __builtin_amdgcn_s_setprio(1); _Pragma("unroll") for (int m = 0; m < 4; ++m) _Pragma("unroll") for (int n = 0; n < 2; ++n) _Pragma("unroll") for (int k = 0; k < 2; ++k) \
        acc[ai][bj][m][n] = __builtin_amdgcn_mfma_f32_16x16x32_bf16(Bt[n][k], At[m][k], acc[ai][bj][m][n], 0, 0, 0); __builtin_amdgcn_s_setprio(0); } while (0)
#define PG8_WAIT_V(n) asm volatile("s_waitcnt vmcnt(" #n ")" ::: "memory")
#define PG8_WAIT_L(n) asm volatile("s_waitcnt lgkmcnt(" #n ")" ::: "memory")
#define PG8_BAR __builtin_amdgcn_s_barrier()
#define PG8_SCHED __builtin_amdgcn_sched_barrier(0)
    Unit cur;
    for (int ui = 0; S.next(ui, cur); ++ui) {
        const int pm = cur.pm, pn = cur.pn;
        f32x4 acc[2][2][4][2];
#pragma unroll
        for (int a = 0; a < 2; ++a)
#pragma unroll
            for (int b = 0; b < 2; ++b)
#pragma unroll
                for (int m = 0; m < 4; ++m)
#pragma unroll
                    for (int n = 0; n < 2; ++n) { f64x2 z_; asm volatile("v_mov_b64 %0, 0\n\tv_mov_b64 %1, 0" : "=v"(z_.x), "=v"(z_.y)); acc[a][b][m][n] = __builtin_bit_cast(f32x4, z_); }
        bf16x8 At[4][2], B0[2][2], B1[2][2];
        PG8_STAGEB2(PG8_SB(0, 0), 0, 0); PG8_STAGEB2(PG8_SB(0, 1), 0, 1); PG8_STAGEA2(PG8_SA(0, 0), 0, 0); PG8_STAGEA2(PG8_SA(0, 1), 0, 1);
        if (wr == 1) PG8_BAR;
        PG8_WAIT_V(2); PG8_BAR;
        PG8_STAGEB2(PG8_SB(1, 0), 1, 0); PG8_STAGEA2(PG8_SA(1, 0), 1, 0); PG8_STAGEB2(PG8_SB(1, 1), 1, 1);
        PG8_WAIT_V(6); PG8_BAR;
#pragma unroll 1
        for (int t = 0; t < nt; t += 2) {
            if (t == nt0) { int l2 = lane; asm volatile("" : "+v"(l2)); int w2 = wid; asm volatile("" : "+s"(w2)); E.mid(acc, cur, w2 >> 2, w2 & 3, l2 & 15, l2 >> 4); }
            PG8_LDB(B0, 0, 0); PG8_LDB(B1, 0, 1); PG8_SCHED; PG8_LDA(At, 0, 0); PG8_STAGEA2(PG8_SA(1, 1), t + 1, 1);
            PG8_WAIT_V(8); PG8_WAIT_L(0); PG8_BAR; PG8_MMA(0, 0, At, B0); PG8_MMA(0, 1, At, B1); PG8_BAR; PG8_SCHED;
            PG8_LDA(At, 0, 1); PG8_STAGEB2(PG8_SB(0, 0), t + 2, 0); PG8_STAGEB2(PG8_SB(0, 1), t + 2, 1); PG8_STAGEA2(PG8_SA(0, 0), t + 2, 0);
            PG8_WAIT_V(8); PG8_WAIT_L(0); PG8_BAR; PG8_MMA(1, 0, At, B0); PG8_MMA(1, 1, At, B1); PG8_BAR; PG8_SCHED;
            PG8_LDB(B0, 1, 0); PG8_LDB(B1, 1, 1); PG8_SCHED; PG8_LDA(At, 1, 0); PG8_STAGEA2(PG8_SA(0, 1), t + 2, 1);
            PG8_WAIT_V(8); PG8_WAIT_L(0); PG8_BAR; PG8_MMA(0, 0, At, B0); PG8_MMA(0, 1, At, B1); PG8_BAR; PG8_SCHED;
            PG8_LDA(At, 1, 1); PG8_STAGEB2(PG8_SB(1, 0), t + 3, 0); PG8_STAGEB2(PG8_SB(1, 1), t + 3, 1); PG8_STAGEA2(PG8_SA(1, 0), t + 3, 0);
            PG8_WAIT_V(8); PG8_WAIT_L(0); PG8_BAR; PG8_MMA(1, 0, At, B0); PG8_MMA(1, 1, At, B1); PG8_BAR; PG8_SCHED;
        }
        PG8_WAIT_V(0);
        if (wr == 0) PG8_BAR;
        PG8_BAR;
        { int l2 = lane; asm volatile("" : "+v"(l2)); int w2 = wid; asm volatile("" : "+s"(w2)); E(acc, cur, w2 >> 2, w2 & 3, l2 & 15, l2 >> 4); }
        PG8_WAIT_V(0); PG8_BAR;
    }
#undef PG8_SA
#undef PG8_SB
#undef PG8_STAGEA2
#undef PG8_STAGEB2
#undef PG8_LDA
#undef PG8_LDB
#undef PG8_MMA
#undef PG8_WAIT_V
#undef PG8_WAIT_L
#undef PG8_BAR
#undef PG8_SCHED
}
}

#define XB_TMO      128
#define XB_XCNT(j)  (256  + 64 * (j))
#define XB_XSUB(j)  (1280 + 64 * (j))
#define XB_XGEN(j)  (2304 + 64 * (j))
#define XB_TOP      3328
#define XB_TOPGEN   3392
#define XCD_BAR_WORDS 3456
#define XB_SPIN_CAP (1u << 18)
__device__ __forceinline__ unsigned xb_ld(unsigned* p)              { return __hip_atomic_load(p, __ATOMIC_RELAXED, __HIP_MEMORY_SCOPE_AGENT); }
__device__ __forceinline__ unsigned xb_add(unsigned* p, unsigned v) { return __hip_atomic_fetch_add(p, v, __ATOMIC_RELAXED, __HIP_MEMORY_SCOPE_AGENT); }
__device__ __forceinline__ unsigned xb_xcc_id() { return (unsigned)__builtin_amdgcn_s_getreg((3 << 11) | 20) & 0xFu; }
#define XB_SPIN(cond, bar) do { unsigned _sp = 0; while (cond) { __builtin_amdgcn_s_sleep(1); \
    if ((++_sp & 255u) == 0u) { if (xb_ld(&(bar)[XB_TMO])) break; if (_sp > XB_SPIN_CAP) { atomicAdd(&(bar)[XB_TMO], 1u); break; } } } } while (0)
struct XcdBarrier { unsigned* bar; unsigned x; volatile LAS unsigned* st; };
__device__ __forceinline__ XcdBarrier xcd_barrier_post(unsigned* bar, volatile LAS unsigned* st) {
    XcdBarrier b; b.bar = bar; b.x = xb_xcc_id(); b.st = st;
    if (threadIdx.x == 0) (void)xb_add(&bar[XB_XCNT(b.x)], 1u);
    return b;
}
__device__ __forceinline__ void xcd_barrier_complete(unsigned* bar, unsigned x, unsigned& nloc, unsigned& nx) {
    const unsigned G = gridDim.x * gridDim.y * gridDim.z;
    unsigned sum, cnt, mine, sp = 0u;
    for (;;) {
        sum = 0u; cnt = 0u; mine = 0u;
#pragma unroll
        for (unsigned j = 0; j < 16; ++j) { const unsigned c = xb_ld(&bar[XB_XCNT(j)]); sum += c; cnt += (c > 0u) ? 1u : 0u; mine = (j == x) ? c : mine; }
        if (sum == G) break;
        __builtin_amdgcn_s_sleep(1);
        if ((++sp & 255u) == 0u) { if (xb_ld(&bar[XB_TMO])) break; if (sp > XB_SPIN_CAP) { atomicAdd(&bar[XB_TMO], 1u); break; } }
    }
    nloc = mine > 0u ? mine : 1u; nx = cnt > 0u ? cnt : 1u;
}
__device__ __forceinline__ void xcd_barrier(const XcdBarrier& b) {
    asm volatile("s_waitcnt vmcnt(0)" ::: "memory");
    __syncthreads();
    if (threadIdx.x == 0) {
        unsigned* bar = b.bar;
        __builtin_amdgcn_s_waitcnt(0);
        unsigned nloc = b.st[0], nx = b.st[1];
        if (nloc == 0u) { xcd_barrier_complete(bar, b.x, nloc, nx); b.st[0] = nloc; b.st[1] = nx; }
        const unsigned old = xb_add(&bar[XB_XSUB(b.x)], 1u);
        const unsigned gen = old / nloc;
        if (old + 1u == (gen + 1u) * nloc) {
            __builtin_amdgcn_fence(__ATOMIC_RELEASE, "agent");
            asm volatile("s_waitcnt vmcnt(0)" ::: "memory");
            const unsigned og = xb_add(&bar[XB_TOP], 1u);
            const unsigned tg = og / nx;
            if (og + 1u == (tg + 1u) * nx) xb_add(&bar[XB_TOPGEN], 1u);
            else XB_SPIN(xb_ld(&bar[XB_TOPGEN]) == tg, bar);
            __builtin_amdgcn_fence(__ATOMIC_ACQUIRE, "agent");
            xb_add(&bar[XB_XGEN(b.x)], 1u);
            asm volatile("s_waitcnt vmcnt(0)" ::: "memory");
        } else {
            XB_SPIN(xb_ld(&bar[XB_XGEN(b.x)]) == gen, bar);
            __builtin_amdgcn_fence(__ATOMIC_ACQUIRE, "agent");
            asm volatile("s_waitcnt vmcnt(0)" ::: "memory");
        }
    }
    __syncthreads();
}


__device__ __forceinline__ void xcd_barrier_arrive(const XcdBarrier& b) {
    asm volatile("s_waitcnt vmcnt(0)" ::: "memory");
    __syncthreads();
    if (threadIdx.x == 0) {
        unsigned* bar = b.bar;
        __builtin_amdgcn_s_waitcnt(0);
        unsigned nloc = b.st[0], nx = b.st[1];
        if (nloc == 0u) { xcd_barrier_complete(bar, b.x, nloc, nx); b.st[0] = nloc; b.st[1] = nx; }
        const unsigned old = xb_add(&bar[XB_XSUB(b.x)], 1u);
        const unsigned gen = old / nloc;
        unsigned role = 0u, tg = 0u;
        if (old + 1u == (gen + 1u) * nloc) {
            role = 1u;
            __builtin_amdgcn_fence(__ATOMIC_RELEASE, "agent");
            asm volatile("s_waitcnt vmcnt(0)" ::: "memory");
            const unsigned og = xb_add(&bar[XB_TOP], 1u);
            tg = og / nx;
            if (og + 1u == (tg + 1u) * nx) { xb_add(&bar[XB_TOPGEN], 1u); role = 3u; }
        }
        b.st[5] = gen; b.st[6] = role; b.st[7] = tg;
    }
}
__device__ __forceinline__ void xcd_barrier_wait(const XcdBarrier& b) {
    __syncthreads();
    if (threadIdx.x == 0) {
        unsigned* bar = b.bar;
        const unsigned gen = b.st[5], role = b.st[6], tg = b.st[7];
        if (role & 1u) {
            if (!(role & 2u)) XB_SPIN(xb_ld(&bar[XB_TOPGEN]) == tg, bar);
            __builtin_amdgcn_fence(__ATOMIC_ACQUIRE, "agent");
            xb_add(&bar[XB_XGEN(b.x)], 1u);
            asm volatile("s_waitcnt vmcnt(0)" ::: "memory");
        } else {
            XB_SPIN(xb_ld(&bar[XB_XGEN(b.x)]) == gen, bar);
            __builtin_amdgcn_fence(__ATOMIC_ACQUIRE, "agent");
            asm volatile("s_waitcnt vmcnt(0)" ::: "memory");
        }
    }
    __syncthreads();
}


__device__ __forceinline__ void group_barrier_arrive(unsigned* gcnt) {
    asm volatile("s_waitcnt vmcnt(0)" ::: "memory");
    __syncthreads();
    if (threadIdx.x == 0) __hip_atomic_fetch_add(gcnt, 1u, __ATOMIC_RELAXED, __HIP_MEMORY_SCOPE_AGENT);
}
__device__ __forceinline__ void group_barrier_wait(unsigned* gcnt, unsigned target, unsigned* tmo) {
    if (threadIdx.x == 0) {
        unsigned sp = 0;
        while (__hip_atomic_load(gcnt, __ATOMIC_RELAXED, __HIP_MEMORY_SCOPE_AGENT) < target) {
            __builtin_amdgcn_s_sleep(1);
            if ((++sp & 1023u) == 0u) { if (__hip_atomic_load(tmo, __ATOMIC_RELAXED, __HIP_MEMORY_SCOPE_AGENT) != 0u) break; if (sp > (1u << 22)) { __hip_atomic_store(tmo, 1u, __ATOMIC_RELAXED, __HIP_MEMORY_SCOPE_AGENT); break; } }
        }
        __builtin_amdgcn_fence(__ATOMIC_ACQUIRE, "agent");
        asm volatile("s_waitcnt vmcnt(0)" ::: "memory");
    }
    __syncthreads();
}
struct Frame {
    LAS unsigned char* lds;
    unsigned* ctl;
    int tid, lane, wave, vcu, G;
    unsigned char* ws;
};
struct Args { const float* in[15]; float* out; unsigned char* ws; int ph_lo, ph_hi, li, pad; };

__device__ __forceinline__ int fresh(int v) { asm volatile("" : "+v"(v)); return v; }
__device__ __forceinline__ float wave_sum(float v) {
#pragma unroll
    for (int o = 1; o < 64; o <<= 1) v += __shfl_xor(v, o);
    return v;
}
__device__ __forceinline__ float wave_max(float v) {
#pragma unroll
    for (int o = 1; o < 64; o <<= 1) v = fmaxf(v, __shfl_xor(v, o));
    return v;
}

__host__ __device__ __forceinline__ int win_row(int n) { if (n < 7168) return n; const int g = (n - 7168) >> 10, c = (n - 7168) & 1023; return 7168 + 256 * (c >> 7) + 128 * g + (c & 127); }
template <class RowFn>
__device__ __forceinline__ void p0_transpose_item(const float* W, int K, int N, const float* kscale, float gscale, const RowFn& rowptr, LAS float* scr, int item, int lane) {
    const int nblk = N / 32, kb = item / nblk, nb = item % nblk, k0 = 64 * kb, n0 = 32 * nb;
    float wv[32];
#pragma unroll
    for (int i = 0; i < 32; ++i) wv[i] = __builtin_nontemporal_load(W + (size_t)(k0 + 2 * i + (lane >> 5)) * N + n0 + (lane & 31));
#pragma unroll
    for (int i = 0; i < 32; ++i) { const int kk = 2 * i + (lane >> 5); const float sc = kscale ? kscale[k0 + kk] * gscale : gscale; scr[kk * 33 + (lane & 31)] = wv[i] * sc; }
    LDS_WAIT(); asm volatile("" ::: "memory");
    const int c = lane & 7;
#pragma unroll
    for (int j = 0; j < 4; ++j) { const int n = (lane >> 3) + 8 * j; const LAS float* s = scr + (8 * c) * 33 + n;
        u32x4 o; o.x = cvt_pk_bf16(s[0 * 33], s[1 * 33]); o.y = cvt_pk_bf16(s[2 * 33], s[3 * 33]); o.z = cvt_pk_bf16(s[4 * 33], s[5 * 33]); o.w = cvt_pk_bf16(s[6 * 33], s[7 * 33]);
        *(u32x4*)(rowptr(n0 + n) + k0 + 8 * c) = o; }
    LDS_WAIT(); asm volatile("" ::: "memory");
}

template <class RowFn>
__device__ __forceinline__ void p0_mini_item(const float* W, int N, const float* kscale, float gscale, const RowFn& rowptr, int kb, int nb, int lane) {
    const int k0 = 32 * kb, n = 64 * nb + lane;
    float v[32];
#pragma unroll
    for (int j = 0; j < 32; ++j) v[j] = __builtin_nontemporal_load(W + (size_t)(k0 + j) * N + n);
#pragma unroll
    for (int j = 0; j < 32; ++j) v[j] *= kscale ? kscale[k0 + j] * gscale : gscale;
    bf16_t* dst = rowptr(n) + k0;
#pragma unroll
    for (int q = 0; q < 4; ++q) { u32x4 o; o.x = cvt_pk_bf16(v[8 * q], v[8 * q + 1]); o.y = cvt_pk_bf16(v[8 * q + 2], v[8 * q + 3]); o.z = cvt_pk_bf16(v[8 * q + 4], v[8 * q + 5]); o.w = cvt_pk_bf16(v[8 * q + 6], v[8 * q + 7]);
        *(u32x4*)(dst + 8 * q) = o; }
}
constexpr int P1_MINI = 32 * 144 + 16 * 16 + 2 * 32 * 16 + 16 * 32;
__device__ __forceinline__ void p0_layer1_mini(const float* const* in, unsigned char* ws, int idx, int lane) {
    bf16_t* Wb = (bf16_t*)(ws + WS_W);
    if (idx < 32 * 144) { bf16_t* dst = Wb + W_IN_T / 2 + (size_t)NIN * DM;
        p0_mini_item(in[2] + (size_t)DM * NIN, NIN, in[1] + DM, 1.0f, [=](int n) { return dst + (size_t)win_row(n) * DM; }, idx / 144, idx % 144, lane); return; } idx -= 32 * 144;
    if (idx < 256) { bf16_t* dst = Wb + W_OATT_T / 2 + (size_t)DM * 512;
        p0_mini_item(in[11] + (size_t)512 * DM, DM, nullptr, 1.0f, [=](int n) { return dst + (size_t)n * 512; }, idx / 16, idx % 16, lane); return; } idx -= 256;
    if (idx < 512) { bf16_t* dst = Wb + W_OLRU_T / 2 + (size_t)DM * DM;
        p0_mini_item(in[12] + (size_t)DM * DM, DM, nullptr, 1.0f, [=](int n) { return dst + (size_t)n * DM; }, idx / 16, idx % 16, lane); return; } idx -= 512;
    if (idx < 512) { bf16_t* dst = Wb + W_OUT_T / 2 + (size_t)DM * DM;
        p0_mini_item(in[13] + (size_t)DM * DM, DM, nullptr, 1.0f, [=](int n) { return dst + (size_t)n * DM; }, idx / 16, idx % 16, lane); return; } idx -= 512;
    {   const int s = idx / 32, item = idx % 32, dir = s >> 3, kind = (s >> 2) & 1, n = s & 3;
        const float* src = (kind ? in[8] : in[6]) + ((size_t)((1 * 2 + dir) * 4 + n)) * 65536;
        bf16_t* dst = Wb + W_RG_T / 2 + (size_t)(1 * 4 + n) * 4 * 65536;
        p0_mini_item(src, 256, nullptr, -LOG2E, [=](int j) { return dst + (size_t)(j >> 6) * 65536 + (size_t)(128 * dir + 32 * ((j >> 4) & 3) + 16 * kind + (j & 15)) * 256; }, item / 4, item % 4, lane);
    }
}
__device__ __forceinline__ void p0_prologue(Frame& F, const Args& a) {
    LAS float* scr = (LAS float*)(F.lds + F.wave * 16384);
    const int gw = F.vcu * 8 + F.wave, NGW = F.G * 8;
    bf16_t* Wb = (bf16_t*)(F.ws + WS_W);
    constexpr int I_IN = (DM / 64) * (NIN / 32), I_OA = (512 / 64) * (DM / 32), I_OL = (DM / 64) * (DM / 32), I_RG = (256 / 64) * (256 / 32);
    constexpr int PER_LAYER = I_IN + I_OA + 2 * I_OL + 16 * I_RG;
    const int n_items = (F.G == 256) ? PER_LAYER : DEPTH * PER_LAYER;
    for (int it = gw; it < n_items; it += NGW) {
        const int l = it / PER_LAYER; int r = it % PER_LAYER;
        if (r < I_IN) { bf16_t* dst = Wb + W_IN_T / 2 + (size_t)l * NIN * DM;
            p0_transpose_item(a.in[2] + (size_t)l * DM * NIN, DM, NIN, a.in[1] + l * DM, 1.0f, [=](int n) { return dst + (size_t)win_row(n) * DM; }, scr, r, F.lane); continue; } r -= I_IN;
        if (r < I_OA) { bf16_t* dst = Wb + W_OATT_T / 2 + (size_t)l * DM * 512;
            p0_transpose_item(a.in[11] + (size_t)l * 512 * DM, 512, DM, nullptr, 1.0f, [=](int n) { return dst + (size_t)n * 512; }, scr, r, F.lane); continue; } r -= I_OA;
        if (r < I_OL) { bf16_t* dst = Wb + W_OLRU_T / 2 + (size_t)l * DM * DM;
            p0_transpose_item(a.in[12] + (size_t)l * DM * DM, DM, DM, nullptr, 1.0f, [=](int n) { return dst + (size_t)n * DM; }, scr, r, F.lane); continue; } r -= I_OL;
        if (r < I_OL) { bf16_t* dst = Wb + W_OUT_T / 2 + (size_t)l * DM * DM;
            p0_transpose_item(a.in[13] + (size_t)l * DM * DM, DM, DM, nullptr, 1.0f, [=](int n) { return dst + (size_t)n * DM; }, scr, r, F.lane); continue; } r -= I_OL;
        {
            const int s = r / I_RG, item = r % I_RG, dir = s >> 3, kind = (s >> 2) & 1, n = s & 3;
            const float* src = (kind ? a.in[8] : a.in[6]) + ((size_t)((l * 2 + dir) * 4 + n)) * 65536;
            bf16_t* dst = Wb + W_RG_T / 2 + (size_t)(l * 4 + n) * 4 * 65536;
            p0_transpose_item(src, 256, 256, nullptr, -LOG2E, [=](int j) { return dst + (size_t)(j >> 6) * 65536 + (size_t)(128 * dir + 32 * ((j >> 4) & 3) + 16 * kind + (j & 15)) * 256; }, scr, item, F.lane);
        }
    }
    for (int i = gw * 64 + F.lane; i < DEPTH * 2 * DM; i += NGW * 64) {
        const float c2 = -8.0f * LOG2E * log1pf(expf(-a.in[10][i]));
        ((f32x4*)(F.ws + WS_LC))[i] = (f32x4){__builtin_amdgcn_exp2f(-LOG2E * a.in[7][i]), __builtin_amdgcn_exp2f(-LOG2E * a.in[9][i]), c2, 2.0f * c2};
    }
    const float* x = a.in[0]; bf16_t* XB = (bf16_t*)(F.ws + WS_XB);
    for (int m0 = gw * 4; m0 < M; m0 += NGW * 4) {
        f32x4 v[4][4];
#pragma unroll
        for (int r = 0; r < 4; ++r)
#pragma unroll
            for (int j = 0; j < 4; ++j) v[r][j] = __builtin_nontemporal_load((const f32x4*)(x + (size_t)(m0 + r) * DM) + F.lane + 64 * j);
#pragma unroll
        for (int r = 0; r < 4; ++r) { float s = 0.f;
#pragma unroll
            for (int j = 0; j < 4; ++j) { const f32x4 t = v[r][j]; s += (t.x * t.x + t.y * t.y) + (t.z * t.z + t.w * t.w); }
            const float ssum = wave_sum(s); if (F.lane == 0) ((float*)(F.ctl + CW_SS))[m0 + r] = ssum;
            const float rstd = __builtin_amdgcn_rsqf(ssum * (1.0f / DM) + NORM_EPS);
            unsigned long long* o8 = (unsigned long long*)(XB + (size_t)(m0 + r) * DM) + F.lane;
#pragma unroll
            for (int j = 0; j < 4; ++j) { const f32x4 t = v[r][j] * rstd;
                o8[64 * j] = (unsigned long long)cvt_pk_bf16(t.x, t.y) | ((unsigned long long)cvt_pk_bf16(t.z, t.w) << 32); } }
    }
}

struct EpiProjA {
    static constexpr bool PERM = true, AFTER_DRAIN = false;
    unsigned char* ws; bool dry;
    __device__ __forceinline__ void operator()(const f32x4 (&acc)[2][2][4][2], const pg8::Unit& u, int wr, int wc, int fr, int fq) const {
        const int kind = u.pn / 6;
#pragma unroll
        for (int ai = 0; ai < 2; ++ai)
#pragma unroll
            for (int m = 0; m < 4; ++m) {
                const int row = u.pm * 256 + ai * 128 + wr * 64 + m * 16 + fr;
                if (kind < 3) {
                    const int b = row >> 13, p = row & 8191; const float sc = (kind == 0) ? QSCALE : 1.0f;
                    bf16_t* base = (bf16_t*)(ws + WS_Q + (size_t)kind * (WS_K - WS_Q));
#pragma unroll
                    for (int bj = 0; bj < 2; ++bj) {
                        const int hh = 2 * (u.pn - 6 * kind) + bj;
                        bf16_t* dst = base + ((size_t)(b * NH + hh) * SEQ + p) * HD + wc * 32 + 8 * fq;
                        const f32x4 v0 = acc[ai][bj][m][0] * sc, v1 = acc[ai][bj][m][1] * sc;
                        u32x4 w; w.x = cvt_pk_bf16(v0[0], v0[1]); w.y = cvt_pk_bf16(v0[2], v0[3]); w.z = cvt_pk_bf16(v1[0], v1[1]); w.w = cvt_pk_bf16(v1[2], v1[3]);
                        if (!dry) *(u32x4*)dst = w;
#if defined(DRY_SCRATCH)
                        else *(u32x4*)(ws + 234 * MiB + (size_t)blockIdx.x * 131072 + ((ai * 4 + m) * 2 + bj) * 8192 + (wr * 4 + wc) * 1024 + (fq * 16 + fr) * 16) = w;
#elif defined(DRY_FRESH)
                        else *(u32x4*)(ws + WS_Q + (size_t)(u.pm * 20 + u.pn) * 131072 + ((ai * 4 + m) * 2 + bj) * 8192 + (wr * 4 + wc) * 1024 + (fq * 16 + fr) * 16) = w;
#elif defined(DRY_REAL)
                        else *(u32x4*)dst = w;
#else
                        else asm volatile("" :: "v"(w));
#endif
                    }
                } else {
#pragma unroll
                    for (int bj = 0; bj < 2; ++bj) {
                        bf16_t* dst = (bf16_t*)(ws + WS_SGA) + (size_t)row * 512 + (u.pn - 18) * 256 + bj * 128 + wc * 32 + 8 * fq;
                        const f32x4 v0 = acc[ai][bj][m][0], v1 = acc[ai][bj][m][1];
                        u32x4 w; w.x = cvt_pk_bf16(fast_silu(v0[0]), fast_silu(v0[1])); w.y = cvt_pk_bf16(fast_silu(v0[2]), fast_silu(v0[3]));
                        w.z = cvt_pk_bf16(fast_silu(v1[0]), fast_silu(v1[1])); w.w = cvt_pk_bf16(fast_silu(v1[2]), fast_silu(v1[3]));
                        *(u32x4*)dst = w;
                    }
                }
            }
    }
};
struct EpiProjB {
    static constexpr bool PERM = true, AFTER_DRAIN = false;
    unsigned char* ws; const float* bgate; bf16_t* SGLp;
    __device__ __forceinline__ void operator()(const f32x4 (&acc)[2][2][4][2], const pg8::Unit& u, int wr, int wc, int fr, int fq) const {
        const int kind = u.pn < 4 ? 0 : (u.pn < 8 ? 1 : 2);
        if (kind == 2) {
            const int c0 = (u.pn - 8) * 128 + wc * 32 + 8 * fq;
            f32x4 ba[2], bl[2];
#pragma unroll
            for (int n = 0; n < 2; ++n) { ba[n] = *(const f32x4*)(bgate + c0 + 4 * n); bl[n] = *(const f32x4*)(bgate + 1024 + c0 + 4 * n); }
#pragma unroll
            for (int ai = 0; ai < 2; ++ai)
#pragma unroll
                for (int m = 0; m < 4; ++m) {
                    const int row = u.pm * 256 + ai * 128 + wr * 64 + m * 16 + fr;
                    float ra[8], gl[8];
#pragma unroll
                    for (int n = 0; n < 2; ++n)
#pragma unroll
                        for (int e = 0; e < 4; ++e) { const float ga = fast_sigmoid(acc[ai][0][m][n][e] + ba[n][e]); const float g2 = fast_sigmoid(acc[ai][1][m][n][e] + bl[n][e]);
                            gl[4 * n + e] = g2; ra[4 * n + e] = ga * __builtin_amdgcn_rcpf(fmaxf(g2, 1e-30f)); }
                    bf16_t* dst = (bf16_t*)(ws + WS_GATE) + (size_t)row * 2048 + c0;
                    u32x4 w; w.x = cvt_pk_bf16(ra[0], ra[1]); w.y = cvt_pk_bf16(ra[2], ra[3]); w.z = cvt_pk_bf16(ra[4], ra[5]); w.w = cvt_pk_bf16(ra[6], ra[7]);
                    *(u32x4*)dst = w;
                    w.x = cvt_pk_bf16(gl[0], gl[1]); w.y = cvt_pk_bf16(gl[2], gl[3]); w.z = cvt_pk_bf16(gl[4], gl[5]); w.w = cvt_pk_bf16(gl[6], gl[7]);
                    *(u32x4*)(dst + 1024) = w;
                }
            return;
        }
#pragma unroll
        for (int ai = 0; ai < 2; ++ai)
#pragma unroll
            for (int m = 0; m < 4; ++m) {
                const int row = u.pm * 256 + ai * 128 + wr * 64 + m * 16 + fr;
#pragma unroll
                for (int bj = 0; bj < 2; ++bj) {
                    const int cin = bj * 128 + wc * 32 + 8 * fq;
                    f32x4 v0 = acc[ai][bj][m][0], v1 = acc[ai][bj][m][1];
                    bf16_t* dst;
                    if (kind == 0) dst = (bf16_t*)(ws + WS_XLRU) + (size_t)row * DM + u.pn * 256 + cin;
                    else { dst = SGLp + (size_t)row * DM + (u.pn - 4) * 256 + cin;
#pragma unroll
                        for (int e = 0; e < 4; ++e) { v0[e] = fast_silu(v0[e]); v1[e] = fast_silu(v1[e]); } }
                    u32x4 w; w.x = cvt_pk_bf16(v0[0], v0[1]); w.y = cvt_pk_bf16(v0[2], v0[3]); w.z = cvt_pk_bf16(v1[0], v1[1]); w.w = cvt_pk_bf16(v1[2], v1[3]);
                    *(u32x4*)dst = w;
                }
            }
    }
};
struct EpiProjAB {
    static constexpr bool PERM = true, AFTER_DRAIN = false;
    EpiProjA A; EpiProjB B;
    __device__ __forceinline__ void operator()(const f32x4 (&acc)[2][2][4][2], const pg8::Unit& u, int wr, int wc, int fr, int fq) const {
        if (u.pn < 20) A(acc, u, wr, wc, fr, fq);
        else { pg8::Unit u2 = u; u2.pn = u.pn - 20; B(acc, u2, wr, wc, fr, fq); }
    }
};
struct EpiMerge2 {
    static constexpr bool PERM = true;
    bf16_t* MG; const bf16_t* GATE;
    __device__ __forceinline__ void mid(f32x4 (&acc)[2][2][4][2], const pg8::Unit& u, int wr, int wc, int fr, int fq) const {
#pragma unroll
        for (int ai = 0; ai < 2; ++ai) {
            u32x4 ra[4][2];
#pragma unroll
            for (int m = 0; m < 4; ++m)
#pragma unroll
                for (int bj = 0; bj < 2; ++bj) {
                    const int row = u.pm * 256 + ai * 128 + wr * 64 + m * 16 + fr, col = u.pn * 256 + bj * 128 + wc * 32 + 8 * fq;
                    ra[m][bj] = *(const u32x4*)(GATE + (size_t)row * 2048 + col);
                }
#pragma unroll
            for (int m = 0; m < 4; ++m)
#pragma unroll
                for (int bj = 0; bj < 2; ++bj) {
                    const u32x4 r4 = ra[m][bj];
                    f32x4& v0 = acc[ai][bj][m][0]; f32x4& v1 = acc[ai][bj][m][1];
                    v0[0] *= bf_lo(r4.x); v0[1] *= bf_hi(r4.x); v0[2] *= bf_lo(r4.y); v0[3] *= bf_hi(r4.y);
                    v1[0] *= bf_lo(r4.z); v1[1] *= bf_hi(r4.z); v1[2] *= bf_lo(r4.w); v1[3] *= bf_hi(r4.w);
                }
        }
    }
    __device__ __forceinline__ void operator()(const f32x4 (&acc)[2][2][4][2], const pg8::Unit& u, int wr, int wc, int fr, int fq) const {
        u32x4 gl[2][4][2];
#pragma unroll
        for (int ai = 0; ai < 2; ++ai)
#pragma unroll
            for (int m = 0; m < 4; ++m)
#pragma unroll
                for (int bj = 0; bj < 2; ++bj) {
                    const int row = u.pm * 256 + ai * 128 + wr * 64 + m * 16 + fr, col = u.pn * 256 + bj * 128 + wc * 32 + 8 * fq;
                    gl[ai][m][bj] = *(const u32x4*)(GATE + (size_t)row * 2048 + 1024 + col);
                }
#pragma unroll
        for (int ai = 0; ai < 2; ++ai) {
#pragma unroll
            for (int m = 0; m < 4; ++m)
#pragma unroll
                for (int bj = 0; bj < 2; ++bj) {
                    const int row = u.pm * 256 + ai * 128 + wr * 64 + m * 16 + fr, col = u.pn * 256 + bj * 128 + wc * 32 + 8 * fq;
                    const u32x4 g4 = gl[ai][m][bj];
                    f32x4 v0 = acc[ai][bj][m][0], v1 = acc[ai][bj][m][1];
                    v0[0] *= fmaxf(bf_lo(g4.x), 1e-30f); v0[1] *= fmaxf(bf_hi(g4.x), 1e-30f); v0[2] *= fmaxf(bf_lo(g4.y), 1e-30f); v0[3] *= fmaxf(bf_hi(g4.y), 1e-30f);
                    v1[0] *= fmaxf(bf_lo(g4.z), 1e-30f); v1[1] *= fmaxf(bf_hi(g4.z), 1e-30f); v1[2] *= fmaxf(bf_lo(g4.w), 1e-30f); v1[3] *= fmaxf(bf_hi(g4.w), 1e-30f);
                    u32x4 w; w.x = cvt_pk_bf16(v0[0], v0[1]); w.y = cvt_pk_bf16(v0[2], v0[3]); w.z = cvt_pk_bf16(v1[0], v1[1]); w.w = cvt_pk_bf16(v1[2], v1[3]);
                    *(u32x4*)(MG + (size_t)row * DM + col) = w;
                }
        }
    }
};
template <bool LAST> struct EpiResidNorm {
    static constexpr bool PERM = false, AFTER_DRAIN = true;
    const bf16_t* XBin; const float* ssin; float* out; bf16_t* XB; float* ssn; const float* g; unsigned* pan; unsigned* tmo;
    __device__ __forceinline__ void load_round(u32x2 (&xr)[2][2][2], const pg8::Unit& u, int r, int wr, int wc, int fr, int fq) const {
        const int ai = r >> 1, mp = r & 1;
#pragma unroll
        for (int mm = 0; mm < 2; ++mm)
#pragma unroll
            for (int bj = 0; bj < 2; ++bj)
#pragma unroll
                for (int n = 0; n < 2; ++n) {
                    const int row = u.pm * 256 + ai * 128 + wr * 64 + (mp * 2 + mm) * 16 + fr;
                    xr[mm][bj][n] = *(const u32x2*)(XBin + (size_t)row * DM + u.pn * 256 + bj * 128 + wc * 32 + n * 16 + 4 * fq);
                }
    }
    __device__ __forceinline__ void fused(f32x4 (&acc)[2][2][4][2], const pg8::Unit& u, int wr, int wc, int fr, int fq, LAS unsigned char* lds, int wid, int lane) const {
        u32x2 xr[4][2][2][2];
        float sc[2][4];
#pragma unroll
        for (int ai = 0; ai < 2; ++ai)
#pragma unroll
            for (int m = 0; m < 4; ++m) sc[ai][m] = ssin[u.pm * 256 + ai * 128 + wr * 64 + m * 16 + fr];
#pragma unroll
        for (int r = 0; r < 4; ++r) load_round(xr[r], u, r, wr, wc, fr, fq);
#pragma unroll
        for (int ai = 0; ai < 2; ++ai)
#pragma unroll
            for (int m = 0; m < 4; ++m) sc[ai][m] = __builtin_amdgcn_sqrtf(sc[ai][m] * (1.0f / DM) + NORM_EPS);
#pragma unroll
        for (int r = 0; r < 4; ++r) {
            const int ai = r >> 1, mp = r & 1;
#pragma unroll
            for (int mm = 0; mm < 2; ++mm) {
                const int m = mp * 2 + mm, row = u.pm * 256 + ai * 128 + wr * 64 + m * 16 + fr; float s = 0.f;
#pragma unroll
                for (int bj = 0; bj < 2; ++bj)
#pragma unroll
                    for (int n = 0; n < 2; ++n) { const u32x2 w = xr[r][mm][bj][n];
                        const f32x4 xi = (f32x4){bf_lo(w.x), bf_hi(w.x), bf_lo(w.y), bf_hi(w.y)};
                        const f32x4 v = xi * sc[ai][m] + acc[ai][bj][m][n]; acc[ai][bj][m][n] = v; s += (v[0] * v[0] + v[1] * v[1]) + (v[2] * v[2] + v[3] * v[3]); }
                s += __shfl_xor(s, 16); s += __shfl_xor(s, 32);
                if (fq == 0) atomicAdd(ssn + row, s);
            }
        }
        asm volatile("s_waitcnt vmcnt(0)" ::: "memory"); __builtin_amdgcn_s_barrier(); asm volatile("" ::: "memory");
        unsigned* cnt = pan + 64 * u.pm;
        if (wid == 0 && lane == 0) __hip_atomic_fetch_add(cnt, 1u, __ATOMIC_RELAXED, __HIP_MEMORY_SCOPE_AGENT);
        if (wid == 0) {
            unsigned sp = 0;
            while ((unsigned)__builtin_amdgcn_readfirstlane(__hip_atomic_load(cnt, __ATOMIC_RELAXED, __HIP_MEMORY_SCOPE_AGENT)) < 4u) {
                __builtin_amdgcn_s_sleep(1);
                if ((++sp & 1023u) == 0u) { if (__hip_atomic_load(tmo, __ATOMIC_RELAXED, __HIP_MEMORY_SCOPE_AGENT) != 0u) break; if (sp > (1u << 22)) { if (lane == 0) __hip_atomic_store(tmo, 1u, __ATOMIC_RELAXED, __HIP_MEMORY_SCOPE_AGENT); break; } }
            }
        }
        __builtin_amdgcn_s_barrier(); asm volatile("" ::: "memory");
        float rs[2][4];
#pragma unroll
        for (int ai = 0; ai < 2; ++ai)
#pragma unroll
            for (int m = 0; m < 4; ++m) rs[ai][m] = __hip_atomic_load(ssn + u.pm * 256 + ai * 128 + wr * 64 + m * 16 + fr, __ATOMIC_RELAXED, __HIP_MEMORY_SCOPE_AGENT);
        f32x4 gv[2][2];
#pragma unroll
        for (int bj = 0; bj < 2; ++bj)
#pragma unroll
            for (int n = 0; n < 2; ++n) gv[bj][n] = LAST ? *(const f32x4*)(g + u.pn * 256 + bj * 128 + wc * 32 + n * 16 + 4 * fq) : (f32x4){1.f, 1.f, 1.f, 1.f};
#pragma unroll
        for (int ai = 0; ai < 2; ++ai)
#pragma unroll
            for (int m = 0; m < 4; ++m) {
                const int row = u.pm * 256 + ai * 128 + wr * 64 + m * 16 + fr;
                const float rstd = __builtin_amdgcn_rsqf(rs[ai][m] * (1.0f / DM) + NORM_EPS);
#pragma unroll
                for (int bj = 0; bj < 2; ++bj)
#pragma unroll
                    for (int n = 0; n < 2; ++n) {
                        const size_t off = (size_t)row * DM + u.pn * 256 + bj * 128 + wc * 32 + n * 16 + 4 * fq;
                        if (LAST) *(f32x4*)(out + off) = acc[ai][bj][m][n] * rstd * gv[bj][n];
                        else { const f32x4 v = acc[ai][bj][m][n] * rstd; u32x2 w; w.x = cvt_pk_bf16(v[0], v[1]); w.y = cvt_pk_bf16(v[2], v[3]); *(u32x2*)(XB + off) = w; }
                    }
            }
    }
};

typedef float f32x16 __attribute__((ext_vector_type(16)));
typedef short s16x4 __attribute__((ext_vector_type(4)));
typedef __bf16 bf16x2_t __attribute__((ext_vector_type(2)));
__device__ __forceinline__ unsigned cvtpk_c(float lo, float hi) { f32x2 v = {lo, hi}; bf16x2_t b = __builtin_convertvector(v, bf16x2_t); return __builtin_bit_cast(unsigned, b); }
__device__ __forceinline__ int crow(int r, int hi) { return (r & 3) + 8 * (r >> 2) + 4 * hi; }
__device__ __forceinline__ void attn_dma(LAS unsigned char* img, const bf16_t* base, int U, int seq_lo, int seq_hi, int sh, int w, int lane) {
    const int rseq = seq_lo >> (13 - sh);
    const __amdgpu_buffer_rsrc_t rs = __builtin_amdgcn_make_buffer_rsrc((void*)base, 0, SEQ * 256, 0x00020000);
    const int rl0 = lane >> 4, cp = lane & 15;
#pragma unroll
    for (int i = 0; i < 12; ++i) {
        const int pc = w * 12 + i, row_local = 4 * pc + rl0;
        int grow = U - 64 + row_local; grow = grow < seq_lo ? seq_lo : grow; grow = grow > seq_hi - 1 ? seq_hi - 1 : grow;
        const int tok = ((grow - seq_lo) << sh) + rseq;
        const int voff = tok * 256 + ((cp ^ ((rl0 << 2) | (i & 3))) << 4);
        __builtin_amdgcn_raw_ptr_buffer_load_lds(rs, (LAS void*)(img + pc * 1024), 16, voff, 0, 0, 0);
    }
}
constexpr int ATT_STG = 98304;
struct AttnUnit { int bh, U, seq_lo, seq_hi, hh, sh; };
__device__ __forceinline__ AttnUnit attn_decode(int unit) {
    AttnUnit a; a.bh = unit >> 5; const int qb = unit & 31; a.hh = a.bh % NH; a.sh = 2 * (a.hh >> 2); const int ng = SEQ >> a.sh;
    a.U = qb * 256; a.seq_lo = a.U & ~(ng - 1); a.seq_hi = a.seq_lo + ng; return a;
}
__device__ __forceinline__ void attn_load_q(bf16x8 (&qf)[8], const Frame& F, const AttnUnit& au) {
    const int c = F.lane & 31, hi = F.lane >> 5, rseq = au.seq_lo >> (13 - au.sh);
    const int qtok = ((au.U + 32 * F.wave + c - au.seq_lo) << au.sh) + rseq;
    const bf16_t* qrow = (const bf16_t*)(F.ws + WS_Q) + (size_t)au.bh * SEQ * HD + (size_t)qtok * HD + 8 * hi;
#pragma unroll
    for (int s = 0; s < 8; ++s) qf[s] = *(const bf16x8*)(qrow + 16 * s);
}
__device__ __forceinline__ void attn_unit(Frame& F, int unit, int next_unit, bool first, bf16x8 (&qf)[8]) {
    constexpr bool dry = false;
    LAS unsigned char* img = F.lds;
    const int lane = F.lane, w = F.wave, c = lane & 31, hi = lane >> 5;
    const AttnUnit au = attn_decode(unit);
    const int bh = au.bh, U = au.U, seq_lo = au.seq_lo, seq_hi = au.seq_hi;
    bf16_t* Qh = (bf16_t*)(F.ws + WS_Q) + (size_t)bh * SEQ * HD;
    const bf16_t* Vh = (const bf16_t*)(F.ws + WS_V) + (size_t)bh * SEQ * HD;
    const int rseq = seq_lo >> (13 - au.sh);
    const int qtok = ((U + 32 * w + c - seq_lo) << au.sh) + rseq;
    const float slope2 = __builtin_amdgcn_exp2f(-8.0f * (float)(au.hh + 1) / 12.0f) * (float)(1 << au.sh) * LOG2E;
    if (first) asm volatile("s_waitcnt vmcnt(0)" ::: "memory"); else asm volatile("s_waitcnt vmcnt(8)" ::: "memory");
    __builtin_amdgcn_s_barrier(); asm volatile("" ::: "memory");
    const bool lo_edge = (U == seq_lo), hi_edge = (U + 256 == seq_hi);
    f32x16 p[5];
    {   const int lk = fresh(lane), ck = lk & 31, hk = lk >> 5;
        const unsigned swz = ((unsigned)(ck & 3) << 2) | ((unsigned)(ck >> 2) & 3u);
        unsigned kx[8];
#pragma unroll
        for (int s = 0; s < 8; ++s) kx[s] = 256u * (unsigned)(32 * w + ck) + 16u * (((unsigned)(2 * s + hk)) ^ swz);
        const float dbase = (float)(4 * hk - ck);
#pragma unroll
        for (int i = 0; i < 5; ++i) {
            const bool tile_dead = (lo_edge && (w + i < 2)) || (hi_edge && (w + i >= 10));
            f32x16 a;
#pragma unroll
            for (int r = 0; r < 16; ++r) {
                const float ad = fabsf((float)(32 * i + (r & 3) + 8 * (r >> 2) - 64) + dbase);
                float b = -slope2 * ad;
                if (i == 0 || i == 4) b = (ad <= 64.0f) ? b : -1e30f;
                a[r] = tile_dead ? -1e30f : b;
            }
#pragma unroll
            for (int s = 0; s < 8; ++s) { const bf16x8 kf = *(const LAS bf16x8*)(img + kx[s] + 8192 * i); a = __builtin_amdgcn_mfma_f32_32x32x16_bf16(kf, qf[s], a, 0, 0, 0); }
            p[i] = a;
        }
    }
    asm volatile("s_waitcnt lgkmcnt(0)" ::: "memory"); __builtin_amdgcn_s_barrier(); asm volatile("" ::: "memory");
    attn_dma(img, Vh, U, seq_lo, seq_hi, au.sh, w, lane);
    if (next_unit < BATCH * NH * 32) { const AttnUnit nq = attn_decode(next_unit); attn_load_q(qf, F, nq); }
    float mx = -1e30f;
#pragma unroll
    for (int i = 0; i < 5; ++i)
#pragma unroll
        for (int r = 0; r < 16; ++r) mx = fmaxf(mx, p[i][r]);
    mx = fmaxf(mx, __shfl_xor(mx, 32));
    float l = 0.f;
    u32x4 pa[5][2];
#pragma unroll
    for (int i = 0; i < 5; ++i) {
#pragma unroll
        for (int r = 0; r < 16; ++r) { const float e = __builtin_amdgcn_exp2f(p[i][r] - mx); p[i][r] = e; l += e; }
#pragma unroll
        for (int s = 0; s < 2; ++s) {
            pa[i][s].x = cvtpk_c(p[i][8 * s + 0], p[i][8 * s + 1]); pa[i][s].y = cvtpk_c(p[i][8 * s + 2], p[i][8 * s + 3]);
            pa[i][s].z = cvtpk_c(p[i][8 * s + 4], p[i][8 * s + 5]); pa[i][s].w = cvtpk_c(p[i][8 * s + 6], p[i][8 * s + 7]);
        }
    }
    l += __shfl_xor(l, 32);
    const float inv = __builtin_amdgcn_rcpf(l);
    if (hi == 0 && !dry) ((float*)(F.ws + WS_LSE))[(size_t)bh * SEQ + qtok] = mx + __builtin_amdgcn_logf(l);
    asm volatile("s_waitcnt vmcnt(0)" ::: "memory"); __builtin_amdgcn_s_barrier(); asm volatile("" ::: "memory");
    f32x16 o[4];
#pragma unroll
    for (int c4 = 0; c4 < 4; ++c4) o[c4] = (f32x16){0.f, 0.f, 0.f, 0.f, 0.f, 0.f, 0.f, 0.f, 0.f, 0.f, 0.f, 0.f, 0.f, 0.f, 0.f, 0.f};
    {   const int lv = fresh(lane), blk = (lv >> 4) & 1, q = (lv & 15) >> 2, pp = lv & 3, hv = lv >> 5;
        unsigned vx[4][2];
#pragma unroll
        for (int c4 = 0; c4 < 4; ++c4)
#pragma unroll
            for (int t = 0; t < 2; ++t)
                vx[c4][t] = 256u * (unsigned)(32 * w + 8 * t + 4 * hv + q) + 16u * ((((unsigned)(c4 ^ q)) << 2) | (((unsigned)(2 * blk + (pp >> 1))) ^ ((unsigned)(2 * t + hv)))) + 8u * (unsigned)(pp & 1);
#pragma unroll
        for (int i = 0; i < 5; ++i)
#pragma unroll
            for (int s = 0; s < 2; ++s) {
                const bf16x8 pf = __builtin_bit_cast(bf16x8, pa[i][s]);
#pragma unroll
                for (int c4 = 0; c4 < 4; ++c4) {
                    const s16x4 v0 = __builtin_bit_cast(s16x4, __builtin_amdgcn_ds_read_tr16_b64_v4i16((LAS s16x4*)(img + vx[c4][0] + 8192 * i + 4096 * s)));
                    const s16x4 v1 = __builtin_bit_cast(s16x4, __builtin_amdgcn_ds_read_tr16_b64_v4i16((LAS s16x4*)(img + vx[c4][1] + 8192 * i + 4096 * s)));
                    const bf16x8 vf = (bf16x8){v0[0], v0[1], v0[2], v0[3], v1[0], v1[1], v1[2], v1[3]};
                    o[c4] = __builtin_amdgcn_mfma_f32_32x32x16_bf16(vf, pf, o[c4], 0, 0, 0);
                }
            }
    }
    asm volatile("s_waitcnt lgkmcnt(0)" ::: "memory"); __builtin_amdgcn_s_barrier(); asm volatile("" ::: "memory");
    if (next_unit < BATCH * NH * 32) { const AttnUnit nu = attn_decode(next_unit);
        attn_dma(img, (const bf16_t*)(F.ws + WS_K) + (size_t)nu.bh * SEQ * HD, nu.U, nu.seq_lo, nu.seq_hi, nu.sh, w, lane); }
    asm volatile("" ::: "memory");
    {   LAS unsigned char* stg = F.lds + ATT_STG + w * 4096;
        const int otok0 = ((U + 32 * w - seq_lo) << au.sh) + rseq;
#pragma unroll
        for (int rnd = 0; rnd < 2; ++rnd) {
            if ((c >> 4) == rnd) {
                const int rr = c & 15;
#pragma unroll
                for (int c4 = 0; c4 < 4; ++c4)
#pragma unroll
                    for (int g = 0; g < 4; ++g) {
                        u32x2 v; v.x = cvtpk_c(o[c4][4 * g + 0] * inv, o[c4][4 * g + 1] * inv); v.y = cvtpk_c(o[c4][4 * g + 2] * inv, o[c4][4 * g + 3] * inv);
                        *(LAS u32x2*)(stg + rr * 256 + (((4 * c4 + g) ^ rr) << 4) + 8 * hi) = v;
                    }
            }
            asm volatile("s_waitcnt lgkmcnt(0)" ::: "memory");
#pragma unroll
            for (int it = 0; it < 4; ++it) { const int row = it * 4 + (lane >> 4), ch = lane & 15;
                const u32x4 v = *(const LAS u32x4*)(stg + row * 256 + ((ch ^ row) << 4));
                if (!dry) __builtin_nontemporal_store(v, (u32x4*)(Qh + (size_t)(otok0 + ((rnd * 16 + row) << au.sh)) * HD + ch * 8)); }
            asm volatile("s_waitcnt lgkmcnt(0)" ::: "memory");
        }
    }
}
__device__ __forceinline__ void attn_phase(Frame& F, bool dry) {
    int unit = F.vcu;
    if (unit < BATCH * NH * 32) { const AttnUnit au = attn_decode(unit);
        attn_dma(F.lds, (const bf16_t*)(F.ws + WS_K) + (size_t)au.bh * SEQ * HD, au.U, au.seq_lo, au.seq_hi, au.sh, F.wave, F.lane); }
    bf16x8 qf[8];
    if (unit < BATCH * NH * 32) { const AttnUnit au = attn_decode(unit); attn_load_q(qf, F, au); }
    bool first = true;
    for (; unit < BATCH * NH * 32; unit += F.G) { attn_unit(F, unit, unit + F.G, first, qf); first = false; }
    __syncthreads();
}

struct MixItem { float l[3]; u32x4 o[3], sg; };
__device__ __forceinline__ void attn_mix_load(MixItem& R, const unsigned char* ws, int pm, int slot, int part, int j) {
    const bf16_t* O = (const bf16_t*)(ws + WS_Q); const float* LSE = (const float*)(ws + WS_LSE); const bf16_t* SGA = (const bf16_t*)(ws + WS_SGA);
    const int it = part * 1024 + 512 * j + fresh(threadIdx.x), row = pm * 256 + (it >> 4), ch = it & 15, b = row >> 13, p = row & 8191;
#pragma unroll
    for (int g = 0; g < 3; ++g) { const int hh = 4 * g + slot;
        const size_t r = (size_t)(b * NH + hh) * SEQ + p; R.l[g] = __builtin_nontemporal_load(LSE + r); R.o[g] = __builtin_nontemporal_load((const u32x4*)(O + r * HD + 8 * ch)); }
    R.sg = *(const u32x4*)(SGA + (size_t)row * 512 + slot * 128 + 8 * ch);
}
__device__ __forceinline__ void attn_mix_finish(const MixItem& R, unsigned char* ws, int pm, int slot, int part, int j, bool dry) {
    bf16_t* SGA = (bf16_t*)(ws + WS_SGA);
    const int it = part * 1024 + 512 * j + fresh(threadIdx.x), row = pm * 256 + (it >> 4), ch = it & 15;
    const float mx = fmaxf(fmaxf(R.l[0], R.l[1]), R.l[2]);
    float w0 = __builtin_amdgcn_exp2f(R.l[0] - mx), w1 = __builtin_amdgcn_exp2f(R.l[1] - mx), w2 = __builtin_amdgcn_exp2f(R.l[2] - mx); const float inv = __builtin_amdgcn_rcpf(w0 + w1 + w2); w0 *= inv; w1 *= inv; w2 *= inv;
    u32x4 y;
#define MIXW(f) { const float lo = (w0 * bf_lo(R.o[0].f) + w1 * bf_lo(R.o[1].f) + w2 * bf_lo(R.o[2].f)) * bf_lo(R.sg.f); const float hi = (w0 * bf_hi(R.o[0].f) + w1 * bf_hi(R.o[1].f) + w2 * bf_hi(R.o[2].f)) * bf_hi(R.sg.f); y.f = cvt_pk_bf16(lo, hi); }
    MIXW(x) MIXW(y) MIXW(z) MIXW(w)
#undef MIXW
    if (!dry) *(u32x4*)(SGA + (size_t)row * 512 + slot * 128 + 8 * ch) = y;
}
__device__ __forceinline__ void attn_mix(unsigned char* ws, int pm, int slot, int part, bool dry) {
    MixItem R0, R1; attn_mix_load(R0, ws, pm, slot, part, 0); attn_mix_load(R1, ws, pm, slot, part, 1); attn_mix_finish(R0, ws, pm, slot, part, 0, dry); attn_mix_finish(R1, ws, pm, slot, part, 1, dry); }

__device__ __forceinline__ void lru_conv(Frame& F, bf16_t* XC, int pm, int n, const float* conv_w, const float* conv_b) {
    const bf16_t* XL = (const bf16_t*)(F.ws + WS_XLRU);
    const int tid = fresh(threadIdx.x), c0 = n * 256 + (tid & 31) * 8, r0 = pm * 256 + (tid >> 5) * 16, t0 = r0 & 8191;
    float w[4][8], b[8];
#pragma unroll
    for (int j = 0; j < 4; ++j) { const f32x4 w0 = *(const f32x4*)(conv_w + j * DM + c0), w1 = *(const f32x4*)(conv_w + j * DM + c0 + 4);
        w[j][0] = w0[0]; w[j][1] = w0[1]; w[j][2] = w0[2]; w[j][3] = w0[3]; w[j][4] = w1[0]; w[j][5] = w1[1]; w[j][6] = w1[2]; w[j][7] = w1[3]; }
    { const f32x4 b0 = *(const f32x4*)(conv_b + c0), b1 = *(const f32x4*)(conv_b + c0 + 4); b[0] = b0[0]; b[1] = b0[1]; b[2] = b0[2]; b[3] = b0[3]; b[4] = b1[0]; b[5] = b1[1]; b[6] = b1[2]; b[7] = b1[3]; }
    u32x4 xr[19];
#pragma unroll
    for (int i = 0; i < 19; ++i) { const int tt = t0 + i - 2;
        xr[i] = (tt >= 0 && tt < SEQ) ? *(const u32x4*)(XL + (size_t)(r0 + i - 2) * DM + c0) : (u32x4){0u, 0u, 0u, 0u}; }
#pragma unroll
    for (int i = 0; i < 16; ++i) {
        float a[8];
#pragma unroll
        for (int e = 0; e < 8; ++e) a[e] = b[e];
#pragma unroll
        for (int j = 0; j < 4; ++j) { const u32x4 xv = xr[i + j];
            a[0] += w[j][0] * bf_lo(xv.x); a[1] += w[j][1] * bf_hi(xv.x); a[2] += w[j][2] * bf_lo(xv.y); a[3] += w[j][3] * bf_hi(xv.y);
            a[4] += w[j][4] * bf_lo(xv.z); a[5] += w[j][5] * bf_hi(xv.z); a[6] += w[j][6] * bf_lo(xv.w); a[7] += w[j][7] * bf_hi(xv.w); }
        u32x4 o; o.x = cvt_pk_bf16(a[0], a[1]); o.y = cvt_pk_bf16(a[2], a[3]); o.z = cvt_pk_bf16(a[4], a[5]); o.w = cvt_pk_bf16(a[6], a[7]);
        *(u32x4*)(XC + (size_t)(r0 + i) * DM + c0) = o;
    }
}
template <int CTRL> __device__ __forceinline__ float dpp_zero(float v) { return __int_as_float(__builtin_amdgcn_update_dpp(0, __float_as_int(v), CTRL, 0xf, 0xf, true)); }
#define LRU_SCAN_STEP(SH) { const float bs_ = dpp_zero<SH>(Bt), am_ = dpp_zero<SH>(At - 1.0f); Bt = __builtin_fmaf(At, bs_, Bt); At = __builtin_fmaf(At, am_, At); }
struct EpiLruReg {
    static constexpr bool PERM = false, AFTER_DRAIN = false, APERM = true;
    LAS unsigned char* lds; const bf16_t* XC; const f32x4* LC;
    unsigned long long* TIL; unsigned* cnt0; unsigned* tmo; const bf16_t* SGL; bf16_t* YL; unsigned char* ws; int n; const float* const* fin;
    __device__ __forceinline__ void operator()(f32x4 (&acc)[2][2][4][2], const pg8::Unit& u, int wr, int wc, int fr, int fq) const {
        const int qq = u.pn, wid = wr * 4 + wc, lane = fq * 16 + fr;
        const int cu0 = 16 * wc + 4 * fq, ch0 = 256 * n + 64 * qq + cu0;
        unsigned* cnt = cnt0 + qq * 64;
        const size_t off0 = (size_t)(u.pm * 256 + wr * 128 + 8 * fr) * DM + ch0;
        u32x2 xw8[2][4], sg8[2][4];
#pragma unroll
        for (int ai = 0; ai < 2; ++ai)
#pragma unroll
            for (int m = 0; m < 4; ++m) xw8[ai][m] = *(const u32x2*)(XC + off0 + (size_t)(ai * 4 + m) * DM);
        MixItem M0, M1; attn_mix_load(M0, ws, u.pm, n, qq, 0); attn_mix_load(M1, ws, u.pm, n, qq, 1);
        LAS f32x2* xch = (LAS f32x2*)(lds + LRU_XCH);
        LAS f32x2* xtot = xch; const int dummy = 768 + wid * 64 + lane;
        f32x2 pre[2][4];
#pragma unroll
        for (int d = 0; d < 2; ++d) {
            f32x3 lc[4];
#pragma unroll
            for (int e = 0; e < 4; ++e) { const float* lp = (const float*)(LC + d * DM + ch0 + e); const f32x2 v = *(const f32x2*)lp; lc[e][0] = v.x; lc[e][1] = v.y; lc[e][2] = lp[2]; }
#pragma unroll
            for (int ai = 0; ai < 2; ++ai)
#pragma unroll
                for (int m = 0; m < 4; ++m) {
                    const int t = (u.pm * 256 + wr * 128 + 8 * fr + 4 * ai + m) & 8191;
                    const bool first = (d == 0) ? (ai == 0 && m == 0 && t == 0) : (ai == 1 && m == 3 && t == SEQ - 1);
                    u32x2 xw = xw8[ai][m]; asm volatile("" : "+v"(xw.x), "+v"(xw.y));
                    const float xc[4] = {bf_lo(xw.x), bf_hi(xw.x), bf_lo(xw.y), bf_hi(xw.y)};
#pragma unroll
                    for (int e = 0; e < 4; ++e) {
                        const float r = __builtin_amdgcn_rcpf(__builtin_fmaf(__builtin_amdgcn_exp2f(acc[ai][d][m][0][e]), lc[e][0], 1.0f));
                        const float ig = __builtin_amdgcn_rcpf(__builtin_fmaf(__builtin_amdgcn_exp2f(acc[ai][d][m][1][e]), lc[e][1], 1.0f));
                        const float av = __builtin_amdgcn_exp2f(r * lc[e][2]);
                        const float mult = first ? 1.0f : __builtin_amdgcn_sqrtf(1.0f - av * av);
                        acc[ai][d][m][0][e] = av; acc[ai][d][m][1][e] = mult * ig * xc[e];
                    }
                }
#define LRU_A(j) acc[(j) >> 2][d][(j) & 3][0][e]
#define LRU_B(j) acc[(j) >> 2][d][(j) & 3][1][e]
#pragma unroll
            for (int e = 0; e < 4; ++e) {
                if (d == 0) {
#pragma unroll
                    for (int j = 1; j < 8; ++j) { LRU_B(j) = __builtin_fmaf(LRU_A(j), LRU_B(j - 1), LRU_B(j)); LRU_A(j) *= LRU_A(j - 1); }
                } else {
#pragma unroll
                    for (int j = 6; j >= 0; --j) { LRU_B(j) = __builtin_fmaf(LRU_A(j), LRU_B(j + 1), LRU_B(j)); LRU_A(j) *= LRU_A(j + 1); }
                }
                float At = LRU_A(d ? 0 : 7), Bt = LRU_B(d ? 0 : 7);
                if (d == 0) { LRU_SCAN_STEP(0x111) LRU_SCAN_STEP(0x112) LRU_SCAN_STEP(0x114) LRU_SCAN_STEP(0x118) pre[d][e] = (f32x2){1.0f + dpp_zero<0x111>(At - 1.0f), dpp_zero<0x111>(Bt)}; }
                else        { LRU_SCAN_STEP(0x101) LRU_SCAN_STEP(0x102) LRU_SCAN_STEP(0x104) LRU_SCAN_STEP(0x108) pre[d][e] = (f32x2){1.0f + dpp_zero<0x101>(At - 1.0f), dpp_zero<0x101>(Bt)}; }
                xtot[(fr == (d ? 0 : 15)) ? ((d * 2 + wr) * 64 + cu0 + e) : dummy] = (f32x2){At, Bt};
            }
#undef LRU_A
#undef LRU_B
            __builtin_amdgcn_sched_barrier(0);
            if (d == 0) {
#pragma unroll
                for (int ai = 0; ai < 2; ++ai)
#pragma unroll
                    for (int m = 0; m < 4; ++m) {
                        unsigned p0 = cvt_pk_bf16(acc[ai][0][m][0][0], acc[ai][0][m][0][1]), p1 = cvt_pk_bf16(acc[ai][0][m][0][2], acc[ai][0][m][0][3]);
                        asm volatile("" : "+v"(p0), "+v"(p1));
                        acc[ai][0][m][0][0] = __uint_as_float(p0); acc[ai][0][m][0][1] = __uint_as_float(p1);
                    }
            }
        }
#pragma unroll
        for (int ai = 0; ai < 2; ++ai)
#pragma unroll
            for (int m = 0; m < 4; ++m) {
                unsigned p0 = cvt_pk_bf16(acc[ai][1][m][0][0], acc[ai][1][m][0][1]), p1 = cvt_pk_bf16(acc[ai][1][m][0][2], acc[ai][1][m][0][3]);
                asm volatile("" : "+v"(p0), "+v"(p1));
                acc[ai][0][m][0][2] = __uint_as_float(p0); acc[ai][0][m][0][3] = __uint_as_float(p1);
#pragma unroll
                for (int e = 0; e < 4; ++e) { float S = acc[ai][0][m][1][e] + acc[ai][1][m][1][e]; asm volatile("" : "+v"(S)); acc[ai][0][m][1][e] = S; }
            }
        unsigned prea[4];
#pragma unroll
        for (int e = 0; e < 4; ++e) { prea[e] = cvt_pk_bf16(pre[0][e].x, pre[1][e].x); asm volatile("" : "+v"(prea[e]), "+v"(pre[0][e].y), "+v"(pre[1][e].y)); }
        LDS_WAIT(); __builtin_amdgcn_s_barrier(); asm volatile("" ::: "memory");
        const int tid = wid * 64 + lane, dir = (tid >> 6) & 1, cu = tid & 63; const bool pub = tid < 128;
        const size_t tslot = (size_t)(n * 4 + qq) * 128 + dir * 64 + cu;
        if (pub) {
            float Pt = 1.0f, Ht = 0.0f;
#pragma unroll
            for (int s = 0; s < 2; ++s) { const f32x2 v = xch[(dir * 2 + (dir ? 1 - s : s)) * 64 + cu]; Ht = v.x * Ht + v.y; Pt *= v.x; }
            __hip_atomic_store(TIL + (size_t)u.pm * 2048 + tslot, ((unsigned long long)__float_as_uint(Ht) << 32) | __float_as_uint(Pt), __ATOMIC_RELAXED, __HIP_MEMORY_SCOPE_AGENT);
        }
        if (pub) { asm volatile("s_waitcnt vmcnt(0)" ::: "memory");
            if (lane == 0) __hip_atomic_fetch_add(cnt, 1u, __ATOMIC_RELAXED, __HIP_MEMORY_SCOPE_AGENT); }
        if (fin) {
            const int uidx = (u.pm * 4 + n) * 4 + qq;
            int item = -1;
            if (wid >= 2) item = uidx * 6 + (wid - 2); else if (wid == 0 && uidx < P1_MINI - 6144) item = 6144 + uidx;
            if (item >= 0) p0_layer1_mini(fin, ws, item, lane);
        }
        attn_mix_finish(M0, ws, u.pm, n, qq, 0, false); attn_mix_finish(M1, ws, u.pm, n, qq, 1, false);
#pragma unroll
        for (int ai = 0; ai < 2; ++ai)
#pragma unroll
            for (int m = 0; m < 4; ++m) sg8[ai][m] = *(const u32x2*)(SGL + off0 + (size_t)(ai * 4 + m) * DM);
        if (pub) {
            unsigned sp = 0;
            while ((unsigned)__builtin_amdgcn_readfirstlane(__hip_atomic_load(cnt, __ATOMIC_RELAXED, __HIP_MEMORY_SCOPE_AGENT)) < 64u) {
                __builtin_amdgcn_s_sleep(1);
                if ((++sp & 1023u) == 0u) { if (__hip_atomic_load(tmo, __ATOMIC_RELAXED, __HIP_MEMORY_SCOPE_AGENT) != 0u) break; if (sp > (1u << 22)) { if (lane == 0) __hip_atomic_store(tmo, 1u, __ATOMIC_RELAXED, __HIP_MEMORY_SCOPE_AGENT); break; } }
            }
            asm volatile("" ::: "memory");
            float h = 0.0f;
            {   const int pb = u.pm & ~31;
#pragma unroll
                for (int hb = 0; hb < 2; ++hb) {
                    unsigned long long tv[16];
#pragma unroll
                    for (int k = 0; k < 16; ++k) {
                        const int kk = hb * 16 + k, q = dir ? (pb + 31 - kk) : (pb + kk); const bool use = (kk < 31) && (dir ? (q > u.pm) : (q < u.pm));
                        tv[k] = use ? __hip_atomic_load(TIL + (size_t)q * 2048 + tslot, __ATOMIC_RELAXED, __HIP_MEMORY_SCOPE_AGENT) : 0x000000003f800000ull;
                    }
#pragma unroll
                    for (int k = 0; k < 16; ++k) h = __uint_as_float((unsigned)tv[k]) * h + __uint_as_float((unsigned)(tv[k] >> 32));
                    asm volatile("" ::: "memory");
                }
            }
            LAS float* hin = (LAS float*)(lds + LRU_XCH + 4096);
#pragma unroll
            for (int s = 0; s < 2; ++s) { const int sg2 = dir ? 1 - s : s; hin[(dir * 2 + sg2) * 64 + cu] = h; const f32x2 v = xch[(dir * 2 + sg2) * 64 + cu]; h = v.x * h + v.y; }
        }
        LDS_WAIT(); __builtin_amdgcn_s_barrier(); asm volatile("" ::: "memory");
        f32x4 cf = *(const LAS f32x4*)(lds + LRU_XCH + 4096 + ((0 * 2 + wr) * 64 + cu0) * 4), cb = *(const LAS f32x4*)(lds + LRU_XCH + 4096 + ((1 * 2 + wr) * 64 + cu0) * 4);
#pragma unroll
        for (int e = 0; e < 4; ++e) { cf[e] = __builtin_fmaf(bf_lo(prea[e]), cf[e], pre[0][e].y); cb[e] = __builtin_fmaf(bf_hi(prea[e]), cb[e], pre[1][e].y); }
#pragma unroll
        for (int ai = 0; ai < 2; ++ai) {
#pragma unroll
            for (int m = 0; m < 4; ++m) {
                float hh[4];
#pragma unroll
                for (int e = 0; e < 4; ++e) { const unsigned pf = __float_as_uint(acc[ai][0][m][0][e >> 1]), pb = __float_as_uint(acc[ai][0][m][0][2 + (e >> 1)]);
                    hh[e] = __builtin_fmaf((e & 1) ? bf_hi(pb) : bf_lo(pb), cb[e], __builtin_fmaf((e & 1) ? bf_hi(pf) : bf_lo(pf), cf[e], acc[ai][0][m][1][e])); }
                const u32x2 sg = sg8[ai][m];
                u32x2 y; y.x = cvt_pk_bf16(hh[0] * bf_lo(sg.x), hh[1] * bf_hi(sg.x)); y.y = cvt_pk_bf16(hh[2] * bf_lo(sg.y), hh[3] * bf_hi(sg.y));
                *(u32x2*)(YL + off0 + (size_t)(ai * 4 + m) * DM) = y;
            }
        }
    }
};

__device__ __forceinline__ void final_norm(Frame& F, float* out, const float* ss, const float* g, bool dry) {
    const int gw = F.vcu * 8 + F.wave, NGW = F.G * 8;
    f32x4 gv[4];
#pragma unroll
    for (int j = 0; j < 4; ++j) gv[j] = ((const f32x4*)g)[F.lane + 64 * j];
    for (int m = gw; m < M; m += NGW) {
        const float rstd = __builtin_amdgcn_rsqf(ss[m] * (1.0f / DM) + NORM_EPS);
        f32x4* xr = (f32x4*)(out + (size_t)m * DM) + F.lane;
#pragma unroll
        for (int j = 0; j < 4; ++j) { const f32x4 v = xr[64 * j]; if (!dry) xr[64 * j] = v * rstd * gv[j]; }
    }
}

#define MERGE_GATE_UNITS(l_) do { pg8::StaticOrder Sm_; Sm_.init(M, DM, F.G, (int)blockIdx.x, DM, DM, WGM_LOCAL); pg8::Unit mu_; \
        if (Sm_.next(0, mu_)) { pg8::Gemm gg_{(const bf16_t*)(F.ws + WS_XB), Wb + W_IN_T / 2 + ((size_t)(l_) * NIN + NCOL_A) * DM, DM, DM, DM}; \
            pg8::PairUnit S2_; S2_.u0.pm = mu_.pm; S2_.u0.pn = 8 + 2 * mu_.pn; S2_.u0.abyte = mu_.pm * 256 * DM * 2; S2_.u0.bbyte = 0; S2_.tb = 256 * DM * 2; \
            EpiProjB Eg_{F.ws, args.in[3] + (l_) * 2048, (bf16_t*)((unsigned char*)args.out + OUT_SGL_BYTES)}; pg8::gemm_phase(fresh(threadIdx.x), F.lds, gg_, S2_, Eg_); } } while (0)
#ifndef WGM_P1A
#define WGM_P1A 4
#endif
#ifndef WGM_P1B
#define WGM_P1B 4
#endif
#ifndef WGM_LOCAL
#define WGM_LOCAL 4
#endif
constexpr int N_PHASES = 11;
__global__ void __launch_bounds__(512, 2) hybrid_fwd(Args args) {
    extern __shared__ __attribute__((aligned(16))) unsigned char lds_raw[];
    Frame F;
    F.lds = (LAS unsigned char*)lds_raw;
    F.tid = threadIdx.x; F.lane = F.tid & 63; F.wave = __builtin_amdgcn_readfirstlane(F.tid >> 6);
    F.G = gridDim.x; { const int bx = blockIdx.x; F.vcu = (F.G % 8 == 0) ? (bx % 8) * (F.G / 8) + bx / 8 : bx; }
    F.ws = args.ws; F.ctl = (unsigned*)(args.ws + WS_CTL);
    volatile LAS unsigned* MISC = (volatile LAS unsigned*)(F.lds + LDSCTL_OFF);
    if (F.tid < 64) MISC[F.tid] = 0u;
    __syncthreads();
    XcdBarrier bar; bar.bar = F.ctl + CW_BAR; bar.x = 0; bar.st = nullptr;
    if (MK_N_LAUNCHES == 1) bar = xcd_barrier_post(F.ctl + CW_BAR, MISC + 8);
    bool gates_done = false;
    if (F.tid == 0) __hip_atomic_store(F.ctl + CW_XTAB + F.vcu, xb_xcc_id() + 1u, __ATOMIC_RELAXED, __HIP_MEMORY_SCOPE_AGENT);
    bf16_t* Wb = (bf16_t*)(F.ws + WS_W);
    float* ss = (float*)(F.ctl + CW_SS);

#ifndef PHMASK
#define PHMASK 0x3ff
#endif
#ifndef REPEAT_PH
#define REPEAT_PH -1
#endif
#ifndef REPEAT_N
#define REPEAT_N 2
#endif
#ifdef TS_PROBE
    volatile LAS unsigned long long* TS = (volatile LAS unsigned long long*)(F.lds + LDSCTL_OFF + 256);
    int nts = 0;
#define TSTAMP() do { if (blockIdx.x == 0 && threadIdx.x == 0) TS[nts] = __builtin_amdgcn_s_memrealtime(); ++nts; } while (0)
    TSTAMP();
#else
#define TSTAMP() do {} while (0)
#endif
    for (int ph = args.ph_lo; ph < args.ph_hi; ++ph) {
#if REPEAT_PH >= 0
      const int reps = (ph == REPEAT_PH) ? REPEAT_N : 1;
      for (int rep = 0; rep < reps; ++rep) {
        const bool dry = (rep + 1 < reps);
        if (rep > 0) xcd_barrier(bar);
#else
      {
        constexpr bool dry = false;
#endif
        { int tv = threadIdx.x; asm volatile("" : "+v"(tv)); F.tid = tv; F.lane = tv & 63; F.wave = __builtin_amdgcn_readfirstlane(tv >> 6); }
        if (ph == 0) { if (PHMASK & 1) p0_prologue(F, args); }
        else {
            const int l = (ph - 1) / 5; int sub = (ph - 1) % 5; if (sub >= 2) ++sub; if (sub >= 4) ++sub;
            const bf16_t* XB = (const bf16_t*)(F.ws + WS_XB);
            if (sub == 0 && (PHMASK & 4)) {
                pg8::Gemm g{XB, Wb + W_IN_T / 2 + (size_t)l * NIN * DM, DM, DM, DM};
                pg8::RotOrder S; S.S.init(M, NCOL_A + DM, F.G, (int)blockIdx.x, DM, DM, WGM_P1A); S.rot = 20;
#ifdef STAGGER_TICKS
                if ((blockIdx.x >> 3) & 1) { const unsigned long long t0 = __builtin_amdgcn_s_memrealtime(); while (__builtin_amdgcn_s_memrealtime() - t0 < STAGGER_TICKS) __builtin_amdgcn_s_sleep(8); }
#endif
                EpiProjAB E{EpiProjA{F.ws, dry}, EpiProjB{F.ws, args.in[3] + l * 2048, (bf16_t*)((unsigned char*)args.out + OUT_SGL_BYTES)}};
                pg8::gemm_phase(fresh(threadIdx.x), F.lds, g, S, E);
            } else if (sub == 1 && (PHMASK & 8)) {
                attn_phase(F, dry);
            } else if (sub == 3 && (PHMASK & 32)) {
                bf16_t* XC = (bf16_t*)args.out;
                for (int task = F.vcu; task < 256; task += F.G) {
                    const int pm = task >> 2, n = task & 3;
                    lru_conv(F, XC, pm, n, args.in[4] + l * 4 * DM, args.in[5] + l * DM);
                    VM_WAIT(); __syncthreads();
                    {   pg8::Gemm g{XC, Wb + W_RG_T / 2, DM, 256, 256};
                        pg8::QuadUnit S; S.u0.pm = pm; S.u0.pn = 0; S.u0.abyte = (pm * 256 * DM + n * 256) * 2; S.u0.bbyte = ((l * 4 + n) * 4) * 65536 * 2; S.bstep = 65536 * 2;
                        EpiLruReg E{F.lds, XC, (const f32x4*)(F.ws + WS_LC) + l * 2048, (unsigned long long*)(F.ws + WS_TIL + (size_t)l * MiB),
                                    F.ctl + CW_CNT + (((l * 2 + (pm >> 5)) * 4 + n) * 4) * 64, F.ctl + CW_TMO, (const bf16_t*)((const unsigned char*)args.out + OUT_SGL_BYTES), (bf16_t*)(F.ws + WS_XLRU), F.ws, n, (l == 0 && F.G == 256) ? args.in : nullptr};
                        pg8::gemm_phase(fresh(threadIdx.x), F.lds, g, S, E);
                    }
                }
            } else if (sub == 5 && (PHMASK & 128)) {
                pg8::Gemm2 g{(const bf16_t*)(F.ws + WS_SGA), Wb + W_OATT_T / 2 + (size_t)l * DM * 512, 512, 512, 512,
                             (const bf16_t*)(F.ws + WS_XLRU), Wb + W_OLRU_T / 2 + (size_t)l * DM * DM, DM, DM, DM};
                pg8::StaticOrder S; S.init(M, DM, F.G, (int)blockIdx.x, DM, DM, WGM_LOCAL);
                if (!gates_done) { MERGE_GATE_UNITS(l); }
                gates_done = false;
                EpiMerge2 E{(bf16_t*)(F.ws + WS_MG), (const bf16_t*)(F.ws + WS_GATE)};
                pg8::gemm_phase2(fresh(threadIdx.x), F.lds, g, S, E);
            } else if (sub == 6 && (PHMASK & 256)) {
                pg8::Gemm g{(const bf16_t*)(F.ws + WS_MG), Wb + W_OUT_T / 2 + (size_t)l * DM * DM, DM, DM, DM};
                pg8::StaticOrder S; S.init(M, DM, F.G, (int)blockIdx.x, DM, DM, WGM_LOCAL);
                if (l + 1 < DEPTH) { EpiResidNorm<false> E{(const bf16_t*)(F.ws + WS_XB), ss + l * M, args.out, (bf16_t*)(F.ws + WS_XB), ss + (l + 1) * M, args.in[14], F.ctl + CW_PAN + l * 4096, F.ctl + CW_TMO}; pg8::gemm_phase(fresh(threadIdx.x), F.lds, g, S, E); }
                else { EpiResidNorm<true> E{(const bf16_t*)(F.ws + WS_XB), ss + l * M, args.out, (bf16_t*)(F.ws + WS_XB), ss + (l + 1) * M, args.in[14], F.ctl + CW_PAN + l * 4096, F.ctl + CW_TMO}; pg8::gemm_phase(fresh(threadIdx.x), F.lds, g, S, E); }
            }
        }
      }
        TSTAMP();
        if (ph + 1 < args.ph_hi) {
            const int subp = (ph == 0) ? -1 : ((ph - 1) % 5 < 2 ? (ph - 1) % 5 : (ph - 1) % 5 + 1);
            const bool fast_seams = MISC[10] != 0u;
            if (fast_seams && (subp == 3 || subp == 4)) { const unsigned gen = MISC[11] + 1u; __syncthreads(); if (F.tid == 0) MISC[11] = gen;
                group_barrier_arrive(F.ctl + CW_GBAR + (F.vcu >> 5) * 64);
                if (subp == 3) { const int ln = __builtin_amdgcn_readfirstlane((ph - 1) / 5); MERGE_GATE_UNITS(ln); gates_done = true; }
                group_barrier_wait(F.ctl + CW_GBAR + (F.vcu >> 5) * 64, 32u * gen, F.ctl + CW_TMO); }
            else if (MK_N_LAUNCHES == 1 && subp == 1) {
                xcd_barrier_arrive(bar);
                for (int task = F.vcu; task < 256; task += F.G) {
                    const int ln = __builtin_amdgcn_readfirstlane((ph - 1) / 5), pm_ = task >> 2, n_ = task & 3;
                    pg8::Gemm gg{(const bf16_t*)(F.ws + WS_XB), Wb + W_IN_T / 2 + ((size_t)ln * NIN + NCOL_A) * DM, DM, DM, DM};
                    pg8::SingleUnit S1; S1.u0.pm = pm_; S1.u0.pn = 4 + n_; S1.u0.abyte = pm_ * 256 * DM * 2; S1.u0.bbyte = (4 + n_) * 256 * DM * 2;
                    EpiProjB Es{F.ws, args.in[3] + ln * 2048, (bf16_t*)((unsigned char*)args.out + OUT_SGL_BYTES)};
                    pg8::gemm_phase(fresh(threadIdx.x), F.lds, gg, S1, Es);
                }
                xcd_barrier_wait(bar);
            }
            else xcd_barrier(bar);
            if (ph == 0 && F.G == 256) {
#ifndef NO_FAST_SEAMS
                const int t = F.tid & 255;
                const unsigned mine = __hip_atomic_load(F.ctl + CW_XTAB + t, __ATOMIC_RELAXED, __HIP_MEMORY_SCOPE_AGENT), ref = __hip_atomic_load(F.ctl + CW_XTAB + (t & ~31), __ATOMIC_RELAXED, __HIP_MEMORY_SCOPE_AGENT);
                if ((mine != ref) || (mine == 0u)) MISC[12] = 1u;
                __syncthreads();
                if (F.tid == 0) MISC[10] = (MISC[12] == 0u) ? 1u : 0u;
                __syncthreads();
#endif
            }
        }
        TSTAMP();
        if (REPEAT_PH == 100 && ph == 1) { xcd_barrier(bar); xcd_barrier(bar); xcd_barrier(bar); xcd_barrier(bar); xcd_barrier(bar); xcd_barrier(bar); xcd_barrier(bar); xcd_barrier(bar); }
    }
#ifdef TS_PROBE
    if (blockIdx.x == 0 && threadIdx.x == 0) {
        const unsigned long long dt = TS[TS_PROBE + 1] - TS[TS_PROBE], t0 = __builtin_amdgcn_s_memrealtime();
        while (__builtin_amdgcn_s_memrealtime() - t0 < 16ull * dt) __builtin_amdgcn_s_sleep(4);
    }
#endif
}

extern "C" void kernel_launch(void* const* d_in, const int* in_sizes, int n_in, void* d_out, int out_size, void* d_ws, size_t ws_size, hipStream_t stream) {
    static int grid = 0;
    if (grid == 0) {
        if (n_in != 15 || in_sizes[0] != M * DM || out_size != M * DM || ws_size < WS_END) { fprintf(stderr, "kernel_launch: unexpected shapes / workspace (%d inputs, ws %zu < %zu)\n", n_in, ws_size, (size_t)WS_END); grid = -1; return; }
        int dev = 0, cus = 0, per_cu = 0;
        if (hipGetDevice(&dev) != hipSuccess || hipDeviceGetAttribute(&cus, hipDeviceAttributeMultiprocessorCount, dev) != hipSuccess) { grid = -1; return; }
        if (hipFuncSetAttribute((const void*)hybrid_fwd, hipFuncAttributeMaxDynamicSharedMemorySize, LDS_BYTES) != hipSuccess) { fprintf(stderr, "kernel_launch: hipFuncSetAttribute failed\n"); grid = -1; return; }
        if (hipOccupancyMaxActiveBlocksPerMultiprocessor(&per_cu, (const void*)hybrid_fwd, 512, LDS_BYTES) != hipSuccess || per_cu < 1) { fprintf(stderr, "kernel_launch: occupancy query says %d\n", per_cu); grid = -1; return; }
        (void)hipGetLastError();
        grid = cus;
    }
    if (grid < 0) return;
    (void)hipMemsetAsync((char*)d_ws + WS_CTL, 0, CTL_ZERO_BYTES, stream);
    Args a{};
    for (int i = 0; i < 15; ++i) a.in[i] = (const float*)d_in[i];
    a.out = (float*)d_out; a.ws = (unsigned char*)d_ws;
    if (MK_N_LAUNCHES == 1) { a.ph_lo = 0; a.ph_hi = N_PHASES; a.li = 0; hipLaunchKernelGGL(hybrid_fwd, dim3(grid), dim3(512), LDS_BYTES, stream, a); }
    else for (int ph = 0; ph < N_PHASES; ++ph) { a.ph_lo = ph; a.ph_hi = ph + 1; a.li = ph; hipLaunchKernelGGL(hybrid_fwd, dim3(grid), dim3(512), LDS_BYTES, stream, a); }
}
```
